# Optimizing an MI355X kernel written in HIP

```python
import jax, jax.numpy as jnp
from jax import lax
import numpy as np

D_MODEL = 1024
BATCH = 8
SEQ = 4096
DEPTH = 1
DEC_BATCH = 8
DEC_SEQ = 64
PAST_LEN = 1024

CHUNK = 64
Q_BLOCK = 128
CONV_WIDTH = 3
D_CONV = D_MODEL
N_HEADS = 16
QK_NOPE = 64
QK_ROPE = 32
V_HEAD = 64
Q_LORA = 512
KV_LORA = 256
ROPE_THETA = 10000.0
N_MEM = 256
MEM_HEADS = 4
MEM_HEAD_DIM = D_MODEL // MEM_HEADS
D_FF = 4 * D_MODEL
EPS = 1e-6
IN_COLS = 3 * D_CONV + Q_LORA + KV_LORA + QK_ROPE + 2 * D_MODEL
ATTN_SCALE = (QK_NOPE + QK_ROPE) ** -0.5
MEM_SCALE = MEM_HEAD_DIM ** -0.5

kernel_name = 'hybrid_shortconv_mla_stream_step'


def rms_norm(x, g):
    x32 = x.astype(jnp.float32)
    y = x32 * lax.rsqrt(jnp.mean(x32 * x32, axis=-1, keepdims=True) + EPS)
    return (y * g.astype(jnp.float32)).astype(x.dtype)


def rope(x, pos):
    half = QK_ROPE // 2
    inv = ROPE_THETA ** (-jnp.arange(half, dtype=jnp.float32) / half)
    ang = pos.astype(jnp.float32)[:, None] * inv[None, :]
    ang = ang.reshape((ang.shape[0],) + (1,) * (x.ndim - 3) + (half,))
    cos, sin = jnp.cos(ang), jnp.sin(ang)
    x32 = x.astype(jnp.float32)
    x1, x2 = x32[..., :half], x32[..., half:]
    return jnp.concatenate([x1 * cos - x2 * sin, x2 * cos + x1 * sin], axis=-1).astype(x.dtype)


def split_in(z):
    sizes = (D_CONV, D_CONV, D_CONV, Q_LORA, KV_LORA, QK_ROPE, D_MODEL, D_MODEL)
    idx = np.cumsum(sizes)[:-1].tolist()
    return jnp.split(z, idx, axis=-1)


def short_conv(v, buf, w_conv):
    T = v.shape[1]
    vp = jnp.concatenate([buf.astype(v.dtype), v], axis=1)
    y = vp[:, 0:T] * w_conv[0]
    for k in range(1, CONV_WIDTH):
        y = y + vp[:, k:k + T] * w_conv[k]
    return y, vp[:, T:]


def mla_keys_values(ckv, kr, w_ukv):
    Bn, L = ckv.shape[:2]
    kv = (ckv @ w_ukv).reshape(Bn, L, N_HEADS, QK_NOPE + V_HEAD)
    k = jnp.concatenate([kv[..., :QK_NOPE], jnp.broadcast_to(kr[:, :, None, :], (Bn, L, N_HEADS, QK_ROPE))], axis=-1)
    return k, kv[..., QK_NOPE:]


def chunk_causal_attend(q, k, v, q_pos, k_pos):
    s = jnp.einsum('bqhd,bkhd->bhqk', q, k).astype(jnp.float32) * ATTN_SCALE
    visible = (k_pos[None, :] // CHUNK) <= (q_pos[:, None] // CHUNK)
    p = jax.nn.softmax(jnp.where(visible, s, -jnp.inf), axis=-1).astype(v.dtype)
    return jnp.einsum('bhqk,bkhd->bqhd', p, v)


def blocked_attend(q, k, v, k_pos):
    Bn, T = q.shape[:2]
    nblk = T // Q_BLOCK
    qb = q.reshape(Bn, nblk, Q_BLOCK, N_HEADS, q.shape[-1]).transpose(1, 0, 2, 3, 4)
    starts = jnp.arange(nblk, dtype=jnp.int32) * Q_BLOCK

    def one(args):
        q_blk, start = args
        return chunk_causal_attend(q_blk, k, v, start + jnp.arange(Q_BLOCK, dtype=jnp.int32), k_pos)

    o = lax.map(one, (qb, starts))
    return o.transpose(1, 0, 2, 3, 4).reshape(Bn, T, N_HEADS, V_HEAD)


def memory_kv(mem, g, w_k, w_v):
    Bn, M = mem.shape[:2]
    mn = rms_norm(mem, g)
    k = (mn @ w_k).reshape(Bn, M, MEM_HEADS, MEM_HEAD_DIM)
    v = (mn @ w_v).reshape(Bn, M, MEM_HEADS, MEM_HEAD_DIM)
    return k, v


def memory_attend(h, mem_k, mem_v, w_q, w_o):
    Bn, T = h.shape[:2]
    q = (h @ w_q).reshape(Bn, T, MEM_HEADS, MEM_HEAD_DIM)
    s = jnp.einsum('bqhd,bkhd->bhqk', q, mem_k).astype(jnp.float32) * MEM_SCALE
    p = jax.nn.softmax(s, axis=-1).astype(mem_v.dtype)
    o = jnp.einsum('bhqk,bkhd->bqhd', p, mem_v).reshape(Bn, T, MEM_HEADS * MEM_HEAD_DIM)
    return o @ w_o


def layer(x, conv_buf, past_ckv, past_kr, mem_k, mem_v, blocked,
          g_mix, w_in, w_conv, w_conv_out, g_q, w_uq, g_kv, w_ukv, w_mla_out, w_mix_out,
          g_mem_q, w_qm, w_om, g_mlp, w_up, w_down):
    Bn, T = x.shape[:2]
    past = past_ckv.shape[1]
    pos = past + jnp.arange(T, dtype=jnp.int32)
    k_pos = jnp.arange(past + T, dtype=jnp.int32)
    n = rms_norm(x, g_mix)
    u, gate_b, gate_c, cq, ckv_raw, kr_raw, a_conv, a_mla = split_in(n @ w_in)
    y_sc, new_buf = short_conv(gate_c * u, conv_buf, w_conv)
    y_a = (gate_b * y_sc) @ w_conv_out
    q = (rms_norm(cq, g_q) @ w_uq).reshape(Bn, T, N_HEADS, QK_NOPE + QK_ROPE)
    q = jnp.concatenate([q[..., :QK_NOPE], rope(q[..., QK_NOPE:], pos)], axis=-1)
    ckv = rms_norm(ckv_raw, g_kv)
    kr = rope(kr_raw, pos)
    k, v = mla_keys_values(jnp.concatenate([past_ckv.astype(ckv.dtype), ckv], axis=1),
                           jnp.concatenate([past_kr.astype(kr.dtype), kr], axis=1), w_ukv)
    if blocked:
        o = blocked_attend(q, k, v, k_pos)
    else:
        o = chunk_causal_attend(q, k, v, pos, k_pos)
    y_b = o.reshape(Bn, T, N_HEADS * V_HEAD) @ w_mla_out
    x = x + (jax.nn.sigmoid(a_conv) * y_a + jax.nn.sigmoid(a_mla) * y_b) @ w_mix_out
    x = x + memory_attend(rms_norm(x, g_mem_q), mem_k, mem_v, w_qm, w_om)
    hm = rms_norm(x, g_mlp)
    x = x + jnp.square(jax.nn.relu(hm @ w_up)) @ w_down
    return x, new_buf, ckv, kr


def setup_inputs(seed: int = 0) -> dict:
    key = jax.random.key(seed)
    ks = jax.random.split(key, 32)

    def nrm(k, shape, scale):
        return jax.random.normal(k, shape, jnp.float32) * scale

    def gain(k, shape):
        return 1.0 + 0.01 * jax.random.normal(k, shape, jnp.float32)

    return {
        'x_prompt': nrm(ks[0], (BATCH, SEQ, D_MODEL), 1.0),
        'x_sample': nrm(ks[1], (DEC_BATCH, DEC_SEQ, D_MODEL), 1.0),
        'cache_conv': nrm(ks[2], (DEPTH, DEC_BATCH, CONV_WIDTH - 1, D_CONV), 1.0),
        'cache_ckv': nrm(ks[3], (DEPTH, DEC_BATCH, PAST_LEN, KV_LORA), 1.0),
        'cache_krope': nrm(ks[4], (DEPTH, DEC_BATCH, PAST_LEN, QK_ROPE), 1.0),
        'cache_mem_k': nrm(ks[5], (DEPTH, DEC_BATCH, N_MEM, MEM_HEADS, MEM_HEAD_DIM), 1.0),
        'cache_mem_v': nrm(ks[6], (DEPTH, DEC_BATCH, N_MEM, MEM_HEADS, MEM_HEAD_DIM), 1.0),
        'mem_prompt': nrm(ks[7], (BATCH, N_MEM, D_MODEL), 1.0),
        'g_mix': gain(ks[8], (DEPTH, D_MODEL)),
        'w_in': nrm(ks[9], (DEPTH, D_MODEL, IN_COLS), D_MODEL ** -0.5),
        'w_conv': nrm(ks[10], (DEPTH, CONV_WIDTH, D_CONV), CONV_WIDTH ** -0.5),
        'w_conv_out': nrm(ks[11], (DEPTH, D_CONV, D_MODEL), D_CONV ** -0.5),
        'g_q': gain(ks[12], (DEPTH, Q_LORA)),
        'w_uq': nrm(ks[13], (DEPTH, Q_LORA, N_HEADS * (QK_NOPE + QK_ROPE)), Q_LORA ** -0.5),
        'g_kv': gain(ks[14], (DEPTH, KV_LORA)),
        'w_ukv': nrm(ks[15], (DEPTH, KV_LORA, N_HEADS * (QK_NOPE + V_HEAD)), KV_LORA ** -0.5),
        'w_mla_out': nrm(ks[16], (DEPTH, N_HEADS * V_HEAD, D_MODEL), (N_HEADS * V_HEAD) ** -0.5),
        'w_mix_out': nrm(ks[17], (DEPTH, D_MODEL, D_MODEL), D_MODEL ** -0.5),
        'g_mem_q': gain(ks[18], (DEPTH, D_MODEL)),
        'g_mem_kv': gain(ks[19], (DEPTH, D_MODEL)),
        'w_qm': nrm(ks[20], (DEPTH, D_MODEL, MEM_HEADS * MEM_HEAD_DIM), D_MODEL ** -0.5),
        'w_km': nrm(ks[21], (DEPTH, D_MODEL, MEM_HEADS * MEM_HEAD_DIM), D_MODEL ** -0.5),
        'w_vm': nrm(ks[22], (DEPTH, D_MODEL, MEM_HEADS * MEM_HEAD_DIM), D_MODEL ** -0.5),
        'w_om': nrm(ks[23], (DEPTH, MEM_HEADS * MEM_HEAD_DIM, D_MODEL), D_MODEL ** -0.5),
        'g_mlp': gain(ks[24], (DEPTH, D_MODEL)),
        'w_up': nrm(ks[25], (DEPTH, D_MODEL, D_FF), D_MODEL ** -0.5),
        'w_down': nrm(ks[26], (DEPTH, D_FF, D_MODEL), D_FF ** -0.5),
        'g_final': gain(ks[27], (D_MODEL,)),
    }


def reference(x_prompt, x_sample, cache_conv, cache_ckv, cache_krope, cache_mem_k, cache_mem_v, mem_prompt,
              g_mix, w_in, w_conv, w_conv_out, g_q, w_uq, g_kv, w_ukv, w_mla_out, w_mix_out,
              g_mem_q, g_mem_kv, w_qm, w_km, w_vm, w_om, g_mlp, w_up, w_down, g_final):
    xp, xs = x_prompt, x_sample
    Bp = xp.shape[0]
    p_conv, p_ckv, p_kr, p_mk, p_mv = [], [], [], [], []
    s_conv, s_ckv, s_kr = [], [], []
    for l in range(DEPTH):
        shared = (g_mix[l], w_in[l], w_conv[l], w_conv_out[l], g_q[l], w_uq[l], g_kv[l], w_ukv[l],
                  w_mla_out[l], w_mix_out[l], g_mem_q[l], w_qm[l], w_om[l], g_mlp[l], w_up[l], w_down[l])
        mk, mv = memory_kv(mem_prompt, g_mem_kv[l], w_km[l], w_vm[l])
        xp, b_p, c_p, r_p = layer(xp,
                                  jnp.zeros((Bp, CONV_WIDTH - 1, D_CONV), xp.dtype),
                                  jnp.zeros((Bp, 0, KV_LORA), xp.dtype),
                                  jnp.zeros((Bp, 0, QK_ROPE), xp.dtype),
                                  mk, mv, True, *shared)
        xs, b_s, c_s, r_s = layer(xs, cache_conv[l], cache_ckv[l], cache_krope[l],
                                  cache_mem_k[l], cache_mem_v[l], False, *shared)
        p_conv.append(b_p); p_ckv.append(c_p); p_kr.append(r_p); p_mk.append(mk); p_mv.append(mv)
        s_conv.append(b_s); s_ckv.append(c_s); s_kr.append(r_s)
    y_prompt = rms_norm(xp, g_final)
    y_sample = rms_norm(xs, g_final)
    return (y_prompt, y_sample,
            jnp.stack(p_conv), jnp.stack(p_ckv), jnp.stack(p_kr), jnp.stack(p_mk), jnp.stack(p_mv),
            jnp.stack(s_conv), jnp.stack(s_ckv), jnp.stack(s_kr))
```

```cpp
#include <hip/hip_runtime.h>
#include <cstdio>
#include <cstdint>

#define LAS __attribute__((address_space(3)))
#define GAS __attribute__((address_space(1)))
typedef unsigned short bf16_t;
typedef short bf16x8 __attribute__((ext_vector_type(8)));
typedef short s16x4 __attribute__((ext_vector_type(4)));
typedef float f32x4 __attribute__((ext_vector_type(4)));
typedef float f32x2 __attribute__((ext_vector_type(2)));
typedef float f32x16 __attribute__((ext_vector_type(16)));
typedef unsigned u32x4 __attribute__((ext_vector_type(4)));
typedef unsigned u32x2 __attribute__((ext_vector_type(2)));

constexpr int DM = 1024, NB = 8, SEQ = 4096, DSEQ = 64, PAST = 1024;
constexpr int MP = NB * SEQ;
constexpr int MS = NB * DSEQ;
constexpr int MT = MP + MS;
constexpr int KVS = PAST + DSEQ;
constexpr int KVROWS = MP + NB * KVS;
constexpr int NIN = 5920, NINP = 6144, NIN1 = 5888;
constexpr int QW = 1536, KVW = 2048, DFF = 4096, NMEM = 256;
constexpr float EPS = 1e-6f;
constexpr float LOG2E = 1.4426950408889634f;
constexpr float QSCALE = 0.10206207261596577f * LOG2E;
constexpr float MSCALE = 0.0625f * LOG2E;

typedef __bf16 bf16x2_t __attribute__((ext_vector_type(2)));
__device__ __forceinline__ unsigned cvt_pk_bf16(float lo, float hi) { f32x2 v = {lo, hi}; bf16x2_t b = __builtin_convertvector(v, bf16x2_t); return __builtin_bit_cast(unsigned, b); }
__device__ __forceinline__ float bf_lo(unsigned w) { return __builtin_bit_cast(float, w << 16); }
__device__ __forceinline__ float bf_hi(unsigned w) { return __builtin_bit_cast(float, w & 0xffff0000u); }
__device__ __forceinline__ u32x4 pack8(f32x4 a, f32x4 b) { u32x4 w; w.x = cvt_pk_bf16(a[0], a[1]); w.y = cvt_pk_bf16(a[2], a[3]); w.z = cvt_pk_bf16(b[0], b[1]); w.w = cvt_pk_bf16(b[2], b[3]); return w; }
__device__ __forceinline__ void unpack8(u32x4 w, f32x4& a, f32x4& b) { a = (f32x4){bf_lo(w.x), bf_hi(w.x), bf_lo(w.y), bf_hi(w.y)}; b = (f32x4){bf_lo(w.z), bf_hi(w.z), bf_lo(w.w), bf_hi(w.w)}; }
__device__ __forceinline__ float fast_sigmoid(float x) { return __builtin_amdgcn_rcpf(1.0f + __builtin_amdgcn_exp2f(-x * LOG2E)); }
__device__ __forceinline__ float shx(float v, int m) { int z = 0; asm volatile("" : "+v"(z)); const int l = __builtin_amdgcn_mbcnt_hi(~0u, __builtin_amdgcn_mbcnt_lo(~0u, z));
    return __builtin_bit_cast(float, __builtin_amdgcn_ds_bpermute((l ^ m) << 2, __builtin_bit_cast(int, v))); }
__device__ __forceinline__ float wave_sum(float v) {
#pragma unroll
    for (int o = 1; o < 64; o <<= 1) v += shx(v, o);
    return v;
}

namespace pg8 {
constexpr int BM = 256, BK = 64, HALF = 128, HTB = HALF * BK * 2  , STAGE_BYTES = 8 * HTB, NXCD = 8, WGM = 4;
static_assert(WGM * 4 <= 32, "EpiResFinal: a row panel's four owners must share a round");
__host__ __device__ __forceinline__ int lds_byte(int r, int c) { const int st = (r >> 4) * 2 + (c >> 5), rr = r & 15, cc = c & 31, ob = rr * 64 + cc * 2; return st * 1024 + (ob ^ (((ob >> 9) & 1) << 5)); }
__host__ __device__ __forceinline__ void stage_rc(int b, int& R, int& C) { const int st = b / 1024, sb = b % 1024, swz = sb ^ (((sb >> 9) & 1) << 5); R = (st >> 1) * 16 + swz / 64; C = (st & 1) * 32 + (swz % 64) / 2; }
__host__ __device__ __forceinline__ int perm32(int rho) { const int n = rho >> 4, i = rho & 15; return 8 * (i >> 2) + 4 * n + (i & 3); }

struct Unit { int pm, pn; };
struct Dense {
    const bf16_t* A; const bf16_t* Bt; int K, lda, ldb;
    __device__ __forceinline__ const char* aptr(const Unit& u) const { return (const char*)(A + (size_t)u.pm * 256 * lda); }
    __device__ __forceinline__ const char* bptr(const Unit& u) const { return (const char*)(Bt + (size_t)u.pn * 256 * ldb); }
};
struct StaticOrder {
    int nM, nN, nwg, G, c;
    __host__ __device__ void init(int M, int N, int G_, int c_) { nM = M / BM; nN = N / BM; nwg = nM * nN; G = G_; c = c_; }
    __host__ __device__ bool next(int i, Unit& u) const {
        const long L = (long)i * G + c; if (L >= nwg) return false;
        int wgid = (int)L; { const int q = nwg / NXCD, r = nwg % NXCD, xcd = wgid % NXCD, off = wgid / NXCD; wgid = (xcd < r ? xcd * (q + 1) : r * (q + 1) + (xcd - r) * q) + off; }
        const int nig = WGM * nN, gid = wgid / nig, fm = gid * WGM, gsz = (nM - fm) < WGM ? (nM - fm) : WGM;
        u.pm = fm + ((wgid % nig) % gsz); u.pn = (wgid % nig) / gsz; return true;
    }
    __host__ __device__ __forceinline__ int pm_of(int i) const {
        const long L = (long)i * G + c; if (L >= nwg) return -1;
        int wgid = (int)L; { const int q = nwg / NXCD, r = nwg % NXCD, xcd = wgid % NXCD, off = wgid / NXCD; wgid = (xcd < r ? xcd * (q + 1) : r * (q + 1) + (xcd - r) * q) + off; }
        const int nig = WGM * nN, gid = wgid / nig, fm = gid * WGM, gsz = (nM - fm) < WGM ? (nM - fm) : WGM;
        return fm + ((wgid % nig) % gsz);
    }
};

typedef f32x4 Acc[2][2][4][2];

template <class Prob, class Epi, class Sched>
__device__ __forceinline__ void gemm_phase(LAS unsigned char* lds, const Prob& P, const Sched& S, const Epi& E) {
    const int tid = threadIdx.x, wid = __builtin_amdgcn_readfirstlane(tid >> 6), lane = tid & 63, wr = wid >> 2, wc = wid & 3, fr = lane & 15, fq = lane >> 4;
    const int nt = P.K / BK;
    unsigned voffA[2], voffB[2];
#pragma unroll
    for (int i = 0; i < 2; ++i) { int R, C; stage_rc(tid * 16 + i * 8192, R, C); const int Rb = (R & ~31) + perm32(R & 31);
        voffA[i] = (unsigned)(R * P.lda + C) * 2u; voffB[i] = (unsigned)(Rb * P.ldb + C) * 2u; }
    const size_t kstep = (size_t)(BK * 2);
    const size_t hstepA = (size_t)HALF * P.lda * 2, hstepB = (size_t)HALF * P.ldb * 2;
    const unsigned ldsw = (unsigned)wid * 1024u;
    const int aoff = lds_byte(wr * 64 + fr, fq * 8), boff = lds_byte(wc * 32 + fr, fq * 8);
#define PG8_SA(b, h) (((b) * 2 + (h)) * HTB)
#define PG8_SB(b, h) ((4 + (b) * 2 + (h)) * HTB)
#define PG8_STAGE(bufoff, gbase, voff) do { _Pragma("unroll") for (int _i = 0; _i < 2; ++_i) \
        __builtin_amdgcn_global_load_lds((const unsigned*)((const char*)(gbase) + (voff)[_i]), (LAS unsigned*)(lds + (bufoff) + ldsw + _i * 8192), 16, 0, 0); } while (0)
#define PG8_LDA(dst, b, h) do { _Pragma("unroll") for (int m = 0; m < 4; ++m) _Pragma("unroll") for (int k = 0; k < 2; ++k) dst[m][k] = *(const LAS bf16x8*)(lds + PG8_SA(b, h) + aoff + m * 2048 + k * 1024); } while (0)
#define PG8_LDB(dst, b, h) do { _Pragma("unroll") for (int n = 0; n < 2; ++n) _Pragma("unroll") for (int k = 0; k < 2; ++k) dst[n][k] = *(const LAS bf16x8*)(lds + PG8_SB(b, h) + boff + n * 2048 + k * 1024); } while (0)
#define PG8_MMA(ai, bj, At, Bt) do { __builtin_amdgcn_s_setprio(1); _Pragma("unroll") for (int m = 0; m < 4; ++m) _Pragma("unroll") for (int n = 0; n < 2; ++n) _Pragma("unroll") for (int k = 0; k < 2; ++k) \
        acc[ai][bj][m][n] = __builtin_amdgcn_mfma_f32_16x16x32_bf16(Bt[n][k], At[m][k], acc[ai][bj][m][n], 0, 0, 0); __builtin_amdgcn_s_setprio(0); } while (0)
#define PG8_WAIT_V(n) asm volatile("s_waitcnt vmcnt(" #n ")" ::: "memory")
#define PG8_WAIT_L(n) asm volatile("s_waitcnt lgkmcnt(" #n ")" ::: "memory")
#define PG8_BAR __builtin_amdgcn_s_barrier()
#define PG8_SCHED __builtin_amdgcn_sched_barrier(0)
    Unit cur, nxt; int ui = 0;
    if (!S.next(0, cur)) return;
    Acc acc;
#pragma unroll
    for (int a = 0; a < 2; ++a)
#pragma unroll
        for (int b = 0; b < 2; ++b)
#pragma unroll
            for (int m = 0; m < 4; ++m)
#pragma unroll
                for (int n = 0; n < 2; ++n) acc[a][b][m][n] = (f32x4){0.f, 0.f, 0.f, 0.f};
    bf16x8 At[4][2], B0[2][2], B1[2][2];
    const char* cA = P.aptr(cur); const char* cB = P.bptr(cur);
    PG8_STAGE(PG8_SB(0, 0), cB, voffB); PG8_STAGE(PG8_SB(0, 1), cB + hstepB, voffB); PG8_STAGE(PG8_SA(0, 0), cA, voffA); PG8_STAGE(PG8_SA(0, 1), cA + hstepA, voffA);
    if (wr == 1) PG8_BAR;
    PG8_WAIT_V(2); PG8_BAR;
    PG8_STAGE(PG8_SB(1, 0), cB + kstep, voffB); PG8_STAGE(PG8_SA(1, 0), cA + kstep, voffA); PG8_STAGE(PG8_SB(1, 1), cB + hstepB + kstep, voffB);
    PG8_WAIT_V(6); PG8_BAR;
    for (;;) {
        const bool has_next = S.next(ui + 1, nxt);
        const char* nA = has_next ? P.aptr(nxt) : cA; const char* nB = has_next ? P.bptr(nxt) : cB;
        for (int t = 0; t < nt; t += 2) {
            const bool last = (t == nt - 2);
            const char* a1 = cA + (size_t)(t + 1) * kstep;
            const char* a2 = last ? nA : cA + (size_t)(t + 2) * kstep; const char* b2 = last ? nB : cB + (size_t)(t + 2) * kstep;
            const char* a3 = a2 + kstep; const char* b3 = b2 + kstep;
            PG8_LDB(B0, 0, 0); PG8_LDB(B1, 0, 1); PG8_SCHED; PG8_LDA(At, 0, 0); PG8_STAGE(PG8_SA(1, 1), a1 + hstepA, voffA);
            PG8_WAIT_V(8); PG8_WAIT_L(0); PG8_BAR; PG8_MMA(0, 0, At, B0); PG8_MMA(0, 1, At, B1); PG8_BAR; PG8_SCHED;
            PG8_LDA(At, 0, 1); PG8_STAGE(PG8_SB(0, 0), b2, voffB); PG8_STAGE(PG8_SB(0, 1), b2 + hstepB, voffB); PG8_STAGE(PG8_SA(0, 0), a2, voffA);
            PG8_WAIT_V(8); PG8_WAIT_L(0); PG8_BAR; PG8_MMA(1, 0, At, B0); PG8_MMA(1, 1, At, B1); PG8_BAR; PG8_SCHED;
            PG8_LDB(B0, 1, 0); PG8_LDB(B1, 1, 1); PG8_SCHED; PG8_LDA(At, 1, 0); PG8_STAGE(PG8_SA(0, 1), a2 + hstepA, voffA);
            PG8_WAIT_V(8); PG8_WAIT_L(0); PG8_BAR; PG8_MMA(0, 0, At, B0); PG8_MMA(0, 1, At, B1); PG8_BAR; PG8_SCHED;
            PG8_LDA(At, 1, 1); PG8_STAGE(PG8_SB(1, 0), b3, voffB); PG8_STAGE(PG8_SB(1, 1), b3 + hstepB, voffB); PG8_STAGE(PG8_SA(1, 0), a3, voffA);
            PG8_WAIT_V(8); PG8_WAIT_L(0); PG8_BAR; PG8_MMA(1, 0, At, B0); PG8_MMA(1, 1, At, B1); PG8_BAR; PG8_SCHED;
        }
        if (wr == 0) PG8_BAR;
        E(acc, cur, wr, wc, fr, fq);
        if (!has_next) break;
#pragma unroll
        for (int a = 0; a < 2; ++a)
#pragma unroll
            for (int b = 0; b < 2; ++b)
#pragma unroll
                for (int m = 0; m < 4; ++m)
#pragma unroll
                    for (int n = 0; n < 2; ++n) acc[a][b][m][n] = (f32x4){0.f, 0.f, 0.f, 0.f};
        cur = nxt; cA = nA; cB = nB; ++ui;
        if (wr == 1) PG8_BAR;
    }
    PG8_WAIT_V(0);
    PG8_BAR;
#undef PG8_SA
#undef PG8_SB
#undef PG8_STAGE
#undef PG8_LDA
#undef PG8_LDB
#undef PG8_MMA
#undef PG8_WAIT_V
#undef PG8_WAIT_L
#undef PG8_BAR
#undef PG8_SCHED
}

struct SplitCtx { float* slabs; unsigned* cnt; volatile LAS unsigned* flag; };
struct Piece { int pm, pn, k0, nk, split, slot, uid; };
__device__ __forceinline__ bool piece_of(int N, int K, int G, int c, int split, int coff, Piece& p) {
    const int nN = N / BM, j = (c + coff) % G, un = j / split; p.slot = j % split; p.uid = un; p.pm = 128 + un / nN; p.pn = un % nN; p.nk = K / BK / split; p.k0 = p.slot * p.nk; p.split = split;
    return j < 2 * nN * split;
}
__device__ __forceinline__ bool piece_of_mem(int G, int c, int split, int coff, Piece& p) {
    const int j = (c + coff) % G, un = j / split; p.slot = j % split; p.uid = un; p.pm = 128 + (un >> 2); p.pn = un & 3; p.nk = 16 / split; p.k0 = p.slot * p.nk; p.split = split;
    return j < 32 * split;
}
template <class Prob, class Epi>
__device__ __forceinline__ void gemm_piece(LAS unsigned char* lds, const Prob& P, const Epi& E, const Piece pc, const SplitCtx X) {
    int tid_ = threadIdx.x; asm volatile("" : "+v"(tid_));
    const int tid = tid_, wid = __builtin_amdgcn_readfirstlane(tid >> 6), lane = tid & 63, wr = wid >> 2, wc = wid & 3, fr = lane & 15, fq = lane >> 4;
    unsigned voffA[2], voffB[2];
#pragma unroll
    for (int i = 0; i < 2; ++i) { int R, C; stage_rc(tid * 16 + i * 8192, R, C); const int Rb = (R & ~31) + perm32(R & 31);
        voffA[i] = (unsigned)(R * P.lda + C) * 2u; voffB[i] = (unsigned)(Rb * P.ldb + C) * 2u; }
    const size_t kstep = (size_t)(BK * 2);
    const size_t hstepA = (size_t)HALF * P.lda * 2, hstepB = (size_t)HALF * P.ldb * 2;
    const unsigned ldsw = (unsigned)wid * 1024u;
    const int aoff = lds_byte(wr * 64 + fr, fq * 8), boff = lds_byte(wc * 32 + fr, fq * 8);
#define PG8_SA(b, h) (((b) * 2 + (h)) * HTB)
#define PG8_SB(b, h) ((4 + (b) * 2 + (h)) * HTB)
#define PG8_STAGE(bufoff, gbase, voff) do { _Pragma("unroll") for (int _i = 0; _i < 2; ++_i) \
        __builtin_amdgcn_global_load_lds((const unsigned*)((const char*)(gbase) + (voff)[_i]), (LAS unsigned*)(lds + (bufoff) + ldsw + _i * 8192), 16, 0, 0); } while (0)
#define PG8_LDA(dst, b, h) do { _Pragma("unroll") for (int m = 0; m < 4; ++m) _Pragma("unroll") for (int k = 0; k < 2; ++k) dst[m][k] = *(const LAS bf16x8*)(lds + PG8_SA(b, h) + aoff + m * 2048 + k * 1024); } while (0)
#define PG8_LDB(dst, b, h) do { _Pragma("unroll") for (int n = 0; n < 2; ++n) _Pragma("unroll") for (int k = 0; k < 2; ++k) dst[n][k] = *(const LAS bf16x8*)(lds + PG8_SB(b, h) + boff + n * 2048 + k * 1024); } while (0)
#define PG8_MMA(ai, bj, At, Bt) do { __builtin_amdgcn_s_setprio(1); _Pragma("unroll") for (int m = 0; m < 4; ++m) _Pragma("unroll") for (int n = 0; n < 2; ++n) _Pragma("unroll") for (int k = 0; k < 2; ++k) \
        acc[ai][bj][m][n] = __builtin_amdgcn_mfma_f32_16x16x32_bf16(Bt[n][k], At[m][k], acc[ai][bj][m][n], 0, 0, 0); __builtin_amdgcn_s_setprio(0); } while (0)
#define PG8_WAIT_V(n) asm volatile("s_waitcnt vmcnt(" #n ")" ::: "memory")
#define PG8_WAIT_L(n) asm volatile("s_waitcnt lgkmcnt(" #n ")" ::: "memory")
#define PG8_BAR __builtin_amdgcn_s_barrier()
#define PG8_SCHED __builtin_amdgcn_sched_barrier(0)
    Unit cur; cur.pm = pc.pm; cur.pn = pc.pn;
    Acc acc;
#pragma unroll
    for (int a = 0; a < 2; ++a)
#pragma unroll
        for (int b = 0; b < 2; ++b)
#pragma unroll
            for (int m = 0; m < 4; ++m)
#pragma unroll
                for (int n = 0; n < 2; ++n) acc[a][b][m][n] = (f32x4){0.f, 0.f, 0.f, 0.f};
    {
    bf16x8 At[4][2], B0[2][2], B1[2][2];
    const char* cA = P.aptr(cur) + (size_t)pc.k0 * kstep; const char* cB = P.bptr(cur) + (size_t)pc.k0 * kstep;
    PG8_STAGE(PG8_SB(0, 0), cB, voffB); PG8_STAGE(PG8_SB(0, 1), cB + hstepB, voffB); PG8_STAGE(PG8_SA(0, 0), cA, voffA); PG8_STAGE(PG8_SA(0, 1), cA + hstepA, voffA);
    if (wr == 1) PG8_BAR;
    PG8_WAIT_V(2); PG8_BAR;
    PG8_STAGE(PG8_SB(1, 0), cB + kstep, voffB); PG8_STAGE(PG8_SA(1, 0), cA + kstep, voffA); PG8_STAGE(PG8_SB(1, 1), cB + hstepB + kstep, voffB);
    PG8_WAIT_V(6); PG8_BAR;
    const int nt = pc.nk;
    for (int t = 0; t < nt; t += 2) {
        const bool last = (t == nt - 2);
        const char* a1 = cA + (size_t)(t + 1) * kstep;
        const char* a2 = last ? cA : cA + (size_t)(t + 2) * kstep; const char* b2 = last ? cB : cB + (size_t)(t + 2) * kstep;
        const char* a3 = a2 + kstep; const char* b3 = b2 + kstep;
        PG8_LDB(B0, 0, 0); PG8_LDB(B1, 0, 1); PG8_SCHED; PG8_LDA(At, 0, 0); PG8_STAGE(PG8_SA(1, 1), a1 + hstepA, voffA);
        PG8_WAIT_V(8); PG8_WAIT_L(0); PG8_BAR; PG8_MMA(0, 0, At, B0); PG8_MMA(0, 1, At, B1); PG8_BAR; PG8_SCHED;
        PG8_LDA(At, 0, 1); PG8_STAGE(PG8_SB(0, 0), b2, voffB); PG8_STAGE(PG8_SB(0, 1), b2 + hstepB, voffB); PG8_STAGE(PG8_SA(0, 0), a2, voffA);
        PG8_WAIT_V(8); PG8_WAIT_L(0); PG8_BAR; PG8_MMA(1, 0, At, B0); PG8_MMA(1, 1, At, B1); PG8_BAR; PG8_SCHED;
        PG8_LDB(B0, 1, 0); PG8_LDB(B1, 1, 1); PG8_SCHED; PG8_LDA(At, 1, 0); PG8_STAGE(PG8_SA(0, 1), a2 + hstepA, voffA);
        PG8_WAIT_V(8); PG8_WAIT_L(0); PG8_BAR; PG8_MMA(0, 0, At, B0); PG8_MMA(0, 1, At, B1); PG8_BAR; PG8_SCHED;
        PG8_LDA(At, 1, 1); PG8_STAGE(PG8_SB(1, 0), b3, voffB); PG8_STAGE(PG8_SB(1, 1), b3 + hstepB, voffB); PG8_STAGE(PG8_SA(1, 0), a3, voffA);
        PG8_WAIT_V(8); PG8_WAIT_L(0); PG8_BAR; PG8_MMA(1, 0, At, B0); PG8_MMA(1, 1, At, B1); PG8_BAR; PG8_SCHED;
    }
    if (wr == 0) PG8_BAR;
    }
    float* ubase = X.slabs + (size_t)pc.uid * pc.split * 65536;
    const __amdgpu_buffer_rsrc_t rs = __builtin_amdgcn_make_buffer_rsrc((void*)ubase, (short)0, pc.split * 262144, 0x00020000);
    { const int so = pc.slot * 262144;
#pragma unroll
      for (int a = 0; a < 2; ++a)
#pragma unroll
          for (int b = 0; b < 2; ++b)
#pragma unroll
              for (int m = 0; m < 4; ++m)
#pragma unroll
                  for (int n = 0; n < 2; ++n) __builtin_amdgcn_raw_buffer_store_b128(__builtin_bit_cast(u32x4, acc[a][b][m][n]), rs, tid * 16, so + ((((a * 2 + b) * 4 + m) * 2 + n) * 8192), 16); }
    asm volatile("s_waitcnt vmcnt(0)" ::: "memory"); __syncthreads();
    if (tid == 0) { (void)__hip_atomic_fetch_add(X.cnt + pc.uid, 1u, __ATOMIC_RELAXED, __HIP_MEMORY_SCOPE_AGENT);
        unsigned sp = 0u; while (__hip_atomic_load(X.cnt + pc.uid, __ATOMIC_RELAXED, __HIP_MEMORY_SCOPE_AGENT) < (unsigned)pc.split) { __builtin_amdgcn_s_sleep(2); if (++sp > (1u << 22)) break; } }
    __syncthreads();
    const int gsz = 8 / pc.split, g0 = pc.slot * gsz;
    const unsigned rowmask = ((1u << gsz) - 1u) << g0;
#pragma unroll
    for (int a = 0; a < 2; ++a)
#pragma unroll
        for (int b = 0; b < 2; ++b)
#pragma unroll
            for (int m = 0; m < 4; ++m)
#pragma unroll
                for (int n = 0; n < 2; ++n) acc[a][b][m][n] = (f32x4){0.f, 0.f, 0.f, 0.f};
    int nsp = pc.split; asm volatile("" : "+s"(nsp));
    for (int s = 0; s < nsp; ++s) {
#pragma unroll
        for (int a = 0; a < 2; ++a)
#pragma unroll
            for (int m = 0; m < 4; ++m)
                if ((rowmask >> (a * 4 + m)) & 1u) {
#pragma unroll
                    for (int b = 0; b < 2; ++b)
#pragma unroll
                        for (int n = 0; n < 2; ++n) acc[a][b][m][n] += __builtin_bit_cast(f32x4, __builtin_amdgcn_raw_buffer_load_b128(rs, tid * 16, s * 262144 + ((((a * 2 + b) * 4 + m) * 2 + n) * 8192), 16));
                }
    }
    E(acc, cur, wr, wc, fr, fq, rowmask);
    return;
    E(acc, cur, wr, wc, fr, fq);
#undef PG8_SA
#undef PG8_SB
#undef PG8_STAGE
#undef PG8_LDA
#undef PG8_LDB
#undef PG8_MMA
#undef PG8_WAIT_V
#undef PG8_WAIT_L
#undef PG8_BAR
#undef PG8_SCHED
}
}

constexpr size_t MiB = 1u << 20;
constexpr size_t UB = (size_t)MT * 1024 * 2;
constexpr size_t WS_CTL = 0, CTL_ZERO_BYTES = 64 * 1024;
constexpr size_t WS_TAB = 1 * MiB;
constexpr size_t WS_RSTD0 = 2 * MiB;
constexpr size_t WS_RQ = WS_RSTD0 + 256 * 1024;
constexpr size_t WS_RSTDM = WS_RQ + 256 * 1024;
constexpr size_t WS_ST1 = 3 * MiB;
constexpr size_t WS_ST2 = WS_ST1 + 2304 * 1024;
constexpr size_t WS_ST3 = WS_ST2 + 2304 * 1024;
constexpr size_t WS_W = 12 * MiB;
constexpr size_t WS_WIN = WS_W;
constexpr size_t WS_WCO = WS_WIN + (size_t)NINP * 1024 * 2;
constexpr size_t WS_WUQ = WS_WCO + 2 * MiB;
constexpr size_t WS_WUKV = WS_WUQ + (size_t)QW * 512 * 2;
constexpr size_t WS_WMO = WS_WUKV + (size_t)KVW * 256 * 2;
constexpr size_t WS_WMX = WS_WMO + 2 * MiB;
constexpr size_t WS_WQM = WS_WMX + 2 * MiB;
constexpr size_t WS_WKV = WS_WQM + 2 * MiB;
constexpr size_t WS_WOM = WS_WKV + 4 * MiB;
constexpr size_t WS_WUP = WS_WOM + 2 * MiB;
constexpr size_t WS_WDN = WS_WUP + 8 * MiB;
constexpr size_t WS_WEND = WS_WDN + 8 * MiB;
constexpr size_t WS_MB = 57 * MiB;
constexpr size_t WS_MEMK = 61 * MiB;
constexpr size_t WS_MEMV = 69 * MiB;
constexpr size_t WS_CKVB = 77 * MiB;
constexpr size_t WS_KRB = 98 * MiB;
constexpr size_t WS_R1 = 101 * MiB;
constexpr size_t WS_R2 = WS_R1 + UB;
constexpr size_t WS_R3 = WS_R2 + UB;
constexpr size_t WS_R4 = WS_R3 + UB;
constexpr size_t WS_R5 = WS_R4 + UB / 2;
constexpr size_t WS_R6 = WS_R5 + UB / 4;
constexpr size_t WS_R7 = WS_R6 + UB;
constexpr size_t WS_R8 = WS_R7 + UB;
constexpr size_t WS_END = WS_R8 + (size_t)MT * 32 * 2;
constexpr size_t WS_WP = WS_R2, WS_VP = WS_R2 + 32 * MiB;
static_assert(64 * MiB <= UB, "Wp | Vp fit R2");
constexpr size_t WS_SLAB = 477 * MiB;
static_assert(WS_WEND <= WS_MB && WS_END <= WS_SLAB && WS_SLAB + 32 * MiB <= 512 * MiB, "d_ws map");
static_assert(WS_R2 + (size_t)KVROWS * KVW * 2 <= WS_R5, "kv overlays v | g | cq");
static_assert(WS_R2 + 4 * UB <= 512 * MiB, "hmid");

constexpr size_t OUT_Y = 0;
constexpr size_t OUT_CONVP = (size_t)MT * 1024;
constexpr size_t OUT_CKVP = OUT_CONVP + 16384;
constexpr size_t OUT_KRP = OUT_CKVP + (size_t)MP * 256;
constexpr size_t OUT_MEMK = OUT_KRP + (size_t)MP * 32;
constexpr size_t OUT_MEMV = OUT_MEMK + 2097152;
constexpr size_t OUT_CONVS = OUT_MEMV + 2097152;
constexpr size_t OUT_CKVS = OUT_CONVS + 16384;
constexpr size_t OUT_KRS = OUT_CKVS + (size_t)MS * 256;
constexpr size_t OUT_TOTAL = OUT_KRS + (size_t)MS * 32;

constexpr int RING_OFF = 0, RING_BYTES = 131072;
constexpr int SCR_OFF = RING_BYTES;
constexpr int LDSCTL_OFF = SCR_OFF + 8192, MISC_OFF = LDSCTL_OFF + 320;
constexpr int LDS_BYTES = 147456;
constexpr int NWAVES = 8;

#define XB_TMO      128
#define XB_XCNT(j)  (256  + 64 * (j))
#define XB_XSUB(j)  (1280 + 64 * (j))
#define XB_XGEN(j)  (2304 + 64 * (j))
#define XB_TOP      3328
#define XB_TOPGEN   3392
#define XCD_BAR_WORDS 3456
#define XB_SPIN_CAP (1u << 20)
__device__ __forceinline__ unsigned xb_ld(unsigned* p)              { return __hip_atomic_load(p, __ATOMIC_RELAXED, __HIP_MEMORY_SCOPE_AGENT); }
__device__ __forceinline__ unsigned xb_add(unsigned* p, unsigned v) { return __hip_atomic_fetch_add(p, v, __ATOMIC_RELAXED, __HIP_MEMORY_SCOPE_AGENT); }
__device__ __forceinline__ unsigned xb_xcc_id() { return (unsigned)__builtin_amdgcn_s_getreg((3 << 11) | 20) & 0xFu; }
#define XB_SPIN(cond, bar) do { unsigned _sp = 0; while (cond) { __builtin_amdgcn_s_sleep(1); \
    if ((++_sp & 255u) == 0u) { if (xb_ld(&(bar)[XB_TMO])) break; if (_sp > XB_SPIN_CAP) { atomicAdd(&(bar)[XB_TMO], 1u); break; } } } } while (0)
struct XcdBarrier { unsigned* bar; unsigned x; volatile LAS unsigned* st; };
__device__ __forceinline__ XcdBarrier xcd_barrier_post(unsigned* bar, volatile LAS unsigned* st) {
    XcdBarrier b; b.bar = bar; b.x = xb_xcc_id(); b.st = st;
    if (threadIdx.x == 0) (void)xb_add(&bar[XB_XCNT(b.x)], 1u);
    return b;
}
__device__ __forceinline__ void xcd_barrier_complete(unsigned* bar, unsigned x, unsigned& nloc, unsigned& nx) {
    const unsigned G = gridDim.x * gridDim.y * gridDim.z;
    unsigned sum, cnt, mine, sp = 0u;
    for (;;) {
        sum = 0u; cnt = 0u; mine = 0u;
#pragma unroll
        for (unsigned j = 0; j < 16; ++j) { const unsigned c = xb_ld(&bar[XB_XCNT(j)]); sum += c; cnt += (c > 0u) ? 1u : 0u; mine = (j == x) ? c : mine; }
        if (sum == G) break;
        __builtin_amdgcn_s_sleep(1);
        if ((++sp & 255u) == 0u) { if (xb_ld(&bar[XB_TMO])) break; if (sp > XB_SPIN_CAP) { atomicAdd(&bar[XB_TMO], 1u); break; } }
    }
    nloc = mine > 0u ? mine : 1u; nx = cnt > 0u ? cnt : 1u;
}
__device__ __forceinline__ void xcd_barrier(const XcdBarrier& b) {
    asm volatile("s_waitcnt vmcnt(0)" ::: "memory");
    __syncthreads();
    if (threadIdx.x == 0) {
        unsigned* bar = b.bar;
        __builtin_amdgcn_s_waitcnt(0);
        unsigned nloc = b.st[0], nx = b.st[1];
        if (nloc == 0u) { xcd_barrier_complete(bar, b.x, nloc, nx); b.st[0] = nloc; b.st[1] = nx; }
        const unsigned old = xb_add(&bar[XB_XSUB(b.x)], 1u);
        const unsigned gen = old / nloc;
        if (old + 1u == (gen + 1u) * nloc) {
            __builtin_amdgcn_fence(__ATOMIC_RELEASE, "agent");
            asm volatile("s_waitcnt vmcnt(0)" ::: "memory");
            const unsigned og = xb_add(&bar[XB_TOP], 1u);
            const unsigned tg = og / nx;
            if (og + 1u == (tg + 1u) * nx) xb_add(&bar[XB_TOPGEN], 1u);
            else XB_SPIN(xb_ld(&bar[XB_TOPGEN]) == tg, bar);
            __builtin_amdgcn_fence(__ATOMIC_ACQUIRE, "agent");
            xb_add(&bar[XB_XGEN(b.x)], 1u);
            asm volatile("s_waitcnt vmcnt(0)" ::: "memory");
        } else {
            XB_SPIN(xb_ld(&bar[XB_XGEN(b.x)]) == gen, bar);
            __builtin_amdgcn_fence(__ATOMIC_ACQUIRE, "agent");
            asm volatile("s_waitcnt vmcnt(0)" ::: "memory");
        }
    }
    __syncthreads();
}

namespace pg8 {
#define EPI_ROWS(ai, m) (u.pm * 256 + (ai) * 128 + wr * 64 + (m) * 16 + fr)
#define FOR_AI_M _Pragma("unroll") for (int ai = 0; ai < 2; ++ai) _Pragma("unroll") for (int m = 0; m < 4; ++m) if ((rowmask >> (ai * 4 + m)) & 1u)

struct EpiIn {
    const float* rstd0; bf16_t *v, *Bg, *cq, *ckvraw, *sigc, *siga; unsigned rt, pmt;
    static __device__ __forceinline__ void plain(const Acc& acc, bf16_t* dst, int ld, int ai, int m, float rs) {
#pragma unroll
        for (int bj = 0; bj < 2; ++bj) *(u32x4*)(dst + bj * 128) = pack8(acc[ai][bj][m][0] * rs, acc[ai][bj][m][1] * rs);
    }
    static __device__ __forceinline__ void sigm(const Acc& acc, bf16_t* dst, int ai, int m, float rs) {
#pragma unroll
        for (int bj = 0; bj < 2; ++bj) { f32x4 a = acc[ai][bj][m][0] * rs, b = acc[ai][bj][m][1] * rs;
#pragma unroll
            for (int e = 0; e < 4; ++e) { a[e] = fast_sigmoid(a[e]); b[e] = fast_sigmoid(b[e]); }
            *(u32x4*)(dst + bj * 128) = pack8(a, b); }
    }
    __device__ __forceinline__ void operator()(Acc& acc, const Unit& u, int wr, int wc, int fr, int fq, unsigned rowmask = 0xffu) const {
        const int pn = u.pn, cw = wc * 32 + 8 * fq;
        int slot = -1;
#pragma unroll
        for (int k = 0; k < 8; ++k) slot = (*reinterpret_cast<const LAS int*>(pmt + 4 * k) == u.pm) ? k : slot;
        slot = __builtin_amdgcn_readfirstlane(slot);
        const LAS float* rp = reinterpret_cast<const LAS float*>(rt + (unsigned)((slot < 0 ? 0 : slot) * 256 + wr * 64 + fr) * 4u);
        FOR_AI_M {
            const int r = EPI_ROWS(ai, m); const float rs = slot >= 0 ? rp[ai * 128 + m * 16] : rstd0[r];
            if (pn < 8) {
                const float rs2 = rs * rs;
                *(u32x4*)(v + (size_t)r * 1024 + pn * 128 + cw) = pack8(acc[ai][0][m][0] * acc[ai][1][m][0] * rs2, acc[ai][0][m][1] * acc[ai][1][m][1] * rs2);
            } else if (pn < 12) { plain(acc, Bg + (size_t)r * 1024 + (pn - 8) * 256 + cw, 1024, ai, m, rs);
            } else if (pn < 14) { plain(acc, cq + (size_t)r * 512 + (pn - 12) * 256 + cw, 512, ai, m, rs);
            } else if (pn < 15) { plain(acc, ckvraw + (size_t)r * 256 + cw, 256, ai, m, rs);
            } else if (pn < 19) { sigm(acc, sigc + (size_t)r * 1024 + (pn - 15) * 256 + cw, ai, m, rs);
            } else { sigm(acc, siga + (size_t)r * 1024 + (pn - 19) * 256 + cw, ai, m, rs); }
        }
    }
};
struct EpiMemKV {
    const float* rstdm; float *outk, *outv; bf16_t *memk, *memv;
    __device__ __forceinline__ void operator()(Acc& acc, const Unit& u, int wr, int wc, int fr, int fq, unsigned rowmask = 0xffu) const {
        const bool isk = u.pn < 4; const int c0 = (u.pn & 3) * 256 + wc * 32 + 8 * fq; float* out = isk ? outk : outv; bf16_t* cp = isk ? memk : memv;
        FOR_AI_M {
            const int r = EPI_ROWS(ai, m); const float rs = rstdm[r];
#pragma unroll
            for (int bj = 0; bj < 2; ++bj) { const f32x4 a = acc[ai][bj][m][0] * rs, b = acc[ai][bj][m][1] * rs; const size_t off = (size_t)r * 1024 + c0 + bj * 128;
                *(f32x4*)(out + off) = a; *(f32x4*)(out + off + 4) = b; *(u32x4*)(cp + off) = pack8(a, b); }
        }
    }
};
struct EpiGate {
    bf16_t* buf;
    __device__ __forceinline__ void operator()(Acc& acc, const Unit& u, int wr, int wc, int fr, int fq, unsigned rowmask = 0xffu) const {
        const int c0 = u.pn * 256 + wc * 32 + 8 * fq;
        FOR_AI_M { const int r = EPI_ROWS(ai, m);
#pragma unroll
            for (int bj = 0; bj < 2; ++bj) { bf16_t* p = buf + (size_t)r * 1024 + c0 + bj * 128; f32x4 a, b; unpack8(*(const u32x4*)p, a, b);
                *(u32x4*)p = pack8(a * acc[ai][bj][m][0], b * acc[ai][bj][m][1]); } }
    }
};
struct EpiMix {
    const bf16_t* ya; bf16_t* buf;
    __device__ __forceinline__ void operator()(Acc& acc, const Unit& u, int wr, int wc, int fr, int fq, unsigned rowmask = 0xffu) const {
        const int c0 = u.pn * 256 + wc * 32 + 8 * fq;
        FOR_AI_M { const int r = EPI_ROWS(ai, m);
#pragma unroll
            for (int bj = 0; bj < 2; ++bj) { const size_t off = (size_t)r * 1024 + c0 + bj * 128; f32x4 a, b, ya0, ya1; unpack8(*(const u32x4*)(buf + off), a, b); unpack8(*(const u32x4*)(ya + off), ya0, ya1);
                *(u32x4*)(buf + off) = pack8(ya0 + a * acc[ai][bj][m][0], ya1 + b * acc[ai][bj][m][1]); } }
    }
};
struct EpiQ {
    const float* rq; const f32x2* tab; bf16_t* q;
    __device__ __forceinline__ void operator()(Acc& acc, const Unit& u, int wr, int wc, int fr, int fq, unsigned rowmask = 0xffu) const {
        FOR_AI_M {
            const int r = EPI_ROWS(ai, m); const float rs = rq[r];
            const int pos = r < MP ? (r & (SEQ - 1)) : PAST + ((r - MP) & (DSEQ - 1));
#pragma unroll
            for (int bj = 0; bj < 2; ++bj) {
                const int g = u.pn * 8 + bj * 4 + wc;
                f32x4 a = acc[ai][bj][m][0] * rs, b = acc[ai][bj][m][1] * rs;
                if (g % 3 == 2) {
                    const f32x2* t = tab + pos * 16 + 8 * (fq & 1);
                    const float sgn = fq < 2 ? -1.f : 1.f;
#pragma unroll
                    for (int e = 0; e < 4; ++e) { const f32x2 cs0 = t[e], cs1 = t[4 + e];
                        const float pa = shx(a[e], 32), pb = shx(b[e], 32);
                        a[e] = a[e] * cs0.x + sgn * pa * cs0.y; b[e] = b[e] * cs1.x + sgn * pb * cs1.y; }
                }
                *(u32x4*)(q + (size_t)r * QW + g * 32 + 8 * fq) = pack8(a * QSCALE, b * QSCALE);
            }
        }
    }
};
struct EpiPlain {
    bf16_t* out; int ld;
    __device__ __forceinline__ void operator()(Acc& acc, const Unit& u, int wr, int wc, int fr, int fq, unsigned rowmask = 0xffu) const {
        const int c0 = u.pn * 256 + wc * 32 + 8 * fq;
        FOR_AI_M { const int r = EPI_ROWS(ai, m);
#pragma unroll
            for (int bj = 0; bj < 2; ++bj) *(u32x4*)(out + (size_t)r * ld + c0 + bj * 128) = pack8(acc[ai][bj][m][0], acc[ai][bj][m][1]); }
    }
};
struct EpiRes {
    const float* xold_p; const float* xold_s; float* xout; bf16_t* xb; float* stats;
    __device__ __forceinline__ void operator()(Acc& acc, const Unit& u, int wr, int wc, int fr, int fq, unsigned rowmask = 0xffu) const {
        const int c0 = u.pn * 256 + wc * 32 + 8 * fq;
        FOR_AI_M { const int r = EPI_ROWS(ai, m); const float* xo = r < MP ? xold_p + (size_t)r * 1024 : xold_s + (size_t)(r - MP) * 1024; float ss = 0.f;
#pragma unroll
            for (int bj = 0; bj < 2; ++bj) { const int c = c0 + bj * 128; const f32x4 a = *(const f32x4*)(xo + c) + acc[ai][bj][m][0], b = *(const f32x4*)(xo + c + 4) + acc[ai][bj][m][1];
                *(f32x4*)(xout + (size_t)r * 1024 + c) = a; *(f32x4*)(xout + (size_t)r * 1024 + c + 4) = b;
                if (xb) *(u32x4*)(xb + (size_t)r * 1024 + c) = pack8(a, b);
                ss += (a[0] * a[0] + a[1] * a[1]) + (a[2] * a[2] + a[3] * a[3]) + (b[0] * b[0] + b[1] * b[1]) + (b[2] * b[2] + b[3] * b[3]); }
            ss += shx(ss, 16); ss += shx(ss, 32);
            if (fq == 0) stats[(size_t)r * 16 + u.pn * 4 + wc] = ss; }
    }
};
struct EpiResFinal {
    const float* xold_p; const float* xold_s; float* out; float* stats; unsigned* cnt; const float* gfin;
    __device__ __forceinline__ void operator()(Acc& acc, const Unit& u, int wr, int wc, int fr, int fq, unsigned rowmask = 0xffu) const {
        const int c0 = u.pn * 256 + wc * 32 + 8 * fq;
        FOR_AI_M { const int r = EPI_ROWS(ai, m); const float* xo = r < MP ? xold_p + (size_t)r * 1024 : xold_s + (size_t)(r - MP) * 1024; float ss = 0.f;
#pragma unroll
            for (int bj = 0; bj < 2; ++bj) { const int c = c0 + bj * 128; const f32x4 a = *(const f32x4*)(xo + c) + acc[ai][bj][m][0], b = *(const f32x4*)(xo + c + 4) + acc[ai][bj][m][1];
                acc[ai][bj][m][0] = a; acc[ai][bj][m][1] = b;
                ss += (a[0] * a[0] + a[1] * a[1]) + (a[2] * a[2] + a[3] * a[3]) + (b[0] * b[0] + b[1] * b[1]) + (b[2] * b[2] + b[3] * b[3]); }
            ss += shx(ss, 16); ss += shx(ss, 32);
            if (fq == 0) __hip_atomic_store(stats + (size_t)r * 16 + u.pn * 4 + wc, ss, __ATOMIC_RELAXED, __HIP_MEMORY_SCOPE_AGENT); }
        asm volatile("s_waitcnt vmcnt(0)" ::: "memory"); __builtin_amdgcn_s_barrier(); asm volatile("" ::: "memory");
        if (threadIdx.x == 0) { unsigned* cw = cnt + u.pm * 8 + __builtin_ctz(rowmask);
            (void)__hip_atomic_fetch_add(cw, 1u, __ATOMIC_RELAXED, __HIP_MEMORY_SCOPE_AGENT);
            unsigned sp = 0u; while (__hip_atomic_load(cw, __ATOMIC_RELAXED, __HIP_MEMORY_SCOPE_AGENT) < 4u) { __builtin_amdgcn_s_sleep(2); if (++sp > (1u << 22)) break; } }
        asm volatile("s_waitcnt vmcnt(0)" ::: "memory"); __builtin_amdgcn_s_barrier(); asm volatile("" ::: "memory");
        const __amdgpu_buffer_rsrc_t rs = __builtin_amdgcn_make_buffer_rsrc((void*)stats, (short)0, MT * 64, 0x00020000);
        FOR_AI_M { const int r = EPI_ROWS(ai, m);
            const f32x4 s0 = __builtin_bit_cast(f32x4, __builtin_amdgcn_raw_buffer_load_b128(rs, r * 64, 0, 16)), s1 = __builtin_bit_cast(f32x4, __builtin_amdgcn_raw_buffer_load_b128(rs, r * 64 + 16, 0, 16)),
                        s2 = __builtin_bit_cast(f32x4, __builtin_amdgcn_raw_buffer_load_b128(rs, r * 64 + 32, 0, 16)), s3 = __builtin_bit_cast(f32x4, __builtin_amdgcn_raw_buffer_load_b128(rs, r * 64 + 48, 0, 16));
            const float t = ((s0[0] + s0[1]) + (s0[2] + s0[3])) + ((s1[0] + s1[1]) + (s1[2] + s1[3])) + ((s2[0] + s2[1]) + (s2[2] + s2[3])) + ((s3[0] + s3[1]) + (s3[2] + s3[3]));
            const float rsd = __builtin_amdgcn_rsqf(t * (1.0f / 1024.0f) + EPS);
#pragma unroll
            for (int bj = 0; bj < 2; ++bj) { const int c = c0 + bj * 128; const f32x4 g0 = *(const f32x4*)(gfin + c), g1 = *(const f32x4*)(gfin + c + 4);
                *(f32x4*)(out + (size_t)r * 1024 + c) = acc[ai][bj][m][0] * rsd * g0; *(f32x4*)(out + (size_t)r * 1024 + c + 4) = acc[ai][bj][m][1] * rsd * g1; } }
    }
};
__device__ __forceinline__ float row_rstd(const float* stats, int r) {
    const f32x4* s = (const f32x4*)(stats + (size_t)r * 16); const f32x4 a = s[0], b = s[1], c = s[2], d = s[3];
    const float t = ((a[0] + a[1]) + (a[2] + a[3])) + ((b[0] + b[1]) + (b[2] + b[3])) + ((c[0] + c[1]) + (c[2] + c[3])) + ((d[0] + d[1]) + (d[2] + d[3]));
    return __builtin_amdgcn_rsqf(t * (1.0f / 1024.0f) + EPS);
}
template <int ACT> struct EpiNormAct {
    const float* stats; bf16_t* out; int ld; float scale; unsigned rt, pmt;
    __device__ __forceinline__ void operator()(Acc& acc, const Unit& u, int wr, int wc, int fr, int fq, unsigned rowmask = 0xffu) const {
        const int c0 = u.pn * 256 + wc * 32 + 8 * fq;
        int slot = -1;
#pragma unroll
        for (int k = 0; k < 8; ++k) slot = (*reinterpret_cast<const LAS int*>(pmt + 4 * k) == u.pm) ? k : slot;
        slot = __builtin_amdgcn_readfirstlane(slot);
        if (slot >= 0) {
            const LAS float* rp = reinterpret_cast<const LAS float*>(rt + (unsigned)(slot * 256 + wr * 64 + fr) * 4u);
            FOR_AI_M { const int r = EPI_ROWS(ai, m); const float rs = rp[ai * 128 + m * 16] * scale;
#pragma unroll
                for (int bj = 0; bj < 2; ++bj) { f32x4 a = acc[ai][bj][m][0] * rs, b = acc[ai][bj][m][1] * rs;
                    if (ACT == 1) {
#pragma unroll
                        for (int e = 0; e < 4; ++e) { const float x = fmaxf(a[e], 0.f), y = fmaxf(b[e], 0.f); a[e] = x * x; b[e] = y * y; } }
                    *(u32x4*)(out + (size_t)r * ld + c0 + bj * 128) = pack8(a, b); } }
        } else {
            FOR_AI_M { const int r = EPI_ROWS(ai, m); const float rs = row_rstd(stats, r) * scale;
#pragma unroll
                for (int bj = 0; bj < 2; ++bj) { f32x4 a = acc[ai][bj][m][0] * rs, b = acc[ai][bj][m][1] * rs;
                    if (ACT == 1) {
#pragma unroll
                        for (int e = 0; e < 4; ++e) { const float x = fmaxf(a[e], 0.f), y = fmaxf(b[e], 0.f); a[e] = x * x; b[e] = y * y; } }
                    *(u32x4*)(out + (size_t)r * ld + c0 + bj * 128) = pack8(a, b); } }
        }
    }
};

__device__ __forceinline__ int ma_row0(int pm) { return pm < 128 ? pm * 256 : MP + (pm - 128) * DSEQ; }
__device__ __forceinline__ int ma_batch(int pm) { return pm < 128 ? pm >> 4 : 8 + (pm - 128); }
struct ProbMA {
    const bf16_t* A; const bf16_t* W; int K, lda, ldb;
    __device__ __forceinline__ const char* aptr(const Unit& u) const { return (const char*)(A + (size_t)ma_row0(u.pm) * 1024); }
    __device__ __forceinline__ const char* bptr(const Unit& u) const { return (const char*)(W + ((size_t)ma_batch(u.pm) * 1024 + u.pn * 256) * 1024); }
};
struct PreOrder {
    int G, c;
    __device__ __forceinline__ bool next(int i, Unit& u) const { const int L = i * G + c; u.pm = L >> 2; u.pn = L & 3; return c >= 0 && L < 256; }
};
struct ProbWp {
    const bf16_t* memk; const bf16_t* wqg; int K, lda, ldb;
    __device__ __forceinline__ const char* aptr(const Unit& u) const { return (const char*)(memk + (size_t)((u.pm >> 2) * 256) * 1024 + (u.pm & 3) * 256); }
    __device__ __forceinline__ const char* bptr(const Unit& u) const { return (const char*)(wqg + (size_t)(u.pn * 256) * 1024 + (u.pm & 3) * 256); }
};
struct ProbVp {
    const bf16_t* womt; const bf16_t* memv; int K, lda, ldb;
    __device__ __forceinline__ const char* aptr(const Unit& u) const { return (const char*)(womt + (size_t)((u.pm & 3) * 256) * 1024 + u.pn * 256); }
    __device__ __forceinline__ const char* bptr(const Unit& u) const { return (const char*)(memv + (size_t)((u.pm >> 2) * 256) * 1024 + u.pn * 256); }
};
struct EpiSoftmaxS {
    const float* stats; float scale; bf16_t* P; LAS float* scr;
    __device__ __forceinline__ void operator()(Acc& acc, const Unit& u, int wr, int wc, int fr, int fq, unsigned rowmask = 0xffu) const {
        const int row0 = ma_row0(u.pm), valid = u.pm < 128 ? 256 : DSEQ;
        FOR_AI_M { const int lr = ai * 128 + wr * 64 + m * 16 + fr; const int rr = row0 + lr < MT ? row0 + lr : MT - 1; const float rs = row_rstd(stats, rr) * scale; float mx = -3.0e38f;
#pragma unroll
            for (int bj = 0; bj < 2; ++bj)
#pragma unroll
                for (int n = 0; n < 2; ++n) { acc[ai][bj][m][n] = acc[ai][bj][m][n] * rs;
#pragma unroll
                    for (int e = 0; e < 4; ++e) mx = fmaxf(mx, acc[ai][bj][m][n][e]); }
            mx = fmaxf(mx, shx(mx, 16)); mx = fmaxf(mx, shx(mx, 32));
            if (fq == 0) scr[lr * 4 + wc] = mx; }
        asm volatile("s_waitcnt lgkmcnt(0)" ::: "memory"); __builtin_amdgcn_s_barrier(); asm volatile("" ::: "memory");
        FOR_AI_M { const int lr = ai * 128 + wr * 64 + m * 16 + fr; const f32x4 q = *(const LAS f32x4*)(scr + lr * 4); const float mx = fmaxf(fmaxf(q[0], q[1]), fmaxf(q[2], q[3])); float sm = 0.f;
#pragma unroll
            for (int bj = 0; bj < 2; ++bj)
#pragma unroll
                for (int n = 0; n < 2; ++n)
#pragma unroll
                    for (int e = 0; e < 4; ++e) { const float p = __builtin_amdgcn_exp2f(acc[ai][bj][m][n][e] - mx); acc[ai][bj][m][n][e] = p; sm += p; }
            sm += shx(sm, 16); sm += shx(sm, 32);
            if (fq == 0) scr[1024 + lr * 4 + wc] = sm; }
        asm volatile("s_waitcnt lgkmcnt(0)" ::: "memory"); __builtin_amdgcn_s_barrier(); asm volatile("" ::: "memory");
        FOR_AI_M { const int lr = ai * 128 + wr * 64 + m * 16 + fr; const f32x4 q = *(const LAS f32x4*)(scr + 1024 + lr * 4); const float inv = __builtin_amdgcn_rcpf((q[0] + q[1]) + (q[2] + q[3]));
            if (lr < valid) {
#pragma unroll
                for (int bj = 0; bj < 2; ++bj) *(u32x4*)(P + (size_t)(row0 + lr) * 1024 + u.pn * 256 + bj * 128 + wc * 32 + 8 * fq) = pack8(acc[ai][bj][m][0] * inv, acc[ai][bj][m][1] * inv); } }
    }
};
struct EpiResM {
    float* x; bf16_t* xb; float* stats;
    __device__ __forceinline__ void operator()(Acc& acc, const Unit& u, int wr, int wc, int fr, int fq, unsigned rowmask = 0xffu) const {
        const int row0 = ma_row0(u.pm), valid = u.pm < 128 ? 256 : DSEQ; const int c0 = u.pn * 256 + wc * 32 + 8 * fq;
        FOR_AI_M { const int lr = ai * 128 + wr * 64 + m * 16 + fr; const bool ok = lr < valid; const int r = ok ? row0 + lr : row0; float* xr = x + (size_t)r * 1024; float ss = 0.f;
#pragma unroll
            for (int bj = 0; bj < 2; ++bj) { const int c = c0 + bj * 128; const f32x4 a = *(const f32x4*)(xr + c) + acc[ai][bj][m][0], b = *(const f32x4*)(xr + c + 4) + acc[ai][bj][m][1];
                if (ok) { *(f32x4*)(xr + c) = a; *(f32x4*)(xr + c + 4) = b; *(u32x4*)(xb + (size_t)r * 1024 + c) = pack8(a, b); }
                ss += (a[0] * a[0] + a[1] * a[1]) + (a[2] * a[2] + a[3] * a[3]) + (b[0] * b[0] + b[1] * b[1]) + (b[2] * b[2] + b[3] * b[3]); }
            ss += shx(ss, 16); ss += shx(ss, 32);
            if (fq == 0 && ok) stats[(size_t)r * 16 + u.pn * 4 + wc] = ss; }
    }
};
#undef EPI_ROWS
#undef FOR_AI_M
}

namespace attn {
constexpr int NSLOT = 4, NOPE_B = 0, ROPE_B = NSLOT * 8192, V_B = ROPE_B + NSLOT * 4096;
constexpr int QR_OFF = V_B + NSLOT * 8192;
__device__ __forceinline__ void glds16(const void* sbase, unsigned voff, unsigned lds_dst) { unsigned keep;
    asm volatile("s_mov_b32 %0, m0\n\ts_mov_b32 m0, %3\n\ts_nop 0\n\tglobal_load_lds_dwordx4 %1, %2\n\ts_mov_b32 m0, %0" : "=&s"(keep) : "v"(voff), "s"(sbase), "s"(lds_dst) : "memory"); }
__device__ __forceinline__ s16x4 vtr(const LAS unsigned char* p) { return __builtin_bit_cast(s16x4, __builtin_amdgcn_ds_read_tr16_b64_v4i16((LAS s16x4*)p)); }
struct Unit { int qrow0, kvrow0, h, ntiles, lim_base, lim_step, nwq; };

__device__ __forceinline__ float row_max32(const f32x16& p0, const f32x16& p1) {
    float a = fmaxf(fmaxf(p0[0], p0[1]), p1[0]), b = fmaxf(fmaxf(p0[2], p0[3]), p1[1]); a = fmaxf(fmaxf(a, p1[2]), p1[3]);
#pragma unroll
    for (int r = 4; r < 16; r += 4) { a = fmaxf(fmaxf(a, p0[r]), p0[r + 1]); b = fmaxf(fmaxf(b, p0[r + 2]), p0[r + 3]); a = fmaxf(fmaxf(a, p1[r]), p1[r + 1]); b = fmaxf(fmaxf(b, p1[r + 2]), p1[r + 3]); }
    const float m = fmaxf(a, b);
    auto rr = __builtin_amdgcn_permlane32_swap(__float_as_uint(m), __float_as_uint(m), false, false);
    return fmaxf(__uint_as_float(rr[0]), __uint_as_float(rr[1]));
}
__device__ __forceinline__ void kfrag(bf16x8& a0, bf16x8& a1, int d0, const unsigned (&ka)[6], int ko) {
    if (d0 < 4) { a0 = *reinterpret_cast<const LAS bf16x8*>(ka[d0] + ko); a1 = *reinterpret_cast<const LAS bf16x8*>(ka[d0] + ko + 32 * 128); }
    else { a0 = *reinterpret_cast<const LAS bf16x8*>(ka[d0] + (ko >> 1)); a1 = *reinterpret_cast<const LAS bf16x8*>(ka[d0] + (ko >> 1) + 32 * 64); }
}
struct NoDma { __device__ __forceinline__ void operator()() const {} };
template <bool DO_QK, class Dma = NoDma>
__device__ __forceinline__ void step(f32x16& pn0, f32x16& pn1, f32x16& pc0, f32x16& pc1, f32x16& o0, f32x16& o1, float& lrun, const bf16x8 qmf, const bf16x8 kneg,
                                     const unsigned (&ka)[6], int ko, const LAS unsigned char* vb, const bf16x8 (&qf)[4], const LAS unsigned char* qr, const Dma& dma = Dma()) {
    bf16x8 fa[2][2];
    if (DO_QK) kfrag(fa[0][0], fa[0][1], 0, ka, ko);
    __builtin_amdgcn_s_setprio(1);
#pragma unroll
    for (int d0 = 0; d0 < 6; ++d0) {
        if (DO_QK) {
            if (d0 + 1 < 6) kfrag(fa[(d0 + 1) & 1][0], fa[(d0 + 1) & 1][1], d0 + 1, ka, ko);
            const bf16x8 qd = d0 < 4 ? qf[d0 < 4 ? d0 : 0] : *(const LAS bf16x8*)(qr + (d0 - 4) * 16);
            if (d0 == 0) { const f32x16 z = {}; pn0 = __builtin_amdgcn_mfma_f32_32x32x16_bf16(fa[0][0], qd, z, 0, 0, 0); pn1 = __builtin_amdgcn_mfma_f32_32x32x16_bf16(fa[0][1], qd, z, 0, 0, 0); }
            else { pn0 = __builtin_amdgcn_mfma_f32_32x32x16_bf16(fa[d0 & 1][0], qd, pn0, 0, 0, 0); pn1 = __builtin_amdgcn_mfma_f32_32x32x16_bf16(fa[d0 & 1][1], qd, pn1, 0, 0, 0); }
        }
        if (d0 == 1) dma();
#pragma unroll
        for (int r = (16 * d0) / 6; r < (16 * (d0 + 1)) / 6; ++r) { pc0[r] = __builtin_amdgcn_exp2f(pc0[r]); pc1[r] = __builtin_amdgcn_exp2f(pc1[r]); }
        asm volatile("" ::: "memory");
    }
    if (DO_QK) {
        pn0 = __builtin_amdgcn_mfma_f32_32x32x16_bf16(kneg, qmf, pn0, 0, 0, 0); pn1 = __builtin_amdgcn_mfma_f32_32x32x16_bf16(kneg, qmf, pn1, 0, 0, 0); }
    { float one = 1.0f; asm volatile("" : "+s"(one));
      float sa = pc0[0], sb = pc1[0];
#pragma unroll
      for (int r = 1; r < 16; ++r) { sa = sa + pc0[r]; sb = __builtin_fmaf(pc1[r], one, sb); }
      lrun += sa + sb; }
    u32x4 pw[4];
    pw[0] = (u32x4){cvt_pk_bf16(pc0[0], pc0[1]), cvt_pk_bf16(pc0[2], pc0[3]), cvt_pk_bf16(pc0[4], pc0[5]), cvt_pk_bf16(pc0[6], pc0[7])};
    pw[1] = (u32x4){cvt_pk_bf16(pc0[8], pc0[9]), cvt_pk_bf16(pc0[10], pc0[11]), cvt_pk_bf16(pc0[12], pc0[13]), cvt_pk_bf16(pc0[14], pc0[15])};
    pw[2] = (u32x4){cvt_pk_bf16(pc1[0], pc1[1]), cvt_pk_bf16(pc1[2], pc1[3]), cvt_pk_bf16(pc1[4], pc1[5]), cvt_pk_bf16(pc1[6], pc1[7])};
    pw[3] = (u32x4){cvt_pk_bf16(pc1[8], pc1[9]), cvt_pk_bf16(pc1[10], pc1[11]), cvt_pk_bf16(pc1[12], pc1[13]), cvt_pk_bf16(pc1[14], pc1[15])};
    s16x4 vl[2][4];
    vl[0][0] = vtr(vb); vl[0][1] = vtr(vb + 512); vl[0][2] = vtr(vb + 4096); vl[0][3] = vtr(vb + 4096 + 512);
#pragma unroll
    for (int ks = 0; ks < 4; ++ks) {
        if (ks + 1 < 4) { const int n = (ks + 1) & 1; vl[n][0] = vtr(vb + (ks + 1) * 1024); vl[n][1] = vtr(vb + (ks + 1) * 1024 + 512); vl[n][2] = vtr(vb + 4096 + (ks + 1) * 1024); vl[n][3] = vtr(vb + 4096 + (ks + 1) * 1024 + 512); }
        const int c = ks & 1; const bf16x8 pb = __builtin_bit_cast(bf16x8, pw[ks]);
        const bf16x8 v0 = (bf16x8){vl[c][0][0], vl[c][0][1], vl[c][0][2], vl[c][0][3], vl[c][1][0], vl[c][1][1], vl[c][1][2], vl[c][1][3]};
        const bf16x8 v1 = (bf16x8){vl[c][2][0], vl[c][2][1], vl[c][2][2], vl[c][2][3], vl[c][3][0], vl[c][3][1], vl[c][3][2], vl[c][3][3]};
        o0 = __builtin_amdgcn_mfma_f32_32x32x16_bf16(v0, pb, o0, 0, 0, 0);
        o1 = __builtin_amdgcn_mfma_f32_32x32x16_bf16(v1, pb, o1, 0, 0, 0);
        asm volatile("" ::: "memory");
    }
    __builtin_amdgcn_s_setprio(0);
}
__device__ __forceinline__ bf16x8 mfrag(float m, int hi) {
    const unsigned h = cvt_pk_bf16(m, 0.f) & 0xffffu; const float mh = __builtin_bit_cast(float, h << 16); const unsigned l = cvt_pk_bf16(m - mh, 0.f) & 0xffffu;
    const unsigned w = hi ? 0u : (h | (l << 16));
    return __builtin_bit_cast(bf16x8, (u32x4){w, 0u, 0u, 0u});
}
constexpr float ATT_BIG = 1099511627776.0f;
__device__ __forceinline__ void rebase(f32x16& p0, f32x16& p1, f32x16& o0, f32x16& o1, float& lrun, float& mrun, bf16x8& qmf, int hi) {
    if (__builtin_amdgcn_ballot_w64(lrun > ATT_BIG) != 0ull) {
        auto rr = __builtin_amdgcn_permlane32_swap(__float_as_uint(lrun), __float_as_uint(lrun), false, false);
        const float lt = __uint_as_float(rr[0]) + __uint_as_float(rr[1]);
        const int e = __builtin_amdgcn_frexp_expf(lt) - 1;
        const int d = e > 0 ? e : 0; const float delta = (float)d, alpha = __builtin_amdgcn_ldexpf(1.0f, -d); mrun += delta; lrun *= alpha; qmf = mfrag(mrun, hi);
#pragma unroll
        for (int r = 0; r < 16; ++r) { p0[r] -= delta; p1[r] -= delta; o0[r] *= alpha; o1[r] *= alpha; }
    }
}
__device__ __forceinline__ void unit(const Unit& U, const bf16_t* __restrict__ Q, const bf16_t* __restrict__ KV, const bf16_t* __restrict__ KR, bf16_t* __restrict__ O, LAS unsigned char* lds) {
    int tid_ = threadIdx.x; asm volatile("" : "+v"(tid_));
    const int tid = tid_, lane = tid & 63, r32 = lane & 31, hi = lane >> 5; const int wid = __builtin_amdgcn_readfirstlane(tid >> 6);
    const bool active = wid < U.nwq; const int mylim = active ? U.lim_base + (wid >> 1) * U.lim_step : 0;
    const int nr = wid * 8 + (lane >> 3), rr = wid * 8 + ((lane & 31) >> 2), vr = 16 * (wid & 3) + (lane >> 2);
    const unsigned voffN = (unsigned)(((U.kvrow0 + nr) * KVW + U.h * 128 + 8 * ((lane & 7) ^ ((nr >> 1) & 7))) * 2);
    const unsigned voffR = (unsigned)(((U.kvrow0 + rr) * 32 + 8 * ((lane & 3) ^ ((rr >> 2) & 3))) * 2);
    const unsigned voffV = (unsigned)(((U.kvrow0 + vr) * KVW + U.h * 128 + 64 + (wid >> 2) * 32 + 8 * (lane & 3)) * 2);
    const unsigned lds0 = (unsigned)(size_t)lds;
#define ATT_DMAS(t, s) do { if (wid < 4) { const char* kvb_ = (const char*)KV + (size_t)(t) * (64 * KVW * 2); const char* krb_ = (const char*)KR + (size_t)(t) * (64 * 32 * 2); \
          \
          \
        glds16(kvb_, voffN, (unsigned)__builtin_amdgcn_readfirstlane(lds0 + NOPE_B + (s) * 8192 + wid * 1024)); \
        glds16(kvb_ + 32 * KVW * 2, voffN, (unsigned)__builtin_amdgcn_readfirstlane(lds0 + NOPE_B + (s) * 8192 + (wid + 4) * 1024)); \
        glds16(kvb_, voffV, (unsigned)__builtin_amdgcn_readfirstlane(lds0 + V_B + (s) * 8192 + wid * 1024)); \
        glds16(kvb_ + 64, voffV, (unsigned)__builtin_amdgcn_readfirstlane(lds0 + V_B + (s) * 8192 + (wid + 4) * 1024)); \
        if (lane < 32) { glds16(krb_, voffR, (unsigned)__builtin_amdgcn_readfirstlane(lds0 + ROPE_B + (s) * 4096 + wid * 512)); \
                         glds16(krb_ + 32 * 64, voffR, (unsigned)__builtin_amdgcn_readfirstlane(lds0 + ROPE_B + (s) * 4096 + (wid + 4) * 512)); } } } while (0)
#define ATT_DMA(t) ATT_DMAS(t, (t) & 3)
    ATT_DMA(0); ATT_DMA(1); ATT_DMA(2);
    bf16x8 qf[4], qr4 = (bf16x8){0, 0, 0, 0, 0, 0, 0, 0}, qr5 = qr4;
    if (active) {
        const bf16_t* qp = Q + (size_t)(U.qrow0 + wid * 32 + r32) * QW + U.h * 96 + hi * 8;
#pragma unroll
        for (int d0 = 0; d0 < 4; ++d0) qf[d0] = *(const bf16x8*)(qp + d0 * 16);
        qr4 = *(const bf16x8*)(qp + 64); qr5 = *(const bf16x8*)(qp + 80);
    } else {
#pragma unroll
        for (int d0 = 0; d0 < 4; ++d0) qf[d0] = (bf16x8){0, 0, 0, 0, 0, 0, 0, 0};
    }
    const LAS unsigned char* qr = lds + QR_OFF + tid * 32;
    *(LAS bf16x8*)(lds + QR_OFF + tid * 32) = qr4; *(LAS bf16x8*)(lds + QR_OFF + tid * 32 + 16) = qr5;
    float mrun = 0.f, lrun = 0.f; f32x16 o0 = {}, o1 = {}, pA0 = {}, pA1 = {}, pB0 = {}, pB1 = {};
    bf16x8 qmf = (bf16x8){0, 0, 0, 0, 0, 0, 0, 0}; const bf16x8 kneg = __builtin_bit_cast(bf16x8, (u32x4){hi ? 0u : 0xBF80BF80u, 0u, 0u, 0u});
    unsigned ka[6];
    { const int xn = ((r32 >> 1) & 7) << 4, xr = ((r32 >> 2) & 3) << 4, hb = hi << 4;
#pragma unroll
      for (int d0 = 0; d0 < 6; ++d0) { unsigned a_ = d0 < 4 ? lds0 + NOPE_B + r32 * 128 + ((d0 * 32 + hb) ^ xn) : lds0 + ROPE_B + r32 * 64 + (((d0 - 4) * 32 + hb) ^ xr); asm volatile("" : "+v"(a_)); ka[d0] = a_; } }
    const int vfo = V_B + (4 * hi + ((lane & 15) >> 2)) * 64 + ((lane >> 4) & 1) * 32 + (lane & 3) * 8;
#define ATT_HEADX(t) do { asm volatile("s_waitcnt vmcnt(6) lgkmcnt(0)\n\ts_barrier" ::: "memory"); ATT_DMA((t) + 3); } while (0)
#define ATT_HEAD(t) do { if ((t) + 2 < U.ntiles) asm volatile("s_waitcnt vmcnt(6) lgkmcnt(0)\n\ts_barrier" ::: "memory"); else asm volatile("s_waitcnt vmcnt(0) lgkmcnt(0)\n\ts_barrier" ::: "memory"); \
        if ((t) + 3 < U.ntiles) ATT_DMA((t) + 3); } while (0)
#define ATT_FULLS(PC0, PC1, PN0, PN1, s0, s1) do { \
        step<true>(PN0, PN1, PC0, PC1, o0, o1, lrun, qmf, kneg, ka, (s1) * 8192, lds + (s0) * 8192 + vfo, qf, qr); rebase(PN0, PN1, o0, o1, lrun, mrun, qmf, hi); } while (0)
#define ATT_BARX asm volatile("s_waitcnt vmcnt(6) lgkmcnt(0)\n\ts_barrier" ::: "memory")
#define ATT_FULLD(PC0, PC1, PN0, PN1, s0, s1, td, sd) do { auto dma_ = [&]() { ATT_DMAS(td, sd); }; \
        step<true>(PN0, PN1, PC0, PC1, o0, o1, lrun, qmf, kneg, ka, (s1) * 8192, lds + (s0) * 8192 + vfo, qf, qr, dma_); rebase(PN0, PN1, o0, o1, lrun, mrun, qmf, hi); } while (0)
#define ATT_FULL(PC0, PC1, PN0, PN1, j) ATT_FULLS(PC0, PC1, PN0, PN1, (j) & 3, ((j) + 1) & 3)
#define ATT_LAST(PC0, PC1, PN0, PN1, j) do { const int s0_ = (j) & 3; \
        step<false>(PN0, PN1, PC0, PC1, o0, o1, lrun, qmf, kneg, ka, 0, lds + s0_ * 8192 + vfo, qf, qr); } while (0)
#define ATT_HEADS(t, s) do { asm volatile("s_waitcnt vmcnt(6) lgkmcnt(0)\n\ts_barrier" ::: "memory"); ATT_DMAS((t) + 3, s); } while (0)
    ATT_HEAD(0);
    int j = 1;
    if (0 < mylim) {
        {
#pragma unroll
            for (int d0 = 0; d0 < 6; ++d0) { bf16x8 a0_, a1_; kfrag(a0_, a1_, d0, ka, 0); const bf16x8 qd_ = d0 < 4 ? qf[d0 < 4 ? d0 : 0] : (d0 == 4 ? qr4 : qr5);
                pA0 = __builtin_amdgcn_mfma_f32_32x32x16_bf16(a0_, qd_, pA0, 0, 0, 0); pA1 = __builtin_amdgcn_mfma_f32_32x32x16_bf16(a1_, qd_, pA1, 0, 0, 0); }
            mrun = row_max32(pA0, pA1); qmf = mfrag(mrun, hi);
#pragma unroll
            for (int r_ = 0; r_ < 16; ++r_) { pA0[r_] -= mrun; pA1[r_] -= mrun; }
        }
        j = 0;
        while (j + 4 < mylim && j + 7 < U.ntiles) {
            ATT_FULLS(pA0, pA1, pB0, pB1, 0, 1); ATT_BARX; ATT_FULLD(pB0, pB1, pA0, pA1, 1, 2, j + 4, 0); ATT_BARX;
            ATT_FULLD(pA0, pA1, pB0, pB1, 2, 3, j + 5, 1); ATT_BARX; ATT_FULLD(pB0, pB1, pA0, pA1, 3, 0, j + 6, 2); ATT_HEADS(j + 4, 3); j += 4; }
        while (j + 2 < mylim && j + 5 < U.ntiles) { ATT_FULL(pA0, pA1, pB0, pB1, j); ATT_HEADX(j + 1); ATT_FULL(pB0, pB1, pA0, pA1, j + 1); ATT_HEADX(j + 2); j += 2; }
        while (j + 2 < mylim) { ATT_FULL(pA0, pA1, pB0, pB1, j); ATT_HEAD(j + 1); ATT_FULL(pB0, pB1, pA0, pA1, j + 1); ATT_HEAD(j + 2); j += 2; }
        if (j + 1 < mylim) { ATT_FULL(pA0, pA1, pB0, pB1, j); ATT_HEAD(j + 1); ATT_LAST(pB0, pB1, pA0, pA1, j + 1); j += 2; }
        else { ATT_LAST(pA0, pA1, pB0, pB1, j); j += 1; }
    }
    for (; j < U.ntiles; ++j) ATT_HEAD(j);
#undef ATT_HEADX
#undef ATT_HEAD
#undef ATT_FULL
#undef ATT_LAST
#undef ATT_FULLS
#undef ATT_FULLD
#undef ATT_BARX
#undef ATT_HEADS
#undef ATT_DMAS
#undef ATT_DMA
    asm volatile("s_waitcnt vmcnt(0) lgkmcnt(0)\n\ts_barrier" ::: "memory");
    if (active) {
        const float lt = lrun + shx(lrun, 32), inv = __builtin_amdgcn_rcpf(lt);
        bf16_t* op = O + (size_t)(U.qrow0 + wid * 32 + r32) * 1024 + U.h * 64 + 8 * hi;
#pragma unroll
        for (int dh = 0; dh < 2; ++dh) {
            const f32x16& oo = dh ? o1 : o0;
#pragma unroll
            for (int g = 0; g < 4; g += 2) {
                const unsigned a0 = cvt_pk_bf16(oo[4 * g] * inv, oo[4 * g + 1] * inv), a1 = cvt_pk_bf16(oo[4 * g + 2] * inv, oo[4 * g + 3] * inv);
                const unsigned b0 = cvt_pk_bf16(oo[4 * g + 4] * inv, oo[4 * g + 5] * inv), b1 = cvt_pk_bf16(oo[4 * g + 6] * inv, oo[4 * g + 7] * inv);
                auto s0 = __builtin_amdgcn_permlane32_swap(a0, b0, false, false); auto s1 = __builtin_amdgcn_permlane32_swap(a1, b1, false, false);
                *(u32x4*)(op + dh * 32 + 8 * g) = (u32x4){s0[0], s1[0], s0[1], s1[1]};
            }
        }
    }
}
__device__ __forceinline__ void phase(int vcu, int G, const bf16_t* Q, const bf16_t* KV, const bf16_t* KR, bf16_t* O, LAS unsigned char* lds) {
    for (int w = vcu; w < 256; w += G) {
        const int g = w >> 3, s = w & 7;
        for (int rnd = 0; rnd < 4; ++rnd) {
            const int bh = g + 32 * rnd, b = bh >> 4, h = bh & 15;
            int qlong, qshort;
            if (rnd < 2) { if (s < 4) { qlong = 15 - 2 * s; qshort = 2 * s + 1; } else { qlong = 14 - 2 * (s - 4); qshort = 2 * (s - 4); } }
            else { qlong = 15 - s; qshort = s; }
            for (int k = 0; k < 2; ++k) {
                const int qb = k ? qshort : qlong;
                Unit U; U.qrow0 = b * SEQ + qb * 256; U.kvrow0 = b * SEQ; U.h = h; U.ntiles = 4 * qb + 4; U.lim_base = 4 * qb + 1; U.lim_step = 1; U.nwq = 8;
                unit(U, Q, KV, KR, O, lds);
            }
        }
        if (s >= 4) {
            const int su = g * 4 + (s - 4), b = su >> 4, h = su & 15;
            Unit U; U.qrow0 = MP + b * DSEQ; U.kvrow0 = MP + b * KVS; U.h = h; U.ntiles = KVS / 64; U.lim_base = KVS / 64; U.lim_step = 0; U.nwq = 2;
            unit(U, Q, KV, KR, O, lds);
        }
    }
}
}

struct Args { const float* in[28]; float* out; unsigned char* ws; int ph_lo, ph_hi; };

__device__ __forceinline__ unsigned f2bf(float f) { unsigned u = __builtin_bit_cast(unsigned, f); return (u + 0x7fffu + ((u >> 16) & 1u)) >> 16; }
__device__ __forceinline__ unsigned pk2(float lo, float hi) { return f2bf(lo) | (f2bf(hi) << 16); }

__device__ __forceinline__ void transpose_item(const float* W, int N, const float* gain, bf16_t* WT, size_t ldw, int coff, int k0, int n0, int drow0, LAS float* scr, int lane) {
    float wv[32];
#pragma unroll
    for (int i = 0; i < 32; ++i) wv[i] = W[(size_t)(k0 + 2 * i + (lane >> 5)) * N + n0 + (lane & 31)];
    if (gain) {
#pragma unroll
        for (int i = 0; i < 32; ++i) wv[i] *= gain[k0 + 2 * i + (lane >> 5)];
    }
#pragma unroll
    for (int i = 0; i < 32; ++i) scr[(2 * i + (lane >> 5)) * 33 + (lane & 31)] = wv[i];
    asm volatile("s_waitcnt lgkmcnt(0)" ::: "memory");
    const int c = lane & 7;
#pragma unroll
    for (int j = 0; j < 4; ++j) { const int n = (lane >> 3) + 8 * j; const LAS float* s = scr + (8 * c) * 33 + n;
        u32x4 o; o.x = pk2(s[0 * 33], s[1 * 33]); o.y = pk2(s[2 * 33], s[3 * 33]); o.z = pk2(s[4 * 33], s[5 * 33]); o.w = pk2(s[6 * 33], s[7 * 33]);
        *(u32x4*)(WT + (size_t)(drow0 + n) * ldw + coff + k0 + 8 * c) = o; }
    asm volatile("s_waitcnt lgkmcnt(0)" ::: "memory");
}
__device__ __forceinline__ int win_row(int n0) {
    if (n0 < 1024) return (n0 >> 7) * 256 + (n0 & 127);
    if (n0 < 2048) return 2048 + (n0 - 1024);
    if (n0 < 3072) { const int j = n0 - 2048; return (j >> 7) * 256 + 128 + (j & 127); }
    if (n0 < 3840) return n0;
    if (n0 < 3872) return 5888 + (n0 - 3840);
    return n0 - 32;
}

__device__ __forceinline__ void rope_cs(int pos, int i, float& c, float& s) {
    float iv = 1.0f;
    iv = (i == 1) ? 0.5623413324356079f : iv;
    iv = (i == 2) ? 0.3162277638912201f : iv;
    iv = (i == 3) ? 0.17782793939113617f : iv;
    iv = (i == 4) ? 0.10000000149011612f : iv;
    iv = (i == 5) ? 0.05623413249850273f : iv;
    iv = (i == 6) ? 0.03162277489900589f : iv;
    iv = (i == 7) ? 0.017782794311642647f : iv;
    iv = (i == 8) ? 0.009999999776482582f : iv;
    iv = (i == 9) ? 0.005623413249850273f : iv;
    iv = (i == 10) ? 0.003162277629598975f : iv;
    iv = (i == 11) ? 0.0017782794311642647f : iv;
    iv = (i == 12) ? 0.0010000000474974513f : iv;
    iv = (i == 13) ? 0.000562341301701963f : iv;
    iv = (i == 14) ? 0.0003162277571391314f : iv;
    iv = (i == 15) ? 0.00017782794020604342f : iv;
    const float ang = (float)pos * iv;
    const float n = rintf(ang * 0.15915494309189535f);
    float r = fmaf(-n, 6.2831854820251465f, ang); r = fmaf(-n, -1.7484555e-7f, r);
    c = __cosf(r); s = __sinf(r);
}

__global__ void __launch_bounds__(NWAVES * 64, 2) fwd_kernel(Args args) {
    extern __shared__ __attribute__((aligned(16))) unsigned char lds_raw[];
    LAS unsigned char* lds = (LAS unsigned char*)lds_raw;
    volatile LAS unsigned* MISC = (volatile LAS unsigned*)(lds + MISC_OFF);
    const int wave = __builtin_amdgcn_readfirstlane((int)threadIdx.x >> 6);
    const int G = gridDim.x; const int bx = blockIdx.x; const int vcu = (G % 8 == 0) ? (bx % 8) * (G / 8) + bx / 8 : bx;
    unsigned char* ws = args.ws; float* out = args.out;
    unsigned* ctl = (unsigned*)(ws + WS_CTL);
    for (int u = threadIdx.x; u < (LDS_BYTES - LDSCTL_OFF) / 4; u += NWAVES * 64) ((LAS unsigned*)(lds + LDSCTL_OFF))[u] = 0u;
    __syncthreads();
    const int lo = args.ph_lo, hi = args.ph_hi;
    const bool multi = (hi - lo) > 1;
    XcdBarrier bar; bar.bar = ctl; bar.x = 0; bar.st = nullptr;
    if (multi) bar = xcd_barrier_post(ctl, MISC + 8);
#define IN(k) (({ asm volatile("" : "+s"(kp)); }), (lo <= (k) && (k) < hi))
#define TID_LANE int tid = threadIdx.x; asm volatile("" : "+v"(tid)); const int lane = tid & 63;
#define SEAM(k) do { if (IN(k) && IN((k) + 1)) xcd_barrier(bar); } while (0)
    const int gw = vcu * NWAVES + wave, NGW = G * NWAVES;

    const __attribute__((address_space(4))) unsigned char* kp = (const __attribute__((address_space(4))) unsigned char*)__builtin_amdgcn_kernarg_segment_ptr();
#define KIN(k) (((const float* const __attribute__((address_space(4)))*)kp)[k])
#define x_prompt KIN(0)
#define x_sample KIN(1)
#define cache_conv KIN(2)
#define cache_ckv KIN(3)
#define cache_krope KIN(4)
#define cache_mem_k KIN(5)
#define cache_mem_v KIN(6)
#define mem_prompt KIN(7)
#define g_mix KIN(8)
#define w_in KIN(9)
#define w_conv KIN(10)
#define w_conv_out KIN(11)
#define g_q KIN(12)
#define w_uq KIN(13)
#define g_kv KIN(14)
#define w_ukv KIN(15)
#define w_mla_out KIN(16)
#define w_mix_out KIN(17)
#define g_mem_q KIN(18)
#define g_mem_kv KIN(19)
#define w_qm KIN(20)
#define w_km KIN(21)
#define w_vm KIN(22)
#define w_om KIN(23)
#define g_mlp KIN(24)
#define w_up KIN(25)
#define w_down KIN(26)
#define g_final KIN(27)
    f32x2* tab = (f32x2*)(ws + WS_TAB);
    float* rstd0 = (float*)(ws + WS_RSTD0); float* rq = (float*)(ws + WS_RQ); float* rstdm = (float*)(ws + WS_RSTDM);
    float* st1 = (float*)(ws + WS_ST1); float* st2 = (float*)(ws + WS_ST2); float* st3 = (float*)(ws + WS_ST3);
    bf16_t* Win_t = (bf16_t*)(ws + WS_WIN); bf16_t* Wco_t = (bf16_t*)(ws + WS_WCO); bf16_t* Wuq_t = (bf16_t*)(ws + WS_WUQ); bf16_t* Wukv_t = (bf16_t*)(ws + WS_WUKV);
    bf16_t* Wmo_t = (bf16_t*)(ws + WS_WMO); bf16_t* Wmx_t = (bf16_t*)(ws + WS_WMX); bf16_t* Wqm_g = (bf16_t*)(ws + WS_WQM); bf16_t* Wkv_t = (bf16_t*)(ws + WS_WKV);
    bf16_t* Wom_t = (bf16_t*)(ws + WS_WOM); bf16_t* Wup_t = (bf16_t*)(ws + WS_WUP); bf16_t* Wdn_t = (bf16_t*)(ws + WS_WDN);
    bf16_t* mb = (bf16_t*)(ws + WS_MB); bf16_t* memk = (bf16_t*)(ws + WS_MEMK); bf16_t* memv = (bf16_t*)(ws + WS_MEMV); bf16_t* Wp = (bf16_t*)(ws + WS_WP); bf16_t* Vp = (bf16_t*)(ws + WS_VP);
    bf16_t* ckvb = (bf16_t*)(ws + WS_CKVB); bf16_t* krb = (bf16_t*)(ws + WS_KRB);
    bf16_t* R1 = (bf16_t*)(ws + WS_R1); bf16_t* R2 = (bf16_t*)(ws + WS_R2); bf16_t* R3 = (bf16_t*)(ws + WS_R3); bf16_t* R4 = (bf16_t*)(ws + WS_R4);
    bf16_t* R5 = (bf16_t*)(ws + WS_R5); bf16_t* R6 = (bf16_t*)(ws + WS_R6); bf16_t* R7 = (bf16_t*)(ws + WS_R7); bf16_t* R8 = (bf16_t*)(ws + WS_R8);
    float* slabs = (float*)(ws + WS_SLAB);
    bf16_t* cqb = (bf16_t*)out + (size_t)MT * QW;
    bf16_t* qbuf = (bf16_t*)out;

    if (IN(0)) { TID_LANE
        { constexpr int WKP = 1032; LAS unsigned short* wk = (LAS unsigned short*)(lds + RING_OFF);
          for (int k = tid; k < 1024; k += NWAVES * 64) { const float gk = g_mix[k]; const float* src = w_in + (size_t)k * NIN + 3840;
#pragma unroll
              for (int j4 = 0; j4 < 8; ++j4) { const f32x4 v = *(const f32x4*)(src + 4 * j4) * gk;
#pragma unroll
                  for (int e = 0; e < 4; ++e) wk[(4 * j4 + e) * WKP + k] = (unsigned short)(cvt_pk_bf16(v[e], 0.f) & 0xffffu); } }
          __syncthreads();
          const int rr = lane & 15, q = lane >> 4;
          const LAS unsigned char* wkb = lds + RING_OFF + (rr * WKP + 8 * q) * 2;
          f32x4 acc0, acc1; float ss;
#define P0_LOAD4(A, src, kc) do { _Pragma("unroll") for (int u = 0; u < 4; ++u) { A[u][0] = *(const f32x4*)((src) + 32 * ((kc) + u)); A[u][1] = *(const f32x4*)((src) + 32 * ((kc) + u) + 4); } } while (0)
#define P0_PROC4(A, dst, kc) do { _Pragma("unroll") for (int u = 0; u < 4; ++u) { \
              ss += (A[u][0][0] * A[u][0][0] + A[u][0][1] * A[u][0][1]) + (A[u][0][2] * A[u][0][2] + A[u][0][3] * A[u][0][3]) + (A[u][1][0] * A[u][1][0] + A[u][1][1] * A[u][1][1]) + (A[u][1][2] * A[u][1][2] + A[u][1][3] * A[u][1][3]); \
              const u32x4 pk = pack8(A[u][0], A[u][1]); *(u32x4*)((dst) + 32 * ((kc) + u)) = pk; const bf16x8 af = __builtin_bit_cast(bf16x8, pk); \
              const bf16x8 b0 = *(const LAS bf16x8*)(wkb + ((kc) + u) * 64), b1 = *(const LAS bf16x8*)(wkb + 16 * WKP * 2 + ((kc) + u) * 64); \
              acc0 = __builtin_amdgcn_mfma_f32_16x16x32_bf16(af, b0, acc0, 0, 0, 0); acc1 = __builtin_amdgcn_mfma_f32_16x16x32_bf16(af, b1, acc1, 0, 0, 0); } } while (0)
#define P0_FINISH(R0) do { ss += shx(ss, 16); ss += shx(ss, 32); const float rs = 1.0f / sqrtf(ss * (1.0f / 1024.0f) + EPS); if (q == 0) rstd0[(R0) + rr] = rs; \
              _Pragma("unroll") for (int e = 0; e < 4; ++e) { const float rse = __builtin_bit_cast(float, __builtin_amdgcn_ds_bpermute((4 * q + e) << 2, __builtin_bit_cast(int, rs))); \
                  unsigned short* kp = (unsigned short*)R8 + (size_t)((R0) + 4 * q + e) * 32 + rr; \
                  kp[0] = (unsigned short)(cvt_pk_bf16(acc0[e] * rse, 0.f) & 0xffffu); kp[16] = (unsigned short)(cvt_pk_bf16(acc1[e] * rse, 0.f) & 0xffffu); } } while (0)
          for (int bi = gw; bi < MP / 16; bi += NGW) {
              const int R0 = bi * 16; const float* src = x_prompt + (size_t)(R0 + rr) * 1024 + 8 * q; bf16_t* dst = R1 + (size_t)(R0 + rr) * 1024 + 8 * q;
              acc0 = (f32x4){0.f, 0.f, 0.f, 0.f}; acc1 = acc0; ss = 0.f;
              f32x4 a[2][4][2]; P0_LOAD4(a[0], src, 0);
#pragma unroll
              for (int it = 0; it < 8; ++it) { if (it + 1 < 8) P0_LOAD4(a[(it + 1) & 1], src, 4 * (it + 1)); P0_PROC4(a[it & 1], dst, 4 * it); }
              P0_FINISH(R0);
          }
          { LAS float* part = (LAS float*)(lds + RING_OFF + 73728);
            for (int sb = vcu; sb < MS / 16; sb += G) {
              const int R0 = MP + sb * 16; const float* src = x_sample + (size_t)(sb * 16 + rr) * 1024 + 8 * q; bf16_t* dst = R1 + (size_t)(R0 + rr) * 1024 + 8 * q;
              acc0 = (f32x4){0.f, 0.f, 0.f, 0.f}; acc1 = acc0; ss = 0.f;
              f32x4 a[4][2]; P0_LOAD4(a, src, 4 * wave); P0_PROC4(a, dst, 4 * wave);
              LAS float* mine = part + (wave * 9) * 64 + lane;
              mine[0] = ss;
#pragma unroll
              for (int e = 0; e < 4; ++e) { mine[(1 + e) * 64] = acc0[e]; mine[(5 + e) * 64] = acc1[e]; }
              __syncthreads();
              if (wave == 0) {
                  ss = 0.f; acc0 = (f32x4){0.f, 0.f, 0.f, 0.f}; acc1 = acc0;
                  for (int w = 0; w < NWAVES; ++w) { const LAS float* o = part + (w * 9) * 64 + lane; ss += o[0];
#pragma unroll
                      for (int e = 0; e < 4; ++e) { acc0[e] += o[(1 + e) * 64]; acc1[e] += o[(5 + e) * 64]; } }
                  P0_FINISH(R0);
              }
              __syncthreads();
            } }
#undef P0_LOAD4
#undef P0_PROC4
#undef P0_FINISH
          __syncthreads();
        }
        LAS float* scr = (LAS float*)(lds + RING_OFF + wave * 16384);
        int it = gw;
#define WJ(W, K, N, gain, dst, ldw, coff, mode) do { const int nblk = (N) / 32, nitems = ((K) / 64) * nblk; \
            for (; it < nitems; it += NGW) { const int kb = it / nblk, nb = it % nblk, n0 = nb * 32; transpose_item(W, N, gain, dst, (size_t)(ldw), coff, kb * 64, n0, (mode) ? win_row(n0) : n0, scr, lane); } \
            it -= nitems; } while (0)
        WJ(w_in, 1024, NIN, g_mix, Win_t, 1024, 0, 1);
        WJ(w_conv_out, 1024, 1024, (const float*)nullptr, Wco_t, 1024, 0, 0);
        WJ(w_uq, 512, QW, g_q, Wuq_t, 512, 0, 0);
        WJ(w_ukv, 256, KVW, (const float*)nullptr, Wukv_t, 256, 0, 0);
        WJ(w_mla_out, 1024, 1024, (const float*)nullptr, Wmo_t, 1024, 0, 0);
        WJ(w_mix_out, 1024, 1024, (const float*)nullptr, Wmx_t, 1024, 0, 0);
        WJ(w_km, 1024, 1024, g_mem_kv, Wkv_t, 1024, 0, 0);
        WJ(w_vm, 1024, 1024, g_mem_kv, Wkv_t + (size_t)1024 * 1024, 1024, 0, 0);
        WJ(w_om, 1024, 1024, (const float*)nullptr, Wom_t, 1024, 0, 0);
        WJ(w_up, 1024, DFF, g_mlp, Wup_t, 1024, 0, 0);
        WJ(w_down, DFF, 1024, (const float*)nullptr, Wdn_t, DFF, 0, 0);
#undef WJ
        for (int r = MT + gw; r < MT + 2048; r += NGW) {
            const float* src = r < MP ? x_prompt + (size_t)r * 1024 : (r < MT ? x_sample + (size_t)(r - MP) * 1024 : mem_prompt + (size_t)(r - MT) * 1024);
            bf16_t* dst = r < MT ? R1 + (size_t)r * 1024 : mb + (size_t)(r - MT) * 1024;
            f32x4 v[4]; float s = 0.f;
#pragma unroll
            for (int j = 0; j < 4; ++j) { v[j] = *(const f32x4*)(src + 256 * j + 4 * lane); s += (v[j][0] * v[j][0] + v[j][1] * v[j][1]) + (v[j][2] * v[j][2] + v[j][3] * v[j][3]); }
            s = wave_sum(s); const float rs = 1.0f / sqrtf(s * (1.0f / 1024.0f) + EPS);
            if (lane == 0) { if (r < MT) rstd0[r] = rs; else rstdm[r - MT] = rs; }
#pragma unroll
            for (int j = 0; j < 4; ++j) *(u32x2*)(dst + 256 * j + 4 * lane) = (u32x2){cvt_pk_bf16(v[j][0], v[j][1]), cvt_pk_bf16(v[j][2], v[j][3])};
        }
        for (int i = gw * 64 + lane; i < NB * PAST * 256 / 8; i += NGW * 64) { const int e = i * 8, row = e >> 8, c = e & 255, b = row >> 10, t = row & 1023;
            const f32x4 a = *(const f32x4*)(cache_ckv + e), bb = *(const f32x4*)(cache_ckv + e + 4); *(u32x4*)(ckvb + (size_t)(MP + b * KVS + t) * 256 + c) = pack8(a, bb); }
        for (int i = gw * 64 + lane; i < NB * PAST * 32 / 8; i += NGW * 64) { const int e = i * 8, row = e >> 5, c = e & 31, b = row >> 10, t = row & 1023;
            const f32x4 a = *(const f32x4*)(cache_krope + e), bb = *(const f32x4*)(cache_krope + e + 4); *(u32x4*)(krb + (size_t)(MP + b * KVS + t) * 32 + c) = pack8(a, bb); }
        for (int i = gw * 64 + lane; i < 2048 * 1024 / 8; i += NGW * 64) { const size_t e = (size_t)i * 8;
            const f32x4 a = *(const f32x4*)(cache_mem_k + e), bb = *(const f32x4*)(cache_mem_k + e + 4); *(u32x4*)(memk + (size_t)2048 * 1024 + e) = pack8(a, bb); }
        for (int i = gw * 64 + lane; i < 2048 * 1024 / 8; i += NGW * 64) { const size_t e = (size_t)i * 8;
            const f32x4 a = *(const f32x4*)(cache_mem_v + e), bb = *(const f32x4*)(cache_mem_v + e + 4); *(u32x4*)(memv + (size_t)2048 * 1024 + e) = pack8(a, bb); }
        for (int i = gw * 64 + lane; i < 1024 * 1024 / 8; i += NGW * 64) { const size_t e = (size_t)i * 8; const float gk = g_mem_q[e >> 10];
            const f32x4 a = *(const f32x4*)(w_qm + e) * gk, bb = *(const f32x4*)(w_qm + e + 4) * gk; *(u32x4*)(Wqm_g + e) = pack8(a, bb); }
        for (int i = gw * 64 + lane; i < SEQ * 16; i += NGW * 64) { float c, s; rope_cs(i >> 4, i & 15, c, s); tab[i] = (f32x2){c, s}; }
    }
    SEAM(0);

#define FILL_RT(S, EXPR) do { TID_LANE (void)lane; \
          if (tid == 0) { int n = 0; \
              for (int i = 0; ; ++i) { const int pmi = (S).pm_of(i); if (pmi < 0) break; bool seen = false; for (int k = 0; k < n; ++k) seen = seen || (pmt[k] == pmi); if (!seen && n < 8) pmt[n++] = pmi; } \
              pmt[8] = n; for (int k = n; k < 8; ++k) pmt[k] = -1; } \
          __syncthreads(); \
          const int n_ = pmt[8]; \
          for (int idx = tid; idx < n_ * 256; idx += NWAVES * 64) { const int r = pmt[idx >> 8] * 256 + (idx & 255); rt[idx] = (EXPR); } \
          __syncthreads(); } while (0)
    LAS float* rt = (LAS float*)(lds + SCR_OFF); LAS int* pmt = (LAS int*)(lds + MISC_OFF + 128);
    if (IN(1)) {
        { pg8::Dense P{R1, Win_t, 1024, 1024, 1024}; pg8::StaticOrder S; S.init(MP, NIN1, G, bx);
          FILL_RT(S, rstd0[r]);
          pg8::EpiIn E{rstd0, R2, R3, cqb, R5, R6, R7, (unsigned)(size_t)rt, (unsigned)(size_t)pmt}; pg8::gemm_phase(lds + RING_OFF, P, S, E);
          { pg8::Piece pc; if (pg8::piece_of(NIN1, 1024, G, bx, 2, 128, pc)) pg8::gemm_piece(lds + RING_OFF, P, E, pc, pg8::SplitCtx{out + OUT_Y, ctl + 4096, MISC + 16}); } }
        if (G != 256) { pg8::Dense P{mb, Wkv_t, 1024, 1024, 1024}; pg8::StaticOrder S; S.init(2048, 2048, G, (bx + G - 96) % G);
          pg8::EpiMemKV E{rstdm, out + OUT_MEMK, out + OUT_MEMV, memk, memv}; pg8::gemm_phase(lds + RING_OFF, P, S, E); }
    }
    SEAM(1);

    if (IN(2)) {
        const bool kvcu = G == 256 && (vcu & 31) < 8;
        if (kvcu) { pg8::Dense P{mb, Wkv_t, 1024, 1024, 1024}; pg8::StaticOrder S; S.init(2048, 2048, 64, (vcu >> 5) * 8 + (vcu & 31));
            pg8::EpiMemKV E{rstdm, out + OUT_MEMK, out + OUT_MEMV, memk, memv}; pg8::gemm_phase(lds + RING_OFF, P, S, E); }
        TID_LANE
        int h0, h1, nh;
        if (G == 256) { nh = 3584; if (kvcu) { h0 = 3072 + ((vcu >> 5) * 8 + (vcu & 31)) * NWAVES + wave; h1 = h0 + 1; } else { h0 = 2 * (((vcu >> 5) * 24 + (vcu & 31) - 8) * NWAVES + wave); h1 = h0 + 2; } }
        else { nh = G * NWAVES; h0 = vcu * NWAVES + wave; h1 = h0 + 1; }
        const int rbeg = (int)(((long)h0 * MT) / nh), rend = (int)(((long)h1 * MT) / nh);
        f32x4 wc_[2][6];
#pragma unroll
        for (int hh = 0; hh < 2; ++hh) { const int c = hh * 512 + lane * 8;
#pragma unroll
            for (int k = 0; k < 3; ++k) { wc_[hh][2 * k] = *(const f32x4*)(w_conv + k * 1024 + c); wc_[hh][2 * k + 1] = *(const f32x4*)(w_conv + k * 1024 + c + 4); } }
        const f32x4 gkv = *(const f32x4*)(g_kv + lane * 4);
        f32x4 p1[2][2] = {}, p2[2][2] = {};
        u32x4 cv[2], cb[2], ccq; u32x2 cck; unsigned short ckr;
#define P2_LOAD(r_, V, B, CQ, CK, KR) do { _Pragma("unroll") for (int hh = 0; hh < 2; ++hh) { V[hh] = *(const u32x4*)(R2 + (size_t)(r_) * 1024 + hh * 512 + lane * 8); B[hh] = *(const u32x4*)(R3 + (size_t)(r_) * 1024 + hh * 512 + lane * 8); } \
            CQ = *(const u32x4*)(cqb + (size_t)(r_) * 512 + lane * 8); CK = *(const u32x2*)(R5 + (size_t)(r_) * 256 + lane * 4); KR = R8[(size_t)(r_) * 32 + (lane & 31)]; } while (0)
        if (rbeg < rend) {
            P2_LOAD(rbeg, cv, cb, ccq, cck, ckr);
            { const bool isP = rbeg < MP; const int rr = isP ? rbeg : rbeg - MP; const int b = isP ? rr >> 12 : rr >> 6, t = isP ? rr & (SEQ - 1) : rr & (DSEQ - 1);
#pragma unroll
              for (int hh = 0; hh < 2; ++hh) { const int c = hh * 512 + lane * 8;
                  if (t >= 1) unpack8(*(const u32x4*)(R2 + (size_t)(rbeg - 1) * 1024 + c), p1[hh][0], p1[hh][1]);
                  else if (!isP) { p1[hh][0] = *(const f32x4*)(cache_conv + (size_t)(b * 2 + 1) * 1024 + c); p1[hh][1] = *(const f32x4*)(cache_conv + (size_t)(b * 2 + 1) * 1024 + c + 4); }
                  if (t >= 2) unpack8(*(const u32x4*)(R2 + (size_t)(rbeg - 2) * 1024 + c), p2[hh][0], p2[hh][1]);
                  else if (!isP) { p2[hh][0] = *(const f32x4*)(cache_conv + (size_t)(b * 2 + t) * 1024 + c); p2[hh][1] = *(const f32x4*)(cache_conv + (size_t)(b * 2 + t) * 1024 + c + 4); } } }
        }
        for (int r = rbeg; r < rend; ++r) {
            u32x4 nv[2], nb[2], ncq; u32x2 nck; unsigned short nkr;
            const int rn = r + 1 < rend ? r + 1 : r;
            P2_LOAD(rn, nv, nb, ncq, nck, nkr);
            const bool isP = r < MP; const int rr = isP ? r : r - MP; const int b = isP ? rr >> 12 : rr >> 6, t = isP ? rr & (SEQ - 1) : rr & (DSEQ - 1), T = isP ? SEQ : DSEQ;
            const int kvrow = isP ? r : MP + b * KVS + PAST + t, pos = isP ? t : PAST + t;
            float* oconv = out + (isP ? OUT_CONVP : OUT_CONVS); float* ockv = out + (isP ? OUT_CKVP : OUT_CKVS); float* okr = out + (isP ? OUT_KRP : OUT_KRS);
            if (t == 0) {
#pragma unroll
                for (int hh = 0; hh < 2; ++hh) { const int c = hh * 512 + lane * 8;
                    if (isP) { p1[hh][0] = p1[hh][1] = p2[hh][0] = p2[hh][1] = (f32x4){0.f, 0.f, 0.f, 0.f}; }
                    else { p1[hh][0] = *(const f32x4*)(cache_conv + (size_t)(b * 2 + 1) * 1024 + c); p1[hh][1] = *(const f32x4*)(cache_conv + (size_t)(b * 2 + 1) * 1024 + c + 4);
                           p2[hh][0] = *(const f32x4*)(cache_conv + (size_t)(b * 2) * 1024 + c); p2[hh][1] = *(const f32x4*)(cache_conv + (size_t)(b * 2) * 1024 + c + 4); } }
            }
#pragma unroll
            for (int hh = 0; hh < 2; ++hh) {
                const int c = hh * 512 + lane * 8;
                f32x4 v0a, v0b, ba, bb; unpack8(cv[hh], v0a, v0b); unpack8(cb[hh], ba, bb);
                const f32x4 ga = ba * (wc_[hh][0] * p2[hh][0] + wc_[hh][2] * p1[hh][0] + wc_[hh][4] * v0a), gb = bb * (wc_[hh][1] * p2[hh][1] + wc_[hh][3] * p1[hh][1] + wc_[hh][5] * v0b);
                *(u32x4*)(R1 + (size_t)r * 1024 + c) = pack8(ga, gb);
                if (t >= T - 2) { float* o = oconv + (size_t)(b * 2 + (t - (T - 2))) * 1024 + c; *(f32x4*)o = v0a; *(f32x4*)(o + 4) = v0b; }
                p2[hh][0] = p1[hh][0]; p2[hh][1] = p1[hh][1]; p1[hh][0] = v0a; p1[hh][1] = v0b;
            }
            f32x4 qa, qb; unpack8(ccq, qa, qb);
            float s1 = (qa[0] * qa[0] + qa[1] * qa[1]) + (qa[2] * qa[2] + qa[3] * qa[3]) + (qb[0] * qb[0] + qb[1] * qb[1]) + (qb[2] * qb[2] + qb[3] * qb[3]);
            f32x4 ka = (f32x4){bf_lo(cck.x), bf_hi(cck.x), bf_lo(cck.y), bf_hi(cck.y)};
            float s2 = (ka[0] * ka[0] + ka[1] * ka[1]) + (ka[2] * ka[2] + ka[3] * ka[3]);
#pragma unroll
            for (int o = 1; o < 64; o <<= 1) { s1 += shx(s1, o); s2 += shx(s2, o); }
            if (lane == 0) rq[r] = 1.0f / sqrtf(s1 * (1.0f / 512.0f) + EPS);
            { const float rs = 1.0f / sqrtf(s2 * (1.0f / 256.0f) + EPS); ka = ka * rs * gkv;
              *(f32x4*)(ockv + (size_t)rr * 256 + lane * 4) = ka; *(u32x2*)(ckvb + (size_t)kvrow * 256 + lane * 4) = (u32x2){cvt_pk_bf16(ka[0], ka[1]), cvt_pk_bf16(ka[2], ka[3])}; }
            { const int i = lane & 31; const float xv = __builtin_bit_cast(float, (unsigned)ckr << 16);
              const float pv = shx(xv, 16); const f32x2 cs = tab[pos * 16 + (i & 15)];
              const float o = (i < 16) ? xv * cs.x - pv * cs.y : xv * cs.x + pv * cs.y;
              if (lane < 32) { okr[(size_t)rr * 32 + i] = o; krb[(size_t)kvrow * 32 + i] = (bf16_t)f2bf(o); } }
#pragma unroll
            for (int hh = 0; hh < 2; ++hh) { cv[hh] = nv[hh]; cb[hh] = nb[hh]; }
            ccq = ncq; cck = nck; ckr = nkr;
        }
#undef P2_LOAD
    }
    SEAM(2);

    if (IN(3)) {
        { pg8::Dense P{R1, Wco_t, 1024, 1024, 1024}; pg8::StaticOrder S; S.init(MP, 1024, G, bx);
          pg8::EpiGate E{R6}; pg8::gemm_phase(lds + RING_OFF, P, S, E);
          { pg8::Piece pc; if (pg8::piece_of(1024, 1024, G, bx, 4, 0, pc)) pg8::gemm_piece(lds + RING_OFF, P, E, pc, pg8::SplitCtx{slabs, ctl + 4096 + 64, MISC + 16}); } }
        { pg8::Dense P{cqb, Wuq_t, 512, 512, 512}; pg8::StaticOrder S; S.init(MP, QW, G, bx);
          pg8::EpiQ E{rq, tab, qbuf}; pg8::gemm_phase(lds + RING_OFF, P, S, E);
          { pg8::Piece pc; if (pg8::piece_of(QW, 512, G, bx, 2, 128, pc)) pg8::gemm_piece(lds + RING_OFF, P, E, pc, pg8::SplitCtx{slabs + (size_t)32 * 65536, ctl + 4096 + 128, MISC + 16}); } }
        { pg8::Dense P{ckvb, Wukv_t, 256, 256, 256}; pg8::StaticOrder S; S.init(KVROWS, KVW, G, (bx + 64) % G);
          pg8::EpiPlain E{R2, KVW}; pg8::gemm_phase(lds + RING_OFF, P, S, E); }
    }
    SEAM(3);

    if (IN(5)) attn::phase(vcu, G, qbuf, R2, krb, R1, lds + RING_OFF);
    SEAM(5);

    if (IN(6)) {
        pg8::Dense P{R1, Wmo_t, 1024, 1024, 1024}; pg8::StaticOrder S; S.init(MP, 1024, G, bx);
        pg8::EpiMix E{R6, R7}; pg8::gemm_phase(lds + RING_OFF, P, S, E);
          { pg8::Piece pc; if (pg8::piece_of(1024, 1024, G, bx, 4, 0, pc)) pg8::gemm_piece(lds + RING_OFF, P, E, pc, pg8::SplitCtx{slabs, ctl + 4096 + 192, MISC + 16}); }
        { pg8::ProbWp Pw{memk, Wqm_g, 256, 1024, 1024}; pg8::PreOrder So{G - 32, (int)bx - 32}; pg8::EpiPlain Ew{Wp, 1024}; pg8::gemm_phase(lds + RING_OFF, Pw, So, Ew); }
    }
    SEAM(6);

    if (IN(7)) {
        pg8::Dense P{R7, Wmx_t, 1024, 1024, 1024}; pg8::StaticOrder S; S.init(MP, 1024, G, bx);
        pg8::EpiRes E{x_prompt, x_sample, out + OUT_Y, R1, st1}; pg8::gemm_phase(lds + RING_OFF, P, S, E);
          { pg8::Piece pc; if (pg8::piece_of(1024, 1024, G, bx, 4, 0, pc)) pg8::gemm_piece(lds + RING_OFF, P, E, pc, pg8::SplitCtx{slabs, ctl + 4096 + 256, MISC + 16}); }
        { pg8::ProbVp Pv{Wom_t, memv, 256, 1024, 1024}; pg8::PreOrder So{G - 32, (int)bx - 32}; pg8::EpiPlain Ev{Vp, 1024}; pg8::gemm_phase(lds + RING_OFF, Pv, So, Ev); }
    }
    SEAM(7);

    if (IN(8)) {
        pg8::ProbMA P{R1, Wp, 1024, 1024, 1024}; pg8::StaticOrder S; S.init(MP, 1024, G, bx);
        pg8::EpiSoftmaxS E{st1, MSCALE, R3, (LAS float*)(lds + SCR_OFF)}; pg8::gemm_phase(lds + RING_OFF, P, S, E);
          { pg8::Piece pc; if (pg8::piece_of_mem(G, bx, 4, 0, pc)) pg8::gemm_piece(lds + RING_OFF, P, E, pc, pg8::SplitCtx{slabs, ctl + 4096 + 320, MISC + 16}); }
    }
    SEAM(8);

    if (IN(9)) {
        pg8::ProbMA P{R3, Vp, 1024, 1024, 1024}; pg8::StaticOrder S; S.init(MP, 1024, G, bx);
        pg8::EpiResM E{out + OUT_Y, R1, st2}; pg8::gemm_phase(lds + RING_OFF, P, S, E);
          { pg8::Piece pc; if (pg8::piece_of_mem(G, bx, 4, 0, pc)) pg8::gemm_piece(lds + RING_OFF, P, E, pc, pg8::SplitCtx{slabs, ctl + 4096 + 384, MISC + 16}); }
    }
    SEAM(9);

    if (IN(12)) {
        pg8::Dense P{R1, Wup_t, 1024, 1024, 1024}; pg8::StaticOrder S; S.init(MP, DFF, G, bx);
        FILL_RT(S, pg8::row_rstd(st2, r));
        pg8::EpiNormAct<1> E{st2, R2, DFF, 1.0f, (unsigned)(size_t)rt, (unsigned)(size_t)pmt}; pg8::gemm_phase(lds + RING_OFF, P, S, E);
          { pg8::Piece pc; if (pg8::piece_of(DFF, 1024, G, bx, 4, 0, pc)) pg8::gemm_piece(lds + RING_OFF, P, E, pc, pg8::SplitCtx{slabs, ctl + 4096 + 448, MISC + 16}); }
    }
    SEAM(12);

    if (IN(13)) {
        pg8::Dense P{R2, Wdn_t, DFF, DFF, DFF}; pg8::StaticOrder S; S.init(MP, 1024, G, bx);
        if (G == 256) {
            pg8::EpiResFinal E{out + OUT_Y, out + OUT_Y + (size_t)MP * 1024, out + OUT_Y, st3, ctl + 8192, g_final}; pg8::gemm_phase(lds + RING_OFF, P, S, E);
            { pg8::Piece pc; if (pg8::piece_of(1024, DFF, G, bx, 8, 0, pc)) pg8::gemm_piece(lds + RING_OFF, P, E, pc, pg8::SplitCtx{slabs, ctl + 4096 + 512, MISC + 16}); }
        } else {
            pg8::EpiRes E{out + OUT_Y, out + OUT_Y + (size_t)MP * 1024, out + OUT_Y, nullptr, st3}; pg8::gemm_phase(lds + RING_OFF, P, S, E);
            { pg8::Piece pc; if (pg8::piece_of(1024, DFF, G, bx, 8, 0, pc)) pg8::gemm_piece(lds + RING_OFF, P, E, pc, pg8::SplitCtx{slabs, ctl + 4096 + 512, MISC + 16}); }
        }
    }
    if (G != 256) SEAM(13);

    if (IN(14) && G != 256) { TID_LANE
        for (int r = gw; r < MT; r += NGW) {
            const float rs = pg8::row_rstd(st3, r); float* p = out + OUT_Y + (size_t)r * 1024;
#pragma unroll
            for (int j = 0; j < 4; ++j) { const int c = 256 * j + 4 * lane; *(f32x4*)(p + c) = *(const f32x4*)(p + c) * rs * *(const f32x4*)(g_final + c); }
        }
    }
#undef IN
#undef SEAM
#undef x_prompt
#undef x_sample
#undef cache_conv
#undef cache_ckv
#undef cache_krope
#undef cache_mem_k
#undef cache_mem_v
#undef mem_prompt
#undef g_mix
#undef w_in
#undef w_conv
#undef w_conv_out
#undef g_q
#undef w_uq
#undef g_kv
#undef w_ukv
#undef w_mla_out
#undef w_mix_out
#undef g_mem_q
#undef g_mem_kv
#undef w_qm
#undef w_km
#undef w_vm
#undef w_om
#undef g_mlp
#undef w_up
#undef w_down
#undef g_final
#undef KIN
}

#ifndef MK_PER_PHASE
#define MK_PER_PHASE 0
#endif
constexpr int NPHASE = 15;
extern "C" void kernel_launch(void* const* d_in, const int* in_sizes, int n_in, void* d_out, int out_size, void* d_ws, size_t ws_size, hipStream_t stream) {
    static int grid = 0;
    if (grid == 0) {
        if (n_in != 28 || (size_t)out_size != OUT_TOTAL || ws_size < WS_END) { fprintf(stderr, "kernel_launch: unexpected problem (n_in %d, out %d, ws %zu)\n", n_in, out_size, ws_size); grid = -1; return; }
        int dev = 0, cus = 0, per_cu = 0;
        if (hipGetDevice(&dev) != hipSuccess || hipDeviceGetAttribute(&cus, hipDeviceAttributeMultiprocessorCount, dev) != hipSuccess) { grid = -1; return; }
        if (hipFuncSetAttribute((const void*)fwd_kernel, hipFuncAttributeMaxDynamicSharedMemorySize, LDS_BYTES) != hipSuccess) { fprintf(stderr, "kernel_launch: hipFuncSetAttribute failed\n"); grid = -1; return; }
        if (hipOccupancyMaxActiveBlocksPerMultiprocessor(&per_cu, (const void*)fwd_kernel, NWAVES * 64, LDS_BYTES) != hipSuccess || per_cu < 1) { fprintf(stderr, "kernel_launch: occupancy query says %d\n", per_cu); per_cu = 1; }
        (void)hipGetLastError();
        grid = cus;
    }
    if (grid < 0) return;
    (void)hipMemsetAsync((char*)d_ws + WS_CTL, 0, CTL_ZERO_BYTES, stream);
    Args a{};
    for (int i = 0; i < 28; ++i) a.in[i] = (const float*)d_in[i];
    a.out = (float*)d_out; a.ws = (unsigned char*)d_ws;
#if MK_PER_PHASE
    for (int p = 0; p < NPHASE; ++p) { a.ph_lo = p; a.ph_hi = p + 1; hipLaunchKernelGGL(fwd_kernel, dim3(grid), dim3(NWAVES * 64), LDS_BYTES, stream, a); }
#else
    a.ph_lo = 0; a.ph_hi = NPHASE;
    hipLaunchKernelGGL(fwd_kernel, dim3(grid), dim3(NWAVES * 64), LDS_BYTES, stream, a);
#endif
}
```

```cpp
#include <hip/hip_runtime.h>
#include <cstdio>
#include <cstdint>

#define LAS __attribute__((address_space(3)))
#define GAS __attribute__((address_space(1)))
typedef unsigned short bf16_t;
typedef short bf16x8 __attribute__((ext_vector_type(8)));
typedef short s16x4 __attribute__((ext_vector_type(4)));
typedef float f32x4 __attribute__((ext_vector_type(4)));
typedef float f32x2 __attribute__((ext_vector_type(2)));
typedef float f32x16 __attribute__((ext_vector_type(16)));
typedef unsigned u32x4 __attribute__((ext_vector_type(4)));
typedef unsigned u32x2 __attribute__((ext_vector_type(2)));

constexpr int DM = 1024, NB = 8, SEQ = 4096, DSEQ = 64, PAST = 1024;
constexpr int MP = NB * SEQ;
constexpr int MS = NB * DSEQ;
constexpr int MT = MP + MS;
constexpr int KVS = PAST + DSEQ;
constexpr int KVROWS = MP + NB * KVS;
constexpr int NIN = 5920, NINP = 6144, NIN1 = 5888;
constexpr int QW = 1536, KVW = 2048, DFF = 4096, NMEM = 256;
constexpr float EPS = 1e-6f;
constexpr float LOG2E = 1.4426950408889634f;
constexpr float QSCALE = 0.10206207261596577f * LOG2E;
constexpr float MSCALE = 0.0625f * LOG2E;

typedef __bf16 bf16x2_t __attribute__((ext_vector_type(2)));
__device__ __forceinline__ unsigned cvt_pk_bf16(float lo, float hi) { f32x2 v = {lo, hi}; bf16x2_t b = __builtin_convertvector(v, bf16x2_t); return __builtin_bit_cast(unsigned, b); }
__device__ __forceinline__ float bf_lo(unsigned w) { return __builtin_bit_cast(float, w << 16); }
__device__ __forceinline__ float bf_hi(unsigned w) { return __builtin_bit_cast(float, w & 0xffff0000u); }
__device__ __forceinline__ u32x4 pack8(f32x4 a, f32x4 b) { u32x4 w; w.x = cvt_pk_bf16(a[0], a[1]); w.y = cvt_pk_bf16(a[2], a[3]); w.z = cvt_pk_bf16(b[0], b[1]); w.w = cvt_pk_bf16(b[2], b[3]); return w; }
__device__ __forceinline__ void unpack8(u32x4 w, f32x4& a, f32x4& b) { a = (f32x4){bf_lo(w.x), bf_hi(w.x), bf_lo(w.y), bf_hi(w.y)}; b = (f32x4){bf_lo(w.z), bf_hi(w.z), bf_lo(w.w), bf_hi(w.w)}; }
__device__ __forceinline__ float fast_sigmoid(float x) { return __builtin_amdgcn_rcpf(1.0f + __builtin_amdgcn_exp2f(-x * LOG2E)); }
__device__ __forceinline__ float shx(float v, int m) { int z = 0; asm volatile("" : "+v"(z)); const int l = __builtin_amdgcn_mbcnt_hi(~0u, __builtin_amdgcn_mbcnt_lo(~0u, z));
    return __builtin_bit_cast(float, __builtin_amdgcn_ds_bpermute((l ^ m) << 2, __builtin_bit_cast(int, v))); }
__device__ __forceinline__ float wave_sum(float v) {
#pragma unroll
    for (int o = 1; o < 64; o <<= 1) v += shx(v, o);
    return v;
}

namespace pg8 {
constexpr int BM = 256, BK = 64, HALF = 128, HTB = HALF * BK * 2  , STAGE_BYTES = 8 * HTB, NXCD = 8, WGM = 4;
static_assert(WGM * 4 <= 32, "EpiResFinal: a row panel's four owners must share a round");
__host__ __device__ __forceinline__ int lds_byte(int r, int c) { const int st = (r >> 4) * 2 + (c >> 5), rr = r & 15, cc = c & 31, ob = rr * 64 + cc * 2; return st * 1024 + (ob ^ (((ob >> 9) & 1) << 5)); }
__host__ __device__ __forceinline__ void stage_rc(int b, int& R, int& C) { const int st = b / 1024, sb = b % 1024, swz = sb ^ (((sb >> 9) & 1) << 5); R = (st >> 1) * 16 + swz / 64; C = (st & 1) * 32 + (swz % 64) / 2; }
__host__ __device__ __forceinline__ int perm32(int rho) { const int n = rho >> 4, i = rho & 15; return 8 * (i >> 2) + 4 * n + (i & 3); }

struct Unit { int pm, pn; };
struct Dense {
    const bf16_t* A; const bf16_t* Bt; int K, lda, ldb;
    __device__ __forceinline__ const char* aptr(const Unit& u) const { return (const char*)(A + (size_t)u.pm * 256 * lda); }
    __device__ __forceinline__ const char* bptr(const Unit& u) const { return (const char*)(Bt + (size_t)u.pn * 256 * ldb); }
};
struct StaticOrder {
    int nM, nN, nwg, G, c;
    __host__ __device__ void init(int M, int N, int G_, int c_) { nM = M / BM; nN = N / BM; nwg = nM * nN; G = G_; c = c_; }
    __host__ __device__ bool next(int i, Unit& u) const {
        const long L = (long)i * G + c; if (L >= nwg) return false;
        int wgid = (int)L; { const int q = nwg / NXCD, r = nwg % NXCD, xcd = wgid % NXCD, off = wgid / NXCD; wgid = (xcd < r ? xcd * (q + 1) : r * (q + 1) + (xcd - r) * q) + off; }
        const int nig = WGM * nN, gid = wgid / nig, fm = gid * WGM, gsz = (nM - fm) < WGM ? (nM - fm) : WGM;
        u.pm = fm + ((wgid % nig) % gsz); u.pn = (wgid % nig) / gsz; return true;
    }
    __host__ __device__ __forceinline__ int pm_of(int i) const {
        const long L = (long)i * G + c; if (L >= nwg) return -1;
        int wgid = (int)L; { const int q = nwg / NXCD, r = nwg % NXCD, xcd = wgid % NXCD, off = wgid / NXCD; wgid = (xcd < r ? xcd * (q + 1) : r * (q + 1) + (xcd - r) * q) + off; }
        const int nig = WGM * nN, gid = wgid / nig, fm = gid * WGM, gsz = (nM - fm) < WGM ? (nM - fm) : WGM;
        return fm + ((wgid % nig) % gsz);
    }
};

typedef f32x4 Acc[2][2][4][2];

template <class Prob, class Epi, class Sched>
__device__ __forceinline__ void gemm_phase(LAS unsigned char* lds, const Prob& P, const Sched& S, const Epi& E) {
    const int tid = threadIdx.x, wid = __builtin_amdgcn_readfirstlane(tid >> 6), lane = tid & 63, wr = wid >> 2, wc = wid & 3, fr = lane & 15, fq = lane >> 4;
    const int nt = P.K / BK;
    unsigned voffA[2], voffB[2];
#pragma unroll
    for (int i = 0; i < 2; ++i) { int R, C; stage_rc(tid * 16 + i * 8192, R, C); const int Rb = (R & ~31) + perm32(R & 31);
        voffA[i] = (unsigned)(R * P.lda + C) * 2u; voffB[i] = (unsigned)(Rb * P.ldb + C) * 2u; }
    const size_t kstep = (size_t)(BK * 2);
    const size_t hstepA = (size_t)HALF * P.lda * 2, hstepB = (size_t)HALF * P.ldb * 2;
    const unsigned ldsw = (unsigned)wid * 1024u;
    const int aoff = lds_byte(wr * 64 + fr, fq * 8), boff = lds_byte(wc * 32 + fr, fq * 8);
#define PG8_SA(b, h) (((b) * 2 + (h)) * HTB)
#define PG8_SB(b, h) ((4 + (b) * 2 + (h)) * HTB)
#define PG8_STAGE(bufoff, gbase, voff) do { _Pragma("unroll") for (int _i = 0; _i < 2; ++_i) \
        __builtin_amdgcn_global_load_lds((const unsigned*)((const char*)(gbase) + (voff)[_i]), (LAS unsigned*)(lds + (bufoff) + ldsw + _i * 8192), 16, 0, 0); } while (0)
#define PG8_LDA(dst, b, h) do { _Pragma("unroll") for (int m = 0; m < 4; ++m) _Pragma("unroll") for (int k = 0; k < 2; ++k) dst[m][k] = *(const LAS bf16x8*)(lds + PG8_SA(b, h) + aoff + m * 2048 + k * 1024); } while (0)
#define PG8_LDB(dst, b, h) do { _Pragma("unroll") for (int n = 0; n < 2; ++n) _Pragma("unroll") for (int k = 0; k < 2; ++k) dst[n][k] = *(const LAS bf16x8*)(lds + PG8_SB(b, h) + boff + n * 2048 + k * 1024); } while (0)
#define PG8_MMA(ai, bj, At, Bt) do { __builtin_amdgcn_s_setprio(1); _Pragma("unroll") for (int m = 0; m < 4; ++m) _Pragma("unroll") for (int n = 0; n < 2; ++n) _Pragma("unroll") for (int k = 0; k < 2; ++k) \
        acc[ai][bj][m][n] = __builtin_amdgcn_mfma_f32_16x16x32_bf16(Bt[n][k], At[m][k], acc[ai][bj][m][n], 0, 0, 0); __builtin_amdgcn_s_setprio(0); } while (0)
#define PG8_WAIT_V(n) asm volatile("s_waitcnt vmcnt(" #n ")" ::: "memory")
#define PG8_WAIT_L(n) asm volatile("s_waitcnt lgkmcnt(" #n ")" ::: "memory")
#define PG8_BAR __builtin_amdgcn_s_barrier()
#define PG8_SCHED __builtin_amdgcn_sched_barrier(0)
    Unit cur, nxt; int ui = 0;
    if (!S.next(0, cur)) return;
    Acc acc;
#pragma unroll
    for (int a = 0; a < 2; ++a)
#pragma unroll
        for (int b = 0; b < 2; ++b)
#pragma unroll
            for (int m = 0; m < 4; ++m)
#pragma unroll
                for (int n = 0; n < 2; ++n) acc[a][b][m][n] = (f32x4){0.f, 0.f, 0.f, 0.f};
    bf16x8 At[4][2], B0[2][2], B1[2][2];
    const char* cA = P.aptr(cur); const char* cB = P.bptr(cur);
    PG8_STAGE(PG8_SB(0, 0), cB, voffB); PG8_STAGE(PG8_SB(0, 1), cB + hstepB, voffB); PG8_STAGE(PG8_SA(0, 0), cA, voffA); PG8_STAGE(PG8_SA(0, 1), cA + hstepA, voffA);
    if (wr == 1) PG8_BAR;
    PG8_WAIT_V(2); PG8_BAR;
    PG8_STAGE(PG8_SB(1, 0), cB + kstep, voffB); PG8_STAGE(PG8_SA(1, 0), cA + kstep, voffA); PG8_STAGE(PG8_SB(1, 1), cB + hstepB + kstep, voffB);
    PG8_WAIT_V(6); PG8_BAR;
    for (;;) {
        const bool has_next = S.next(ui + 1, nxt);
        const char* nA = has_next ? P.aptr(nxt) : cA; const char* nB = has_next ? P.bptr(nxt) : cB;
        for (int t = 0; t < nt; t += 2) {
            const bool last = (t == nt - 2);
            const char* a1 = cA + (size_t)(t + 1) * kstep;
            const char* a2 = last ? nA : cA + (size_t)(t + 2) * kstep; const char* b2 = last ? nB : cB + (size_t)(t + 2) * kstep;
            const char* a3 = a2 + kstep; const char* b3 = b2 + kstep;
            PG8_LDB(B0, 0, 0); PG8_LDB(B1, 0, 1); PG8_SCHED; PG8_LDA(At, 0, 0); PG8_STAGE(PG8_SA(1, 1), a1 + hstepA, voffA);
            PG8_WAIT_V(8); PG8_WAIT_L(0); PG8_BAR; PG8_MMA(0, 0, At, B0); PG8_MMA(0, 1, At, B1); PG8_BAR; PG8_SCHED;
            PG8_LDA(At, 0, 1); PG8_STAGE(PG8_SB(0, 0), b2, voffB); PG8_STAGE(PG8_SB(0, 1), b2 + hstepB, voffB); PG8_STAGE(PG8_SA(0, 0), a2, voffA);
            PG8_WAIT_V(8); PG8_WAIT_L(0); PG8_BAR; PG8_MMA(1, 0, At, B0); PG8_MMA(1, 1, At, B1); PG8_BAR; PG8_SCHED;
            PG8_LDB(B0, 1, 0); PG8_LDB(B1, 1, 1); PG8_SCHED; PG8_LDA(At, 1, 0); PG8_STAGE(PG8_SA(0, 1), a2 + hstepA, voffA);
            PG8_WAIT_V(8); PG8_WAIT_L(0); PG8_BAR; PG8_MMA(0, 0, At, B0); PG8_MMA(0, 1, At, B1); PG8_BAR; PG8_SCHED;
            PG8_LDA(At, 1, 1); PG8_STAGE(PG8_SB(1, 0), b3, voffB); PG8_STAGE(PG8_SB(1, 1), b3 + hstepB, voffB); PG8_STAGE(PG8_SA(1, 0), a3, voffA);
            PG8_WAIT_V(8); PG8_WAIT_L(0); PG8_BAR; PG8_MMA(1, 0, At, B0); PG8_MMA(1, 1, At, B1); PG8_BAR; PG8_SCHED;
        }
        if (wr == 0) PG8_BAR;
        E(acc, cur, wr, wc, fr, fq);
        if (!has_next) break;
#pragma unroll
        for (int a = 0; a < 2; ++a)
#pragma unroll
            for (int b = 0; b < 2; ++b)
#pragma unroll
                for (int m = 0; m < 4; ++m)
#pragma unroll
                    for (int n = 0; n < 2; ++n) acc[a][b][m][n] = (f32x4){0.f, 0.f, 0.f, 0.f};
        cur = nxt; cA = nA; cB = nB; ++ui;
        if (wr == 1) PG8_BAR;
    }
    PG8_WAIT_V(0);
    PG8_BAR;
#undef PG8_SA
#undef PG8_SB
#undef PG8_STAGE
#undef PG8_LDA
#undef PG8_LDB
#undef PG8_MMA
#undef PG8_WAIT_V
#undef PG8_WAIT_L
#undef PG8_BAR
#undef PG8_SCHED
}

struct SplitCtx { float* slabs; unsigned* cnt; volatile LAS unsigned* flag; };
struct Piece { int pm, pn, k0, nk, split, slot, uid; };
__device__ __forceinline__ bool piece_of(int N, int K, int G, int c, int split, int coff, Piece& p) {
    const int nN = N / BM, j = (c + coff) % G, un = j / split; p.slot = j % split; p.uid = un; p.pm = 128 + un / nN; p.pn = un % nN; p.nk = K / BK / split; p.k0 = p.slot * p.nk; p.split = split;
    return j < 2 * nN * split;
}
__device__ __forceinline__ bool piece_of_mem(int G, int c, int split, int coff, Piece& p) {
    const int j = (c + coff) % G, un = j / split; p.slot = j % split; p.uid = un; p.pm = 128 + (un >> 2); p.pn = un & 3; p.nk = 16 / split; p.k0 = p.slot * p.nk; p.split = split;
    return j < 32 * split;
}
template <class Prob, class Epi>
__device__ __forceinline__ void gemm_piece(LAS unsigned char* lds, const Prob& P, const Epi& E, const Piece pc, const SplitCtx X) {
    int tid_ = threadIdx.x; asm volatile("" : "+v"(tid_));
    const int tid = tid_, wid = __builtin_amdgcn_readfirstlane(tid >> 6), lane = tid & 63, wr = wid >> 2, wc = wid & 3, fr = lane & 15, fq = lane >> 4;
    unsigned voffA[2], voffB[2];
#pragma unroll
    for (int i = 0; i < 2; ++i) { int R, C; stage_rc(tid * 16 + i * 8192, R, C); const int Rb = (R & ~31) + perm32(R & 31);
        voffA[i] = (unsigned)(R * P.lda + C) * 2u; voffB[i] = (unsigned)(Rb * P.ldb + C) * 2u; }
    const size_t kstep = (size_t)(BK * 2);
    const size_t hstepA = (size_t)HALF * P.lda * 2, hstepB = (size_t)HALF * P.ldb * 2;
    const unsigned ldsw = (unsigned)wid * 1024u;
    const int aoff = lds_byte(wr * 64 + fr, fq * 8), boff = lds_byte(wc * 32 + fr, fq * 8);
#define PG8_SA(b, h) (((b) * 2 + (h)) * HTB)
#define PG8_SB(b, h) ((4 + (b) * 2 + (h)) * HTB)
#define PG8_STAGE(bufoff, gbase, voff) do { _Pragma("unroll") for (int _i = 0; _i < 2; ++_i) \
        __builtin_amdgcn_global_load_lds((const unsigned*)((const char*)(gbase) + (voff)[_i]), (LAS unsigned*)(lds + (bufoff) + ldsw + _i * 8192), 16, 0, 0); } while (0)
#define PG8_LDA(dst, b, h) do { _Pragma("unroll") for (int m = 0; m < 4; ++m) _Pragma("unroll") for (int k = 0; k < 2; ++k) dst[m][k] = *(const LAS bf16x8*)(lds + PG8_SA(b, h) + aoff + m * 2048 + k * 1024); } while (0)
#define PG8_LDB(dst, b, h) do { _Pragma("unroll") for (int n = 0; n < 2; ++n) _Pragma("unroll") for (int k = 0; k < 2; ++k) dst[n][k] = *(const LAS bf16x8*)(lds + PG8_SB(b, h) + boff + n * 2048 + k * 1024); } while (0)
#define PG8_MMA(ai, bj, At, Bt) do { __builtin_amdgcn_s_setprio(1); _Pragma("unroll") for (int m = 0; m < 4; ++m) _Pragma("unroll") for (int n = 0; n < 2; ++n) _Pragma("unroll") for (int k = 0; k < 2; ++k) \
        acc[ai][bj][m][n] = __builtin_amdgcn_mfma_f32_16x16x32_bf16(Bt[n][k], At[m][k], acc[ai][bj][m][n], 0, 0, 0); __builtin_amdgcn_s_setprio(0); } while (0)
#define PG8_WAIT_V(n) asm volatile("s_waitcnt vmcnt(" #n ")" ::: "memory")
#define PG8_WAIT_L(n) asm volatile("s_waitcnt lgkmcnt(" #n ")" ::: "memory")
#define PG8_BAR __builtin_amdgcn_s_barrier()
#define PG8_SCHED __builtin_amdgcn_sched_barrier(0)
    Unit cur; cur.pm = pc.pm; cur.pn = pc.pn;
    Acc acc;
#pragma unroll
    for (int a = 0; a < 2; ++a)
#pragma unroll
        for (int b = 0; b < 2; ++b)
#pragma unroll
            for (int m = 0; m < 4; ++m)
#pragma unroll
                for (int n = 0; n < 2; ++n) acc[a][b][m][n] = (f32x4){0.f, 0.f, 0.f, 0.f};
    {
    bf16x8 At[4][2], B0[2][2], B1[2][2];
    const char* cA = P.aptr(cur) + (size_t)pc.k0 * kstep; const char* cB = P.bptr(cur) + (size_t)pc.k0 * kstep;
    PG8_STAGE(PG8_SB(0, 0), cB, voffB); PG8_STAGE(PG8_SB(0, 1), cB + hstepB, voffB); PG8_STAGE(PG8_SA(0, 0), cA, voffA); PG8_STAGE(PG8_SA(0, 1), cA + hstepA, voffA);
    if (wr == 1) PG8_BAR;
    PG8_WAIT_V(2); PG8_BAR;
    PG8_STAGE(PG8_SB(1, 0), cB + kstep, voffB); PG8_STAGE(PG8_SA(1, 0), cA + kstep, voffA); PG8_STAGE(PG8_SB(1, 1), cB + hstepB + kstep, voffB);
    PG8_WAIT_V(6); PG8_BAR;
    const int nt = pc.nk;
    for (int t = 0; t < nt; t += 2) {
        const bool last = (t == nt - 2);
        const char* a1 = cA + (size_t)(t + 1) * kstep;
        const char* a2 = last ? cA : cA + (size_t)(t + 2) * kstep; const char* b2 = last ? cB : cB + (size_t)(t + 2) * kstep;
        const char* a3 = a2 + kstep; const char* b3 = b2 + kstep;
        PG8_LDB(B0, 0, 0); PG8_LDB(B1, 0, 1); PG8_SCHED; PG8_LDA(At, 0, 0); PG8_STAGE(PG8_SA(1, 1), a1 + hstepA, voffA);
        PG8_WAIT_V(8); PG8_WAIT_L(0); PG8_BAR; PG8_MMA(0, 0, At, B0); PG8_MMA(0, 1, At, B1); PG8_BAR; PG8_SCHED;
        PG8_LDA(At, 0, 1); PG8_STAGE(PG8_SB(0, 0), b2, voffB); PG8_STAGE(PG8_SB(0, 1), b2 + hstepB, voffB); PG8_STAGE(PG8_SA(0, 0), a2, voffA);
        PG8_WAIT_V(8); PG8_WAIT_L(0); PG8_BAR; PG8_MMA(1, 0, At, B0); PG8_MMA(1, 1, At, B1); PG8_BAR; PG8_SCHED;
        PG8_LDB(B0, 1, 0); PG8_LDB(B1, 1, 1); PG8_SCHED; PG8_LDA(At, 1, 0); PG8_STAGE(PG8_SA(0, 1), a2 + hstepA, voffA);
        PG8_WAIT_V(8); PG8_WAIT_L(0); PG8_BAR; PG8_MMA(0, 0, At, B0); PG8_MMA(0, 1, At, B1); PG8_BAR; PG8_SCHED;
        PG8_LDA(At, 1, 1); PG8_STAGE(PG8_SB(1, 0), b3, voffB); PG8_STAGE(PG8_SB(1, 1), b3 + hstepB, voffB); PG8_STAGE(PG8_SA(1, 0), a3, voffA);
        PG8_WAIT_V(8); PG8_WAIT_L(0); PG8_BAR; PG8_MMA(1, 0, At, B0); PG8_MMA(1, 1, At, B1); PG8_BAR; PG8_SCHED;
    }
    if (wr == 0) PG8_BAR;
    }
    float* ubase = X.slabs + (size_t)pc.uid * pc.split * 65536;
    const __amdgpu_buffer_rsrc_t rs = __builtin_amdgcn_make_buffer_rsrc((void*)ubase, (short)0, pc.split * 262144, 0x00020000);
    { const int so = pc.slot * 262144;
#pragma unroll
      for (int a = 0; a < 2; ++a)
#pragma unroll
          for (int b = 0; b < 2; ++b)
#pragma unroll
              for (int m = 0; m < 4; ++m)
#pragma unroll
                  for (int n = 0; n < 2; ++n) __builtin_amdgcn_raw_buffer_store_b128(__builtin_bit_cast(u32x4, acc[a][b][m][n]), rs, tid * 16, so + ((((a * 2 + b) * 4 + m) * 2 + n) * 8192), 16); }
    asm volatile("s_waitcnt vmcnt(0)" ::: "memory"); __syncthreads();
    if (tid == 0) { (void)__hip_atomic_fetch_add(X.cnt + pc.uid, 1u, __ATOMIC_RELAXED, __HIP_MEMORY_SCOPE_AGENT);
        unsigned sp = 0u; while (__hip_atomic_load(X.cnt + pc.uid, __ATOMIC_RELAXED, __HIP_MEMORY_SCOPE_AGENT) < (unsigned)pc.split) { __builtin_amdgcn_s_sleep(2); if (++sp > (1u << 22)) break; } }
    __syncthreads();
    const int gsz = 8 / pc.split, g0 = pc.slot * gsz;
    const unsigned rowmask = ((1u << gsz) - 1u) << g0;
#pragma unroll
    for (int a = 0; a < 2; ++a)
#pragma unroll
        for (int b = 0; b < 2; ++b)
#pragma unroll
            for (int m = 0; m < 4; ++m)
#pragma unroll
                for (int n = 0; n < 2; ++n) acc[a][b][m][n] = (f32x4){0.f, 0.f, 0.f, 0.f};
    int nsp = pc.split; asm volatile("" : "+s"(nsp));
    for (int s = 0; s < nsp; ++s) {
#pragma unroll
        for (int a = 0; a < 2; ++a)
#pragma unroll
            for (int m = 0; m < 4; ++m)
                if ((rowmask >> (a * 4 + m)) & 1u) {
#pragma unroll
                    for (int b = 0; b < 2; ++b)
#pragma unroll
                        for (int n = 0; n < 2; ++n) acc[a][b][m][n] += __builtin_bit_cast(f32x4, __builtin_amdgcn_raw_buffer_load_b128(rs, tid * 16, s * 262144 + ((((a * 2 + b) * 4 + m) * 2 + n) * 8192), 16));
                }
    }
    E(acc, cur, wr, wc, fr, fq, rowmask);
    return;
    E(acc, cur, wr, wc, fr, fq);
#undef PG8_SA
#undef PG8_SB
#undef PG8_STAGE
#undef PG8_LDA
#undef PG8_LDB
#undef PG8_MMA
#undef PG8_WAIT_V
#undef PG8_WAIT_L
#undef PG8_BAR
#undef PG8_SCHED
}
}

constexpr size_t MiB = 1u << 20;
constexpr size_t UB = (size_t)MT * 1024 * 2;
constexpr size_t WS_CTL = 0, CTL_ZERO_BYTES = 64 * 1024;
constexpr size_t WS_TAB = 1 * MiB;
constexpr size_t WS_RSTD0 = 2 * MiB;
constexpr size_t WS_RQ = WS_RSTD0 + 256 * 1024;
constexpr size_t WS_RSTDM = WS_RQ + 256 * 1024;
constexpr size_t WS_ST1 = 3 * MiB;
constexpr size_t WS_ST2 = WS_ST1 + 2304 * 1024;
constexpr size_t WS_ST3 = WS_ST2 + 2304 * 1024;
constexpr size_t WS_W = 12 * MiB;
constexpr size_t WS_WIN = WS_W;
constexpr size_t WS_WCO = WS_WIN + (size_t)NINP * 1024 * 2;
constexpr size_t WS_WUQ = WS_WCO + 2 * MiB;
constexpr size_t WS_WUKV = WS_WUQ + (size_t)QW * 512 * 2;
constexpr size_t WS_WMO = WS_WUKV + (size_t)KVW * 256 * 2;
constexpr size_t WS_WMX = WS_WMO + 2 * MiB;
constexpr size_t WS_WQM = WS_WMX + 2 * MiB;
constexpr size_t WS_WKV = WS_WQM + 2 * MiB;
constexpr size_t WS_WOM = WS_WKV + 4 * MiB;
constexpr size_t WS_WUP = WS_WOM + 2 * MiB;
constexpr size_t WS_WDN = WS_WUP + 8 * MiB;
constexpr size_t WS_WEND = WS_WDN + 8 * MiB;
constexpr size_t WS_MB = 57 * MiB;
constexpr size_t WS_MEMK = 61 * MiB;
constexpr size_t WS_MEMV = 69 * MiB;
constexpr size_t WS_CKVB = 77 * MiB;
constexpr size_t WS_KRB = 98 * MiB;
constexpr size_t WS_R1 = 101 * MiB;
constexpr size_t WS_R2 = WS_R1 + UB;
constexpr size_t WS_R3 = WS_R2 + UB;
constexpr size_t WS_R4 = WS_R3 + UB;
constexpr size_t WS_R5 = WS_R4 + UB / 2;
constexpr size_t WS_R6 = WS_R5 + UB / 4;
constexpr size_t WS_R7 = WS_R6 + UB;
constexpr size_t WS_R8 = WS_R7 + UB;
constexpr size_t WS_END = WS_R8 + (size_t)MT * 32 * 2;
constexpr size_t WS_WP = WS_R2, WS_VP = WS_R2 + 32 * MiB;
static_assert(64 * MiB <= UB, "Wp | Vp fit R2");
constexpr size_t WS_SLAB = 477 * MiB;
static_assert(WS_WEND <= WS_MB && WS_END <= WS_SLAB && WS_SLAB + 32 * MiB <= 512 * MiB, "d_ws map");
static_assert(WS_R2 + (size_t)KVROWS * KVW * 2 <= WS_R5, "kv overlays v | g | cq");
static_assert(WS_R2 + 4 * UB <= 512 * MiB, "hmid");

constexpr size_t OUT_Y = 0;
constexpr size_t OUT_CONVP = (size_t)MT * 1024;
constexpr size_t OUT_CKVP = OUT_CONVP + 16384;
constexpr size_t OUT_KRP = OUT_CKVP + (size_t)MP * 256;
constexpr size_t OUT_MEMK = OUT_KRP + (size_t)MP * 32;
constexpr size_t OUT_MEMV = OUT_MEMK + 2097152;
constexpr size_t OUT_CONVS = OUT_MEMV + 2097152;
constexpr size_t OUT_CKVS = OUT_CONVS + 16384;
constexpr size_t OUT_KRS = OUT_CKVS + (size_t)MS * 256;
constexpr size_t OUT_TOTAL = OUT_KRS + (size_t)MS * 32;

constexpr int RING_OFF = 0, RING_BYTES = 131072;
constexpr int SCR_OFF = RING_BYTES;
constexpr int LDSCTL_OFF = SCR_OFF + 8192, MISC_OFF = LDSCTL_OFF + 320;
constexpr int LDS_BYTES = 147456;
constexpr int NWAVES = 8;

#define XB_TMO      128
#define XB_XCNT(j)  (256  + 64 * (j))
#define XB_XSUB(j)  (1280 + 64 * (j))
#define XB_XGEN(j)  (2304 + 64 * (j))
#define XB_TOP      3328
#define XB_TOPGEN   3392
#define XCD_BAR_WORDS 3456
#define XB_SPIN_CAP (1u << 20)
__device__ __forceinline__ unsigned xb_ld(unsigned* p)              { return __hip_atomic_load(p, __ATOMIC_RELAXED, __HIP_MEMORY_SCOPE_AGENT); }
__device__ __forceinline__ unsigned xb_add(unsigned* p, unsigned v) { return __hip_atomic_fetch_add(p, v, __ATOMIC_RELAXED, __HIP_MEMORY_SCOPE_AGENT); }
__device__ __forceinline__ unsigned xb_xcc_id() { return (unsigned)__builtin_amdgcn_s_getreg((3 << 11) | 20) & 0xFu; }
#define XB_SPIN(cond, bar) do { unsigned _sp = 0; while (cond) { __builtin_amdgcn_s_sleep(1); \
    if ((++_sp & 255u) == 0u) { if (xb_ld(&(bar)[XB_TMO])) break; if (_sp > XB_SPIN_CAP) { atomicAdd(&(bar)[XB_TMO], 1u); break; } } } } while (0)
struct XcdBarrier { unsigned* bar; unsigned x; volatile LAS unsigned* st; };
__device__ __forceinline__ XcdBarrier xcd_barrier_post(unsigned* bar, volatile LAS unsigned* st) {
    XcdBarrier b; b.bar = bar; b.x = xb_xcc_id(); b.st = st;
    if (threadIdx.x == 0) (void)xb_add(&bar[XB_XCNT(b.x)], 1u);
    return b;
}
__device__ __forceinline__ void xcd_barrier_complete(unsigned* bar, unsigned x, unsigned& nloc, unsigned& nx) {
    const unsigned G = gridDim.x * gridDim.y * gridDim.z;
    unsigned sum, cnt, mine, sp = 0u;
    for (;;) {
        sum = 0u; cnt = 0u; mine = 0u;
#pragma unroll
        for (unsigned j = 0; j < 16; ++j) { const unsigned c = xb_ld(&bar[XB_XCNT(j)]); sum += c; cnt += (c > 0u) ? 1u : 0u; mine = (j == x) ? c : mine; }
        if (sum == G) break;
        __builtin_amdgcn_s_sleep(1);
        if ((++sp & 255u) == 0u) { if (xb_ld(&bar[XB_TMO])) break; if (sp > XB_SPIN_CAP) { atomicAdd(&bar[XB_TMO], 1u); break; } }
    }
    nloc = mine > 0u ? mine : 1u; nx = cnt > 0u ? cnt : 1u;
}
__device__ __forceinline__ void xcd_barrier(const XcdBarrier& b) {
    asm volatile("s_waitcnt vmcnt(0)" ::: "memory");
    __syncthreads();
    if (threadIdx.x == 0) {
        unsigned* bar = b.bar;
        __builtin_amdgcn_s_waitcnt(0);
        unsigned nloc = b.st[0], nx = b.st[1];
        if (nloc == 0u) { xcd_barrier_complete(bar, b.x, nloc, nx); b.st[0] = nloc; b.st[1] = nx; }
        const unsigned old = xb_add(&bar[XB_XSUB(b.x)], 1u);
        const unsigned gen = old / nloc;
        if (old + 1u == (gen + 1u) * nloc) {
            __builtin_amdgcn_fence(__ATOMIC_RELEASE, "agent");
            asm volatile("s_waitcnt vmcnt(0)" ::: "memory");
            const unsigned og = xb_add(&bar[XB_TOP], 1u);
            const unsigned tg = og / nx;
            if (og + 1u == (tg + 1u) * nx) xb_add(&bar[XB_TOPGEN], 1u);
            else XB_SPIN(xb_ld(&bar[XB_TOPGEN]) == tg, bar);
            __builtin_amdgcn_fence(__ATOMIC_ACQUIRE, "agent");
            xb_add(&bar[XB_XGEN(b.x)], 1u);
            asm volatile("s_waitcnt vmcnt(0)" ::: "memory");
        } else {
            XB_SPIN(xb_ld(&bar[XB_XGEN(b.x)]) == gen, bar);
            __builtin_amdgcn_fence(__ATOMIC_ACQUIRE, "agent");
            asm volatile("s_waitcnt vmcnt(0)" ::: "memory");
        }
    }
    __syncthreads();
}

namespace pg8 {
#define EPI_ROWS(ai, m) (u.pm * 256 + (ai) * 128 + wr * 64 + (m) * 16 + fr)
#define FOR_AI_M _Pragma("unroll") for (int ai = 0; ai < 2; ++ai) _Pragma("unroll") for (int m = 0; m < 4; ++m) if ((rowmask >> (ai * 4 + m)) & 1u)

struct EpiIn {
    const float* rstd0; bf16_t *v, *Bg, *cq, *ckvraw, *sigc, *siga;
    static __device__ __forceinline__ void plain(const Acc& acc, bf16_t* dst, int ld, int ai, int m, float rs) {
#pragma unroll
        for (int bj = 0; bj < 2; ++bj) *(u32x4*)(dst + bj * 128) = pack8(acc[ai][bj][m][0] * rs, acc[ai][bj][m][1] * rs);
    }
    static __device__ __forceinline__ void sigm(const Acc& acc, bf16_t* dst, int ai, int m, float rs) {
#pragma unroll
        for (int bj = 0; bj < 2; ++bj) { f32x4 a = acc[ai][bj][m][0] * rs, b = acc[ai][bj][m][1] * rs;
#pragma unroll
            for (int e = 0; e < 4; ++e) { a[e] = fast_sigmoid(a[e]); b[e] = fast_sigmoid(b[e]); }
            *(u32x4*)(dst + bj * 128) = pack8(a, b); }
    }
    __device__ __forceinline__ void operator()(Acc& acc, const Unit& u, int wr, int wc, int fr, int fq, unsigned rowmask = 0xffu) const {
        const int pn = u.pn, cw = wc * 32 + 8 * fq;
        FOR_AI_M {
            const int r = EPI_ROWS(ai, m); const float rs = rstd0[r];
            if (pn < 8) {
                const float rs2 = rs * rs;
                *(u32x4*)(v + (size_t)r * 1024 + pn * 128 + cw) = pack8(acc[ai][0][m][0] * acc[ai][1][m][0] * rs2, acc[ai][0][m][1] * acc[ai][1][m][1] * rs2);
            } else if (pn < 12) { plain(acc, Bg + (size_t)r * 1024 + (pn - 8) * 256 + cw, 1024, ai, m, rs);
            } else if (pn < 14) { plain(acc, cq + (size_t)r * 512 + (pn - 12) * 256 + cw, 512, ai, m, rs);
            } else if (pn < 15) { plain(acc, ckvraw + (size_t)r * 256 + cw, 256, ai, m, rs);
            } else if (pn < 19) { sigm(acc, sigc + (size_t)r * 1024 + (pn - 15) * 256 + cw, ai, m, rs);
            } else { sigm(acc, siga + (size_t)r * 1024 + (pn - 19) * 256 + cw, ai, m, rs); }
        }
    }
};
struct EpiMemKV {
    const float* rstdm; float *outk, *outv; bf16_t *memk, *memv;
    __device__ __forceinline__ void operator()(Acc& acc, const Unit& u, int wr, int wc, int fr, int fq, unsigned rowmask = 0xffu) const {
        const bool isk = u.pn < 4; const int c0 = (u.pn & 3) * 256 + wc * 32 + 8 * fq; float* out = isk ? outk : outv; bf16_t* cp = isk ? memk : memv;
        FOR_AI_M {
            const int r = EPI_ROWS(ai, m); const float rs = rstdm[r];
#pragma unroll
            for (int bj = 0; bj < 2; ++bj) { const f32x4 a = acc[ai][bj][m][0] * rs, b = acc[ai][bj][m][1] * rs; const size_t off = (size_t)r * 1024 + c0 + bj * 128;
                *(f32x4*)(out + off) = a; *(f32x4*)(out + off + 4) = b; *(u32x4*)(cp + off) = pack8(a, b); }
        }
    }
};
struct EpiGate {
    bf16_t* buf;
    __device__ __forceinline__ void operator()(Acc& acc, const Unit& u, int wr, int wc, int fr, int fq, unsigned rowmask = 0xffu) const {
        const int c0 = u.pn * 256 + wc * 32 + 8 * fq;
        FOR_AI_M { const int r = EPI_ROWS(ai, m);
#pragma unroll
            for (int bj = 0; bj < 2; ++bj) { bf16_t* p = buf + (size_t)r * 1024 + c0 + bj * 128; f32x4 a, b; unpack8(*(const u32x4*)p, a, b);
                *(u32x4*)p = pack8(a * acc[ai][bj][m][0], b * acc[ai][bj][m][1]); } }
    }
};
struct EpiMix {
    const bf16_t* ya; bf16_t* buf;
    __device__ __forceinline__ void operator()(Acc& acc, const Unit& u, int wr, int wc, int fr, int fq, unsigned rowmask = 0xffu) const {
        const int c0 = u.pn * 256 + wc * 32 + 8 * fq;
        FOR_AI_M { const int r = EPI_ROWS(ai, m);
#pragma unroll
            for (int bj = 0; bj < 2; ++bj) { const size_t off = (size_t)r * 1024 + c0 + bj * 128; f32x4 a, b, ya0, ya1; unpack8(*(const u32x4*)(buf + off), a, b); unpack8(*(const u32x4*)(ya + off), ya0, ya1);
                *(u32x4*)(buf + off) = pack8(ya0 + a * acc[ai][bj][m][0], ya1 + b * acc[ai][bj][m][1]); } }
    }
};
struct EpiQ {
    const float* rq; const f32x2* tab; bf16_t* q;
    __device__ __forceinline__ void operator()(Acc& acc, const Unit& u, int wr, int wc, int fr, int fq, unsigned rowmask = 0xffu) const {
        FOR_AI_M {
            const int r = EPI_ROWS(ai, m); const float rs = rq[r];
            const int pos = r < MP ? (r & (SEQ - 1)) : PAST + ((r - MP) & (DSEQ - 1));
#pragma unroll
            for (int bj = 0; bj < 2; ++bj) {
                const int g = u.pn * 8 + bj * 4 + wc;
                f32x4 a = acc[ai][bj][m][0] * rs, b = acc[ai][bj][m][1] * rs;
                if (g % 3 == 2) {
                    const f32x2* t = tab + pos * 16 + 8 * (fq & 1);
                    const float sgn = fq < 2 ? -1.f : 1.f;
#pragma unroll
                    for (int e = 0; e < 4; ++e) { const f32x2 cs0 = t[e], cs1 = t[4 + e];
                        const float pa = shx(a[e], 32), pb = shx(b[e], 32);
                        a[e] = a[e] * cs0.x + sgn * pa * cs0.y; b[e] = b[e] * cs1.x + sgn * pb * cs1.y; }
                }
                *(u32x4*)(q + (size_t)r * QW + g * 32 + 8 * fq) = pack8(a * QSCALE, b * QSCALE);
            }
        }
    }
};
struct EpiPlain {
    bf16_t* out; int ld;
    __device__ __forceinline__ void operator()(Acc& acc, const Unit& u, int wr, int wc, int fr, int fq, unsigned rowmask = 0xffu) const {
        const int c0 = u.pn * 256 + wc * 32 + 8 * fq;
        FOR_AI_M { const int r = EPI_ROWS(ai, m);
#pragma unroll
            for (int bj = 0; bj < 2; ++bj) *(u32x4*)(out + (size_t)r * ld + c0 + bj * 128) = pack8(acc[ai][bj][m][0], acc[ai][bj][m][1]); }
    }
};
struct EpiRes {
    const float* xold_p; const float* xold_s; float* xout; bf16_t* xb; float* stats;
    __device__ __forceinline__ void operator()(Acc& acc, const Unit& u, int wr, int wc, int fr, int fq, unsigned rowmask = 0xffu) const {
        const int c0 = u.pn * 256 + wc * 32 + 8 * fq;
        FOR_AI_M { const int r = EPI_ROWS(ai, m); const float* xo = r < MP ? xold_p + (size_t)r * 1024 : xold_s + (size_t)(r - MP) * 1024; float ss = 0.f;
#pragma unroll
            for (int bj = 0; bj < 2; ++bj) { const int c = c0 + bj * 128; const f32x4 a = *(const f32x4*)(xo + c) + acc[ai][bj][m][0], b = *(const f32x4*)(xo + c + 4) + acc[ai][bj][m][1];
                *(f32x4*)(xout + (size_t)r * 1024 + c) = a; *(f32x4*)(xout + (size_t)r * 1024 + c + 4) = b;
                if (xb) *(u32x4*)(xb + (size_t)r * 1024 + c) = pack8(a, b);
                ss += (a[0] * a[0] + a[1] * a[1]) + (a[2] * a[2] + a[3] * a[3]) + (b[0] * b[0] + b[1] * b[1]) + (b[2] * b[2] + b[3] * b[3]); }
            ss += shx(ss, 16); ss += shx(ss, 32);
            if (fq == 0) stats[(size_t)r * 16 + u.pn * 4 + wc] = ss; }
    }
};
struct EpiResFinal {
    const float* xold_p; const float* xold_s; float* out; float* stats; unsigned* cnt; const float* gfin;
    __device__ __forceinline__ void operator()(Acc& acc, const Unit& u, int wr, int wc, int fr, int fq, unsigned rowmask = 0xffu) const {
        const int c0 = u.pn * 256 + wc * 32 + 8 * fq;
        FOR_AI_M { const int r = EPI_ROWS(ai, m); const float* xo = r < MP ? xold_p + (size_t)r * 1024 : xold_s + (size_t)(r - MP) * 1024; float ss = 0.f;
#pragma unroll
            for (int bj = 0; bj < 2; ++bj) { const int c = c0 + bj * 128; const f32x4 a = *(const f32x4*)(xo + c) + acc[ai][bj][m][0], b = *(const f32x4*)(xo + c + 4) + acc[ai][bj][m][1];
                acc[ai][bj][m][0] = a; acc[ai][bj][m][1] = b;
                ss += (a[0] * a[0] + a[1] * a[1]) + (a[2] * a[2] + a[3] * a[3]) + (b[0] * b[0] + b[1] * b[1]) + (b[2] * b[2] + b[3] * b[3]); }
            ss += shx(ss, 16); ss += shx(ss, 32);
            if (fq == 0) __hip_atomic_store(stats + (size_t)r * 16 + u.pn * 4 + wc, ss, __ATOMIC_RELAXED, __HIP_MEMORY_SCOPE_AGENT); }
        asm volatile("s_waitcnt vmcnt(0)" ::: "memory"); __builtin_amdgcn_s_barrier(); asm volatile("" ::: "memory");
        if (threadIdx.x == 0) { unsigned* cw = cnt + u.pm * 8 + __builtin_ctz(rowmask);
            (void)__hip_atomic_fetch_add(cw, 1u, __ATOMIC_RELAXED, __HIP_MEMORY_SCOPE_AGENT);
            unsigned sp = 0u; while (__hip_atomic_load(cw, __ATOMIC_RELAXED, __HIP_MEMORY_SCOPE_AGENT) < 4u) { __builtin_amdgcn_s_sleep(2); if (++sp > (1u << 22)) break; } }
        asm volatile("s_waitcnt vmcnt(0)" ::: "memory"); __builtin_amdgcn_s_barrier(); asm volatile("" ::: "memory");
        const __amdgpu_buffer_rsrc_t rs = __builtin_amdgcn_make_buffer_rsrc((void*)stats, (short)0, MT * 64, 0x00020000);
        FOR_AI_M { const int r = EPI_ROWS(ai, m);
            const f32x4 s0 = __builtin_bit_cast(f32x4, __builtin_amdgcn_raw_buffer_load_b128(rs, r * 64, 0, 16)), s1 = __builtin_bit_cast(f32x4, __builtin_amdgcn_raw_buffer_load_b128(rs, r * 64 + 16, 0, 16)),
                        s2 = __builtin_bit_cast(f32x4, __builtin_amdgcn_raw_buffer_load_b128(rs, r * 64 + 32, 0, 16)), s3 = __builtin_bit_cast(f32x4, __builtin_amdgcn_raw_buffer_load_b128(rs, r * 64 + 48, 0, 16));
            const float t = ((s0[0] + s0[1]) + (s0[2] + s0[3])) + ((s1[0] + s1[1]) + (s1[2] + s1[3])) + ((s2[0] + s2[1]) + (s2[2] + s2[3])) + ((s3[0] + s3[1]) + (s3[2] + s3[3]));
            const float rsd = __builtin_amdgcn_rsqf(t * (1.0f / 1024.0f) + EPS);
#pragma unroll
            for (int bj = 0; bj < 2; ++bj) { const int c = c0 + bj * 128; const f32x4 g0 = *(const f32x4*)(gfin + c), g1 = *(const f32x4*)(gfin + c + 4);
                *(f32x4*)(out + (size_t)r * 1024 + c) = acc[ai][bj][m][0] * rsd * g0; *(f32x4*)(out + (size_t)r * 1024 + c + 4) = acc[ai][bj][m][1] * rsd * g1; } }
    }
};
__device__ __forceinline__ float row_rstd(const float* stats, int r) {
    const f32x4* s = (const f32x4*)(stats + (size_t)r * 16); const f32x4 a = s[0], b = s[1], c = s[2], d = s[3];
    const float t = ((a[0] + a[1]) + (a[2] + a[3])) + ((b[0] + b[1]) + (b[2] + b[3])) + ((c[0] + c[1]) + (c[2] + c[3])) + ((d[0] + d[1]) + (d[2] + d[3]));
    return __builtin_amdgcn_rsqf(t * (1.0f / 1024.0f) + EPS);
}
template <int ACT> struct EpiNormAct {
    const float* stats; bf16_t* out; int ld; float scale; unsigned rt, pmt;
    __device__ __forceinline__ void operator()(Acc& acc, const Unit& u, int wr, int wc, int fr, int fq, unsigned rowmask = 0xffu) const {
        const int c0 = u.pn * 256 + wc * 32 + 8 * fq;
        int slot = -1;
#pragma unroll
        for (int k = 0; k < 8; ++k) slot = (*reinterpret_cast<const LAS int*>(pmt + 4 * k) == u.pm) ? k : slot;
        slot = __builtin_amdgcn_readfirstlane(slot);
        if (slot >= 0) {
            const LAS float* rp = reinterpret_cast<const LAS float*>(rt + (unsigned)(slot * 256 + wr * 64 + fr) * 4u);
            FOR_AI_M { const int r = EPI_ROWS(ai, m); const float rs = rp[ai * 128 + m * 16] * scale;
#pragma unroll
                for (int bj = 0; bj < 2; ++bj) { f32x4 a = acc[ai][bj][m][0] * rs, b = acc[ai][bj][m][1] * rs;
                    if (ACT == 1) {
#pragma unroll
                        for (int e = 0; e < 4; ++e) { const float x = fmaxf(a[e], 0.f), y = fmaxf(b[e], 0.f); a[e] = x * x; b[e] = y * y; } }
                    *(u32x4*)(out + (size_t)r * ld + c0 + bj * 128) = pack8(a, b); } }
        } else {
            FOR_AI_M { const int r = EPI_ROWS(ai, m); const float rs = row_rstd(stats, r) * scale;
#pragma unroll
                for (int bj = 0; bj < 2; ++bj) { f32x4 a = acc[ai][bj][m][0] * rs, b = acc[ai][bj][m][1] * rs;
                    if (ACT == 1) {
#pragma unroll
                        for (int e = 0; e < 4; ++e) { const float x = fmaxf(a[e], 0.f), y = fmaxf(b[e], 0.f); a[e] = x * x; b[e] = y * y; } }
                    *(u32x4*)(out + (size_t)r * ld + c0 + bj * 128) = pack8(a, b); } }
        }
    }
};

__device__ __forceinline__ int ma_row0(int pm) { return pm < 128 ? pm * 256 : MP + (pm - 128) * DSEQ; }
__device__ __forceinline__ int ma_batch(int pm) { return pm < 128 ? pm >> 4 : 8 + (pm - 128); }
struct ProbMA {
    const bf16_t* A; const bf16_t* W; int K, lda, ldb;
    __device__ __forceinline__ const char* aptr(const Unit& u) const { return (const char*)(A + (size_t)ma_row0(u.pm) * 1024); }
    __device__ __forceinline__ const char* bptr(const Unit& u) const { return (const char*)(W + ((size_t)ma_batch(u.pm) * 1024 + u.pn * 256) * 1024); }
};
struct PreOrder {
    int G, c;
    __device__ __forceinline__ bool next(int i, Unit& u) const { const int L = i * G + c; u.pm = L >> 2; u.pn = L & 3; return c >= 0 && L < 256; }
};
struct ProbWp {
    const bf16_t* memk; const bf16_t* wqg; int K, lda, ldb;
    __device__ __forceinline__ const char* aptr(const Unit& u) const { return (const char*)(memk + (size_t)((u.pm >> 2) * 256) * 1024 + (u.pm & 3) * 256); }
    __device__ __forceinline__ const char* bptr(const Unit& u) const { return (const char*)(wqg + (size_t)(u.pn * 256) * 1024 + (u.pm & 3) * 256); }
};
struct ProbVp {
    const bf16_t* womt; const bf16_t* memv; int K, lda, ldb;
    __device__ __forceinline__ const char* aptr(const Unit& u) const { return (const char*)(womt + (size_t)((u.pm & 3) * 256) * 1024 + u.pn * 256); }
    __device__ __forceinline__ const char* bptr(const Unit& u) const { return (const char*)(memv + (size_t)((u.pm >> 2) * 256) * 1024 + u.pn * 256); }
};
struct EpiSoftmaxS {
    const float* stats; float scale; bf16_t* P; LAS float* scr; unsigned rt, pmt;
    __device__ __forceinline__ void operator()(Acc& acc, const Unit& u, int wr, int wc, int fr, int fq, unsigned rowmask = 0xffu) const {
        const int row0 = ma_row0(u.pm), valid = u.pm < 128 ? 256 : DSEQ;
        int slot = -1;
#pragma unroll
        for (int k = 0; k < 8; ++k) slot = (*reinterpret_cast<const LAS int*>(pmt + 4 * k) == u.pm) ? k : slot;
        slot = __builtin_amdgcn_readfirstlane(slot);
        const LAS float* rp = reinterpret_cast<const LAS float*>(rt + (unsigned)((slot < 0 ? 0 : slot) * 256) * 4u);
        FOR_AI_M { const int lr = ai * 128 + wr * 64 + m * 16 + fr; const int rr = row0 + lr < MT ? row0 + lr : MT - 1; const float rs = (slot >= 0 ? rp[lr] : row_rstd(stats, rr)) * scale; float mx = -3.0e38f;
#pragma unroll
            for (int bj = 0; bj < 2; ++bj)
#pragma unroll
                for (int n = 0; n < 2; ++n) { acc[ai][bj][m][n] = acc[ai][bj][m][n] * rs;
#pragma unroll
                    for (int e = 0; e < 4; ++e) mx = fmaxf(mx, acc[ai][bj][m][n][e]); }
            mx = fmaxf(mx, shx(mx, 16)); mx = fmaxf(mx, shx(mx, 32));
            if (fq == 0) scr[lr * 4 + wc] = mx; }
        asm volatile("s_waitcnt lgkmcnt(0)" ::: "memory"); __builtin_amdgcn_s_barrier(); asm volatile("" ::: "memory");
        FOR_AI_M { const int lr = ai * 128 + wr * 64 + m * 16 + fr; const f32x4 q = *(const LAS f32x4*)(scr + lr * 4); const float mx = fmaxf(fmaxf(q[0], q[1]), fmaxf(q[2], q[3])); float sm = 0.f;
#pragma unroll
            for (int bj = 0; bj < 2; ++bj)
#pragma unroll
                for (int n = 0; n < 2; ++n)
#pragma unroll
                    for (int e = 0; e < 4; ++e) { const float p = __builtin_amdgcn_exp2f(acc[ai][bj][m][n][e] - mx); acc[ai][bj][m][n][e] = p; sm += p; }
            sm += shx(sm, 16); sm += shx(sm, 32);
            if (fq == 0) scr[1024 + lr * 4 + wc] = sm; }
        asm volatile("s_waitcnt lgkmcnt(0)" ::: "memory"); __builtin_amdgcn_s_barrier(); asm volatile("" ::: "memory");
        FOR_AI_M { const int lr = ai * 128 + wr * 64 + m * 16 + fr; const f32x4 q = *(const LAS f32x4*)(scr + 1024 + lr * 4); const float inv = __builtin_amdgcn_rcpf((q[0] + q[1]) + (q[2] + q[3]));
            if (lr < valid) {
#pragma unroll
                for (int bj = 0; bj < 2; ++bj) *(u32x4*)(P + (size_t)(row0 + lr) * 1024 + u.pn * 256 + bj * 128 + wc * 32 + 8 * fq) = pack8(acc[ai][bj][m][0] * inv, acc[ai][bj][m][1] * inv); } }
    }
};
struct EpiResM {
    float* x; bf16_t* xb; float* stats;
    __device__ __forceinline__ void operator()(Acc& acc, const Unit& u, int wr, int wc, int fr, int fq, unsigned rowmask = 0xffu) const {
        const int row0 = ma_row0(u.pm), valid = u.pm < 128 ? 256 : DSEQ; const int c0 = u.pn * 256 + wc * 32 + 8 * fq;
        FOR_AI_M { const int lr = ai * 128 + wr * 64 + m * 16 + fr; const bool ok = lr < valid; const int r = ok ? row0 + lr : row0; float* xr = x + (size_t)r * 1024; float ss = 0.f;
#pragma unroll
            for (int bj = 0; bj < 2; ++bj) { const int c = c0 + bj * 128; const f32x4 a = *(const f32x4*)(xr + c) + acc[ai][bj][m][0], b = *(const f32x4*)(xr + c + 4) + acc[ai][bj][m][1];
                if (ok) { *(f32x4*)(xr + c) = a; *(f32x4*)(xr + c + 4) = b; *(u32x4*)(xb + (size_t)r * 1024 + c) = pack8(a, b); }
                ss += (a[0] * a[0] + a[1] * a[1]) + (a[2] * a[2] + a[3] * a[3]) + (b[0] * b[0] + b[1] * b[1]) + (b[2] * b[2] + b[3] * b[3]); }
            ss += shx(ss, 16); ss += shx(ss, 32);
            if (fq == 0 && ok) stats[(size_t)r * 16 + u.pn * 4 + wc] = ss; }
    }
};
#undef EPI_ROWS
#undef FOR_AI_M
}

namespace attn {
constexpr int NSLOT = 4, NOPE_B = 0, ROPE_B = NSLOT * 8192, V_B = ROPE_B + NSLOT * 4096;
constexpr int QR_OFF = V_B + NSLOT * 8192;
__device__ __forceinline__ void glds16(const void* sbase, unsigned voff, unsigned lds_dst) { unsigned keep;
    asm volatile("s_mov_b32 %0, m0\n\ts_mov_b32 m0, %3\n\ts_nop 0\n\tglobal_load_lds_dwordx4 %1, %2\n\ts_mov_b32 m0, %0" : "=&s"(keep) : "v"(voff), "s"(sbase), "s"(lds_dst) : "memory"); }
__device__ __forceinline__ s16x4 vtr(const LAS unsigned char* p) { return __builtin_bit_cast(s16x4, __builtin_amdgcn_ds_read_tr16_b64_v4i16((LAS s16x4*)p)); }
struct Unit { int qrow0, kvrow0, h, ntiles, lim_base, lim_step, nwq; };

__device__ __forceinline__ float row_max32(const f32x16& p0, const f32x16& p1) {
    float a = fmaxf(fmaxf(p0[0], p0[1]), p1[0]), b = fmaxf(fmaxf(p0[2], p0[3]), p1[1]); a = fmaxf(fmaxf(a, p1[2]), p1[3]);
#pragma unroll
    for (int r = 4; r < 16; r += 4) { a = fmaxf(fmaxf(a, p0[r]), p0[r + 1]); b = fmaxf(fmaxf(b, p0[r + 2]), p0[r + 3]); a = fmaxf(fmaxf(a, p1[r]), p1[r + 1]); b = fmaxf(fmaxf(b, p1[r + 2]), p1[r + 3]); }
    const float m = fmaxf(a, b);
    auto rr = __builtin_amdgcn_permlane32_swap(__float_as_uint(m), __float_as_uint(m), false, false);
    return fmaxf(__uint_as_float(rr[0]), __uint_as_float(rr[1]));
}
__device__ __forceinline__ void kfrag(bf16x8& a0, bf16x8& a1, int d0, const unsigned (&ka)[6], int ko) {
    if (d0 < 4) { a0 = *reinterpret_cast<const LAS bf16x8*>(ka[d0] + ko); a1 = *reinterpret_cast<const LAS bf16x8*>(ka[d0] + ko + 32 * 128); }
    else { a0 = *reinterpret_cast<const LAS bf16x8*>(ka[d0] + (ko >> 1)); a1 = *reinterpret_cast<const LAS bf16x8*>(ka[d0] + (ko >> 1) + 32 * 64); }
}
struct NoDma { __device__ __forceinline__ void operator()() const {} };
template <bool DO_QK, class Dma = NoDma>
__device__ __forceinline__ void step(f32x16& pn0, f32x16& pn1, f32x16& pc0, f32x16& pc1, f32x16& o0, f32x16& o1, float& lrun, const bf16x8 qmf, const bf16x8 kneg,
                                     const unsigned (&ka)[6], int ko, const LAS unsigned char* vb, const bf16x8 (&qf)[4], const LAS unsigned char* qr, const Dma& dma = Dma()) {
    bf16x8 fa[2][2];
    if (DO_QK) kfrag(fa[0][0], fa[0][1], 0, ka, ko);
    __builtin_amdgcn_s_setprio(1);
#pragma unroll
    for (int d0 = 0; d0 < 6; ++d0) {
        if (DO_QK) {
            if (d0 + 1 < 6) kfrag(fa[(d0 + 1) & 1][0], fa[(d0 + 1) & 1][1], d0 + 1, ka, ko);
            const bf16x8 qd = d0 < 4 ? qf[d0 < 4 ? d0 : 0] : *(const LAS bf16x8*)(qr + (d0 - 4) * 16);
            if (d0 == 0) { const f32x16 z = {}; pn0 = __builtin_amdgcn_mfma_f32_32x32x16_bf16(fa[0][0], qd, z, 0, 0, 0); pn1 = __builtin_amdgcn_mfma_f32_32x32x16_bf16(fa[0][1], qd, z, 0, 0, 0); }
            else { pn0 = __builtin_amdgcn_mfma_f32_32x32x16_bf16(fa[d0 & 1][0], qd, pn0, 0, 0, 0); pn1 = __builtin_amdgcn_mfma_f32_32x32x16_bf16(fa[d0 & 1][1], qd, pn1, 0, 0, 0); }
        }
        if (d0 == 1) dma();
#pragma unroll
        for (int r = (16 * d0) / 6; r < (16 * (d0 + 1)) / 6; ++r) { pc0[r] = __builtin_amdgcn_exp2f(pc0[r]); pc1[r] = __builtin_amdgcn_exp2f(pc1[r]); }
        asm volatile("" ::: "memory");
    }
    if (DO_QK) {
        pn0 = __builtin_amdgcn_mfma_f32_32x32x16_bf16(kneg, qmf, pn0, 0, 0, 0); pn1 = __builtin_amdgcn_mfma_f32_32x32x16_bf16(kneg, qmf, pn1, 0, 0, 0); }
    { float one = 1.0f; asm volatile("" : "+s"(one));
      float sa = pc0[0], sb = pc1[0];
#pragma unroll
      for (int r = 1; r < 16; ++r) { sa = sa + pc0[r]; sb = __builtin_fmaf(pc1[r], one, sb); }
      lrun += sa + sb; }
    u32x4 pw[4];
    pw[0] = (u32x4){cvt_pk_bf16(pc0[0], pc0[1]), cvt_pk_bf16(pc0[2], pc0[3]), cvt_pk_bf16(pc0[4], pc0[5]), cvt_pk_bf16(pc0[6], pc0[7])};
    pw[1] = (u32x4){cvt_pk_bf16(pc0[8], pc0[9]), cvt_pk_bf16(pc0[10], pc0[11]), cvt_pk_bf16(pc0[12], pc0[13]), cvt_pk_bf16(pc0[14], pc0[15])};
    pw[2] = (u32x4){cvt_pk_bf16(pc1[0], pc1[1]), cvt_pk_bf16(pc1[2], pc1[3]), cvt_pk_bf16(pc1[4], pc1[5]), cvt_pk_bf16(pc1[6], pc1[7])};
    pw[3] = (u32x4){cvt_pk_bf16(pc1[8], pc1[9]), cvt_pk_bf16(pc1[10], pc1[11]), cvt_pk_bf16(pc1[12], pc1[13]), cvt_pk_bf16(pc1[14], pc1[15])};
    s16x4 vl[2][4];
    vl[0][0] = vtr(vb); vl[0][1] = vtr(vb + 512); vl[0][2] = vtr(vb + 4096); vl[0][3] = vtr(vb + 4096 + 512);
#pragma unroll
    for (int ks = 0; ks < 4; ++ks) {
        if (ks + 1 < 4) { const int n = (ks + 1) & 1; vl[n][0] = vtr(vb + (ks + 1) * 1024); vl[n][1] = vtr(vb + (ks + 1) * 1024 + 512); vl[n][2] = vtr(vb + 4096 + (ks + 1) * 1024); vl[n][3] = vtr(vb + 4096 + (ks + 1) * 1024 + 512); }
        const int c = ks & 1; const bf16x8 pb = __builtin_bit_cast(bf16x8, pw[ks]);
        const bf16x8 v0 = (bf16x8){vl[c][0][0], vl[c][0][1], vl[c][0][2], vl[c][0][3], vl[c][1][0], vl[c][1][1], vl[c][1][2], vl[c][1][3]};
        const bf16x8 v1 = (bf16x8){vl[c][2][0], vl[c][2][1], vl[c][2][2], vl[c][2][3], vl[c][3][0], vl[c][3][1], vl[c][3][2], vl[c][3][3]};
        o0 = __builtin_amdgcn_mfma_f32_32x32x16_bf16(v0, pb, o0, 0, 0, 0);
        o1 = __builtin_amdgcn_mfma_f32_32x32x16_bf16(v1, pb, o1, 0, 0, 0);
        asm volatile("" ::: "memory");
    }
    __builtin_amdgcn_s_setprio(0);
}
__device__ __forceinline__ bf16x8 mfrag(float m, int hi) {
    const unsigned h = cvt_pk_bf16(m, 0.f) & 0xffffu; const float mh = __builtin_bit_cast(float, h << 16); const unsigned l = cvt_pk_bf16(m - mh, 0.f) & 0xffffu;
    const unsigned w = hi ? 0u : (h | (l << 16));
    return __builtin_bit_cast(bf16x8, (u32x4){w, 0u, 0u, 0u});
}
constexpr float ATT_BIG = 1099511627776.0f;
__device__ __forceinline__ void rebase(f32x16& p0, f32x16& p1, f32x16& o0, f32x16& o1, float& lrun, float& mrun, bf16x8& qmf, int hi) {
    if (__builtin_amdgcn_ballot_w64(lrun > ATT_BIG) != 0ull) {
        auto rr = __builtin_amdgcn_permlane32_swap(__float_as_uint(lrun), __float_as_uint(lrun), false, false);
        const float lt = __uint_as_float(rr[0]) + __uint_as_float(rr[1]);
        const int e = __builtin_amdgcn_frexp_expf(lt) - 1;
        const int d = e > 0 ? e : 0; const float delta = (float)d, alpha = __builtin_amdgcn_ldexpf(1.0f, -d); mrun += delta; lrun *= alpha; qmf = mfrag(mrun, hi);
#pragma unroll
        for (int r = 0; r < 16; ++r) { p0[r] -= delta; p1[r] -= delta; o0[r] *= alpha; o1[r] *= alpha; }
    }
}
__device__ __forceinline__ void unit(const Unit& U, const bf16_t* __restrict__ Q, const bf16_t* __restrict__ KV, const bf16_t* __restrict__ KR, bf16_t* __restrict__ O, LAS unsigned char* lds) {
    int tid_ = threadIdx.x; asm volatile("" : "+v"(tid_));
    const int tid = tid_, lane = tid & 63, r32 = lane & 31, hi = lane >> 5; const int wid = __builtin_amdgcn_readfirstlane(tid >> 6);
    const bool active = wid < U.nwq; const int mylim = active ? U.lim_base + (wid >> 1) * U.lim_step : 0;
    const int nr = wid * 8 + (lane >> 3), rr = wid * 8 + ((lane & 31) >> 2), vr = 16 * (wid & 3) + (lane >> 2);
    const unsigned voffN = (unsigned)(((U.kvrow0 + nr) * KVW + U.h * 128 + 8 * ((lane & 7) ^ ((nr >> 1) & 7))) * 2);
    const unsigned voffR = (unsigned)(((U.kvrow0 + rr) * 32 + 8 * ((lane & 3) ^ ((rr >> 2) & 3))) * 2);
    const unsigned voffV = (unsigned)(((U.kvrow0 + vr) * KVW + U.h * 128 + 64 + (wid >> 2) * 32 + 8 * (lane & 3)) * 2);
    const unsigned lds0 = (unsigned)(size_t)lds;
#define ATT_DMAS(t, s) do { if (wid < 4) { const char* kvb_ = (const char*)KV + (size_t)(t) * (64 * KVW * 2); const char* krb_ = (const char*)KR + (size_t)(t) * (64 * 32 * 2); \
          \
          \
        glds16(kvb_, voffN, (unsigned)__builtin_amdgcn_readfirstlane(lds0 + NOPE_B + (s) * 8192 + wid * 1024)); \
        glds16(kvb_ + 32 * KVW * 2, voffN, (unsigned)__builtin_amdgcn_readfirstlane(lds0 + NOPE_B + (s) * 8192 + (wid + 4) * 1024)); \
        glds16(kvb_, voffV, (unsigned)__builtin_amdgcn_readfirstlane(lds0 + V_B + (s) * 8192 + wid * 1024)); \
        glds16(kvb_ + 64, voffV, (unsigned)__builtin_amdgcn_readfirstlane(lds0 + V_B + (s) * 8192 + (wid + 4) * 1024)); \
        if (lane < 32) { glds16(krb_, voffR, (unsigned)__builtin_amdgcn_readfirstlane(lds0 + ROPE_B + (s) * 4096 + wid * 512)); \
                         glds16(krb_ + 32 * 64, voffR, (unsigned)__builtin_amdgcn_readfirstlane(lds0 + ROPE_B + (s) * 4096 + (wid + 4) * 512)); } } } while (0)
#define ATT_DMA(t) ATT_DMAS(t, (t) & 3)
    ATT_DMA(0); ATT_DMA(1); ATT_DMA(2);
    bf16x8 qf[4], qr4 = (bf16x8){0, 0, 0, 0, 0, 0, 0, 0}, qr5 = qr4;
    if (active) {
        const bf16_t* qp = Q + (size_t)(U.qrow0 + wid * 32 + r32) * QW + U.h * 96 + hi * 8;
#pragma unroll
        for (int d0 = 0; d0 < 4; ++d0) qf[d0] = *(const bf16x8*)(qp + d0 * 16);
        qr4 = *(const bf16x8*)(qp + 64); qr5 = *(const bf16x8*)(qp + 80);
    } else {
#pragma unroll
        for (int d0 = 0; d0 < 4; ++d0) qf[d0] = (bf16x8){0, 0, 0, 0, 0, 0, 0, 0};
    }
    const LAS unsigned char* qr = lds + QR_OFF + tid * 32;
    *(LAS bf16x8*)(lds + QR_OFF + tid * 32) = qr4; *(LAS bf16x8*)(lds + QR_OFF + tid * 32 + 16) = qr5;
    float mrun = 0.f, lrun = 0.f; f32x16 o0 = {}, o1 = {}, pA0 = {}, pA1 = {}, pB0 = {}, pB1 = {};
    bf16x8 qmf = (bf16x8){0, 0, 0, 0, 0, 0, 0, 0}; const bf16x8 kneg = __builtin_bit_cast(bf16x8, (u32x4){hi ? 0u : 0xBF80BF80u, 0u, 0u, 0u});
    unsigned ka[6];
    { const int xn = ((r32 >> 1) & 7) << 4, xr = ((r32 >> 2) & 3) << 4, hb = hi << 4;
#pragma unroll
      for (int d0 = 0; d0 < 6; ++d0) { unsigned a_ = d0 < 4 ? lds0 + NOPE_B + r32 * 128 + ((d0 * 32 + hb) ^ xn) : lds0 + ROPE_B + r32 * 64 + (((d0 - 4) * 32 + hb) ^ xr); asm volatile("" : "+v"(a_)); ka[d0] = a_; } }
    const int vfo = V_B + (4 * hi + ((lane & 15) >> 2)) * 64 + ((lane >> 4) & 1) * 32 + (lane & 3) * 8;
#define ATT_HEADX(t) do { asm volatile("s_waitcnt vmcnt(6) lgkmcnt(0)\n\ts_barrier" ::: "memory"); ATT_DMA((t) + 3); } while (0)
#define ATT_HEAD(t) do { if ((t) + 2 < U.ntiles) asm volatile("s_waitcnt vmcnt(6) lgkmcnt(0)\n\ts_barrier" ::: "memory"); else asm volatile("s_waitcnt vmcnt(0) lgkmcnt(0)\n\ts_barrier" ::: "memory"); \
        if ((t) + 3 < U.ntiles) ATT_DMA((t) + 3); } while (0)
#define ATT_FULLS(PC0, PC1, PN0, PN1, s0, s1) do { \
        step<true>(PN0, PN1, PC0, PC1, o0, o1, lrun, qmf, kneg, ka, (s1) * 8192, lds + (s0) * 8192 + vfo, qf, qr); rebase(PN0, PN1, o0, o1, lrun, mrun, qmf, hi); } while (0)
#define ATT_BARX asm volatile("s_waitcnt vmcnt(6) lgkmcnt(0)\n\ts_barrier" ::: "memory")
#define ATT_FULLD(PC0, PC1, PN0, PN1, s0, s1, td, sd) do { auto dma_ = [&]() { ATT_DMAS(td, sd); }; \
        step<true>(PN0, PN1, PC0, PC1, o0, o1, lrun, qmf, kneg, ka, (s1) * 8192, lds + (s0) * 8192 + vfo, qf, qr, dma_); rebase(PN0, PN1, o0, o1, lrun, mrun, qmf, hi); } while (0)
#define ATT_FULL(PC0, PC1, PN0, PN1, j) ATT_FULLS(PC0, PC1, PN0, PN1, (j) & 3, ((j) + 1) & 3)
#define ATT_LAST(PC0, PC1, PN0, PN1, j) do { const int s0_ = (j) & 3; \
        step<false>(PN0, PN1, PC0, PC1, o0, o1, lrun, qmf, kneg, ka, 0, lds + s0_ * 8192 + vfo, qf, qr); } while (0)
#define ATT_HEADS(t, s) do { asm volatile("s_waitcnt vmcnt(6) lgkmcnt(0)\n\ts_barrier" ::: "memory"); ATT_DMAS((t) + 3, s); } while (0)
    ATT_HEAD(0);
    int j = 1;
    if (0 < mylim) {
        {
#pragma unroll
            for (int d0 = 0; d0 < 6; ++d0) { bf16x8 a0_, a1_; kfrag(a0_, a1_, d0, ka, 0); const bf16x8 qd_ = d0 < 4 ? qf[d0 < 4 ? d0 : 0] : (d0 == 4 ? qr4 : qr5);
                pA0 = __builtin_amdgcn_mfma_f32_32x32x16_bf16(a0_, qd_, pA0, 0, 0, 0); pA1 = __builtin_amdgcn_mfma_f32_32x32x16_bf16(a1_, qd_, pA1, 0, 0, 0); }
            mrun = row_max32(pA0, pA1); qmf = mfrag(mrun, hi);
#pragma unroll
            for (int r_ = 0; r_ < 16; ++r_) { pA0[r_] -= mrun; pA1[r_] -= mrun; }
        }
        j = 0;
        while (j + 4 < mylim && j + 7 < U.ntiles) {
            ATT_FULLS(pA0, pA1, pB0, pB1, 0, 1); ATT_BARX; ATT_FULLD(pB0, pB1, pA0, pA1, 1, 2, j + 4, 0); ATT_BARX;
            ATT_FULLD(pA0, pA1, pB0, pB1, 2, 3, j + 5, 1); ATT_BARX; ATT_FULLD(pB0, pB1, pA0, pA1, 3, 0, j + 6, 2); ATT_HEADS(j + 4, 3); j += 4; }
        while (j + 2 < mylim && j + 5 < U.ntiles) { ATT_FULL(pA0, pA1, pB0, pB1, j); ATT_HEADX(j + 1); ATT_FULL(pB0, pB1, pA0, pA1, j + 1); ATT_HEADX(j + 2); j += 2; }
        while (j + 2 < mylim) { ATT_FULL(pA0, pA1, pB0, pB1, j); ATT_HEAD(j + 1); ATT_FULL(pB0, pB1, pA0, pA1, j + 1); ATT_HEAD(j + 2); j += 2; }
        if (j + 1 < mylim) { ATT_FULL(pA0, pA1, pB0, pB1, j); ATT_HEAD(j + 1); ATT_LAST(pB0, pB1, pA0, pA1, j + 1); j += 2; }
        else { ATT_LAST(pA0, pA1, pB0, pB1, j); j += 1; }
    }
    for (; j < U.ntiles; ++j) ATT_HEAD(j);
#undef ATT_HEADX
#undef ATT_HEAD
#undef ATT_FULL
#undef ATT_LAST
#undef ATT_FULLS
#undef ATT_FULLD
#undef ATT_BARX
#undef ATT_HEADS
#undef ATT_DMAS
#undef ATT_DMA
    asm volatile("s_waitcnt vmcnt(0) lgkmcnt(0)\n\ts_barrier" ::: "memory");
    if (active) {
        const float lt = lrun + shx(lrun, 32), inv = __builtin_amdgcn_rcpf(lt);
        bf16_t* op = O + (size_t)(U.qrow0 + wid * 32 + r32) * 1024 + U.h * 64 + 8 * hi;
#pragma unroll
        for (int dh = 0; dh < 2; ++dh) {
            const f32x16& oo = dh ? o1 : o0;
#pragma unroll
            for (int g = 0; g < 4; g += 2) {
                const unsigned a0 = cvt_pk_bf16(oo[4 * g] * inv, oo[4 * g + 1] * inv), a1 = cvt_pk_bf16(oo[4 * g + 2] * inv, oo[4 * g + 3] * inv);
                const unsigned b0 = cvt_pk_bf16(oo[4 * g + 4] * inv, oo[4 * g + 5] * inv), b1 = cvt_pk_bf16(oo[4 * g + 6] * inv, oo[4 * g + 7] * inv);
                auto s0 = __builtin_amdgcn_permlane32_swap(a0, b0, false, false); auto s1 = __builtin_amdgcn_permlane32_swap(a1, b1, false, false);
                *(u32x4*)(op + dh * 32 + 8 * g) = (u32x4){s0[0], s1[0], s0[1], s1[1]};
            }
        }
    }
}
__device__ __forceinline__ void phase(int vcu, int G, const bf16_t* Q, const bf16_t* KV, const bf16_t* KR, bf16_t* O, LAS unsigned char* lds) {
    for (int w = vcu; w < 256; w += G) {
        const int g = w >> 3, s = w & 7;
        for (int rnd = 0; rnd < 4; ++rnd) {
            const int bh = g + 32 * rnd, b = bh >> 4, h = bh & 15;
            int qlong, qshort;
            if (rnd < 2) { if (s < 4) { qlong = 15 - 2 * s; qshort = 2 * s + 1; } else { qlong = 14 - 2 * (s - 4); qshort = 2 * (s - 4); } }
            else { qlong = 15 - s; qshort = s; }
            for (int k = 0; k < 2; ++k) {
                const int qb = k ? qshort : qlong;
                Unit U; U.qrow0 = b * SEQ + qb * 256; U.kvrow0 = b * SEQ; U.h = h; U.ntiles = 4 * qb + 4; U.lim_base = 4 * qb + 1; U.lim_step = 1; U.nwq = 8;
                unit(U, Q, KV, KR, O, lds);
            }
        }
        if (s >= 4) {
            const int su = g * 4 + (s - 4), b = su >> 4, h = su & 15;
            Unit U; U.qrow0 = MP + b * DSEQ; U.kvrow0 = MP + b * KVS; U.h = h; U.ntiles = KVS / 64; U.lim_base = KVS / 64; U.lim_step = 0; U.nwq = 2;
            unit(U, Q, KV, KR, O, lds);
        }
    }
}
}

struct Args { const float* in[28]; float* out; unsigned char* ws; int ph_lo, ph_hi; };

__device__ __forceinline__ unsigned f2bf(float f) { unsigned u = __builtin_bit_cast(unsigned, f); return (u + 0x7fffu + ((u >> 16) & 1u)) >> 16; }
__device__ __forceinline__ unsigned pk2(float lo, float hi) { return f2bf(lo) | (f2bf(hi) << 16); }

__device__ __forceinline__ void transpose_item(const float* W, int N, const float* gain, bf16_t* WT, size_t ldw, int coff, int k0, int n0, int drow0, LAS float* scr, int lane) {
    float wv[32];
#pragma unroll
    for (int i = 0; i < 32; ++i) wv[i] = W[(size_t)(k0 + 2 * i + (lane >> 5)) * N + n0 + (lane & 31)];
    if (gain) {
#pragma unroll
        for (int i = 0; i < 32; ++i) wv[i] *= gain[k0 + 2 * i + (lane >> 5)];
    }
#pragma unroll
    for (int i = 0; i < 32; ++i) scr[(2 * i + (lane >> 5)) * 33 + (lane & 31)] = wv[i];
    asm volatile("s_waitcnt lgkmcnt(0)" ::: "memory");
    const int c = lane & 7;
#pragma unroll
    for (int j = 0; j < 4; ++j) { const int n = (lane >> 3) + 8 * j; const LAS float* s = scr + (8 * c) * 33 + n;
        u32x4 o; o.x = pk2(s[0 * 33], s[1 * 33]); o.y = pk2(s[2 * 33], s[3 * 33]); o.z = pk2(s[4 * 33], s[5 * 33]); o.w = pk2(s[6 * 33], s[7 * 33]);
        *(u32x4*)(WT + (size_t)(drow0 + n) * ldw + coff + k0 + 8 * c) = o; }
    asm volatile("s_waitcnt lgkmcnt(0)" ::: "memory");
}
__device__ __forceinline__ int win_row(int n0) {
    if (n0 < 1024) return (n0 >> 7) * 256 + (n0 & 127);
    if (n0 < 2048) return 2048 + (n0 - 1024);
    if (n0 < 3072) { const int j = n0 - 2048; return (j >> 7) * 256 + 128 + (j & 127); }
    if (n0 < 3840) return n0;
    if (n0 < 3872) return 5888 + (n0 - 3840);
    return n0 - 32;
}

__device__ __forceinline__ void rope_cs(int pos, int i, float& c, float& s) {
    float iv = 1.0f;
    iv = (i == 1) ? 0.5623413324356079f : iv;
    iv = (i == 2) ? 0.3162277638912201f : iv;
    iv = (i == 3) ? 0.17782793939113617f : iv;
    iv = (i == 4) ? 0.10000000149011612f : iv;
    iv = (i == 5) ? 0.05623413249850273f : iv;
    iv = (i == 6) ? 0.03162277489900589f : iv;
    iv = (i == 7) ? 0.017782794311642647f : iv;
    iv = (i == 8) ? 0.009999999776482582f : iv;
    iv = (i == 9) ? 0.005623413249850273f : iv;
    iv = (i == 10) ? 0.003162277629598975f : iv;
    iv = (i == 11) ? 0.0017782794311642647f : iv;
    iv = (i == 12) ? 0.0010000000474974513f : iv;
    iv = (i == 13) ? 0.000562341301701963f : iv;
    iv = (i == 14) ? 0.0003162277571391314f : iv;
    iv = (i == 15) ? 0.00017782794020604342f : iv;
    const float ang = (float)pos * iv;
    const float n = rintf(ang * 0.15915494309189535f);
    float r = fmaf(-n, 6.2831854820251465f, ang); r = fmaf(-n, -1.7484555e-7f, r);
    c = __cosf(r); s = __sinf(r);
}

__global__ void __launch_bounds__(NWAVES * 64, 2) fwd_kernel(Args args) {
    extern __shared__ __attribute__((aligned(16))) unsigned char lds_raw[];
    LAS unsigned char* lds = (LAS unsigned char*)lds_raw;
    volatile LAS unsigned* MISC = (volatile LAS unsigned*)(lds + MISC_OFF);
    const int wave = __builtin_amdgcn_readfirstlane((int)threadIdx.x >> 6);
    const int G = gridDim.x; const int bx = blockIdx.x; const int vcu = (G % 8 == 0) ? (bx % 8) * (G / 8) + bx / 8 : bx;
    unsigned char* ws = args.ws; float* out = args.out;
    unsigned* ctl = (unsigned*)(ws + WS_CTL);
    for (int u = threadIdx.x; u < (LDS_BYTES - LDSCTL_OFF) / 4; u += NWAVES * 64) ((LAS unsigned*)(lds + LDSCTL_OFF))[u] = 0u;
    __syncthreads();
    const int lo = args.ph_lo, hi = args.ph_hi;
    const bool multi = (hi - lo) > 1;
    XcdBarrier bar; bar.bar = ctl; bar.x = 0; bar.st = nullptr;
    if (multi) bar = xcd_barrier_post(ctl, MISC + 8);
#define IN(k) (({ asm volatile("" : "+s"(kp)); }), (lo <= (k) && (k) < hi))
#define TID_LANE int tid = threadIdx.x; asm volatile("" : "+v"(tid)); const int lane = tid & 63;
#define SEAM(k) do { if (IN(k) && IN((k) + 1)) xcd_barrier(bar); } while (0)
    const int gw = vcu * NWAVES + wave, NGW = G * NWAVES;

    const __attribute__((address_space(4))) unsigned char* kp = (const __attribute__((address_space(4))) unsigned char*)__builtin_amdgcn_kernarg_segment_ptr();
#define KIN(k) (((const float* const __attribute__((address_space(4)))*)kp)[k])
#define x_prompt KIN(0)
#define x_sample KIN(1)
#define cache_conv KIN(2)
#define cache_ckv KIN(3)
#define cache_krope KIN(4)
#define cache_mem_k KIN(5)
#define cache_mem_v KIN(6)
#define mem_prompt KIN(7)
#define g_mix KIN(8)
#define w_in KIN(9)
#define w_conv KIN(10)
#define w_conv_out KIN(11)
#define g_q KIN(12)
#define w_uq KIN(13)
#define g_kv KIN(14)
#define w_ukv KIN(15)
#define w_mla_out KIN(16)
#define w_mix_out KIN(17)
#define g_mem_q KIN(18)
#define g_mem_kv KIN(19)
#define w_qm KIN(20)
#define w_km KIN(21)
#define w_vm KIN(22)
#define w_om KIN(23)
#define g_mlp KIN(24)
#define w_up KIN(25)
#define w_down KIN(26)
#define g_final KIN(27)
    f32x2* tab = (f32x2*)(ws + WS_TAB);
    float* rstd0 = (float*)(ws + WS_RSTD0); float* rq = (float*)(ws + WS_RQ); float* rstdm = (float*)(ws + WS_RSTDM);
    float* st1 = (float*)(ws + WS_ST1); float* st2 = (float*)(ws + WS_ST2); float* st3 = (float*)(ws + WS_ST3);
    bf16_t* Win_t = (bf16_t*)(ws + WS_WIN); bf16_t* Wco_t = (bf16_t*)(ws + WS_WCO); bf16_t* Wuq_t = (bf16_t*)(ws + WS_WUQ); bf16_t* Wukv_t = (bf16_t*)(ws + WS_WUKV);
    bf16_t* Wmo_t = (bf16_t*)(ws + WS_WMO); bf16_t* Wmx_t = (bf16_t*)(ws + WS_WMX); bf16_t* Wqm_g = (bf16_t*)(ws + WS_WQM); bf16_t* Wkv_t = (bf16_t*)(ws + WS_WKV);
    bf16_t* Wom_t = (bf16_t*)(ws + WS_WOM); bf16_t* Wup_t = (bf16_t*)(ws + WS_WUP); bf16_t* Wdn_t = (bf16_t*)(ws + WS_WDN);
    bf16_t* mb = (bf16_t*)(ws + WS_MB); bf16_t* memk = (bf16_t*)(ws + WS_MEMK); bf16_t* memv = (bf16_t*)(ws + WS_MEMV); bf16_t* Wp = (bf16_t*)(ws + WS_WP); bf16_t* Vp = (bf16_t*)(ws + WS_VP);
    bf16_t* ckvb = (bf16_t*)(ws + WS_CKVB); bf16_t* krb = (bf16_t*)(ws + WS_KRB);
    bf16_t* R1 = (bf16_t*)(ws + WS_R1); bf16_t* R2 = (bf16_t*)(ws + WS_R2); bf16_t* R3 = (bf16_t*)(ws + WS_R3); bf16_t* R4 = (bf16_t*)(ws + WS_R4);
    bf16_t* R5 = (bf16_t*)(ws + WS_R5); bf16_t* R6 = (bf16_t*)(ws + WS_R6); bf16_t* R7 = (bf16_t*)(ws + WS_R7); bf16_t* R8 = (bf16_t*)(ws + WS_R8);
    float* slabs = (float*)(ws + WS_SLAB);
    bf16_t* cqb = (bf16_t*)out + (size_t)MT * QW;
    bf16_t* qbuf = (bf16_t*)out;

    if (IN(0)) { TID_LANE
        { constexpr int WKP = 1032; LAS unsigned short* wk = (LAS unsigned short*)(lds + RING_OFF);
          for (int k = tid; k < 1024; k += NWAVES * 64) { const float gk = g_mix[k]; const float* src = w_in + (size_t)k * NIN + 3840;
#pragma unroll
              for (int j4 = 0; j4 < 8; ++j4) { const f32x4 v = *(const f32x4*)(src + 4 * j4) * gk;
#pragma unroll
                  for (int e = 0; e < 4; ++e) wk[(4 * j4 + e) * WKP + k] = (unsigned short)(cvt_pk_bf16(v[e], 0.f) & 0xffffu); } }
          __syncthreads();
          const int rr = lane & 15, q = lane >> 4;
          const LAS unsigned char* wkb = lds + RING_OFF + (rr * WKP + 8 * q) * 2;
          f32x4 acc0, acc1; float ss;
#define P0_LOAD4(A, src, kc) do { _Pragma("unroll") for (int u = 0; u < 4; ++u) { A[u][0] = *(const f32x4*)((src) + 32 * ((kc) + u)); A[u][1] = *(const f32x4*)((src) + 32 * ((kc) + u) + 4); } } while (0)
#define P0_PROC4(A, dst, kc) do { _Pragma("unroll") for (int u = 0; u < 4; ++u) { \
              ss += (A[u][0][0] * A[u][0][0] + A[u][0][1] * A[u][0][1]) + (A[u][0][2] * A[u][0][2] + A[u][0][3] * A[u][0][3]) + (A[u][1][0] * A[u][1][0] + A[u][1][1] * A[u][1][1]) + (A[u][1][2] * A[u][1][2] + A[u][1][3] * A[u][1][3]); \
              const u32x4 pk = pack8(A[u][0], A[u][1]); *(u32x4*)((dst) + 32 * ((kc) + u)) = pk; const bf16x8 af = __builtin_bit_cast(bf16x8, pk); \
              const bf16x8 b0 = *(const LAS bf16x8*)(wkb + ((kc) + u) * 64), b1 = *(const LAS bf16x8*)(wkb + 16 * WKP * 2 + ((kc) + u) * 64); \
              acc0 = __builtin_amdgcn_mfma_f32_16x16x32_bf16(af, b0, acc0, 0, 0, 0); acc1 = __builtin_amdgcn_mfma_f32_16x16x32_bf16(af, b1, acc1, 0, 0, 0); } } while (0)
#define P0_FINISH(R0) do { ss += shx(ss, 16); ss += shx(ss, 32); const float rs = 1.0f / sqrtf(ss * (1.0f / 1024.0f) + EPS); if (q == 0) rstd0[(R0) + rr] = rs; \
              _Pragma("unroll") for (int e = 0; e < 4; ++e) { const float rse = __builtin_bit_cast(float, __builtin_amdgcn_ds_bpermute((4 * q + e) << 2, __builtin_bit_cast(int, rs))); \
                  unsigned short* kp = (unsigned short*)R8 + (size_t)((R0) + 4 * q + e) * 32 + rr; \
                  kp[0] = (unsigned short)(cvt_pk_bf16(acc0[e] * rse, 0.f) & 0xffffu); kp[16] = (unsigned short)(cvt_pk_bf16(acc1[e] * rse, 0.f) & 0xffffu); } } while (0)
          for (int bi = gw; bi < MP / 16; bi += NGW) {
              const int R0 = bi * 16; const float* src = x_prompt + (size_t)(R0 + rr) * 1024 + 8 * q; bf16_t* dst = R1 + (size_t)(R0 + rr) * 1024 + 8 * q;
              acc0 = (f32x4){0.f, 0.f, 0.f, 0.f}; acc1 = acc0; ss = 0.f;
              f32x4 a[2][4][2]; P0_LOAD4(a[0], src, 0);
#pragma unroll
              for (int it = 0; it < 8; ++it) { if (it + 1 < 8) P0_LOAD4(a[(it + 1) & 1], src, 4 * (it + 1)); P0_PROC4(a[it & 1], dst, 4 * it); }
              P0_FINISH(R0);
          }
          { LAS float* part = (LAS float*)(lds + RING_OFF + 73728);
            for (int sb = vcu; sb < MS / 16; sb += G) {
              const int R0 = MP + sb * 16; const float* src = x_sample + (size_t)(sb * 16 + rr) * 1024 + 8 * q; bf16_t* dst = R1 + (size_t)(R0 + rr) * 1024 + 8 * q;
              acc0 = (f32x4){0.f, 0.f, 0.f, 0.f}; acc1 = acc0; ss = 0.f;
              f32x4 a[4][2]; P0_LOAD4(a, src, 4 * wave); P0_PROC4(a, dst, 4 * wave);
              LAS float* mine = part + (wave * 9) * 64 + lane;
              mine[0] = ss;
#pragma unroll
              for (int e = 0; e < 4; ++e) { mine[(1 + e) * 64] = acc0[e]; mine[(5 + e) * 64] = acc1[e]; }
              __syncthreads();
              if (wave == 0) {
                  ss = 0.f; acc0 = (f32x4){0.f, 0.f, 0.f, 0.f}; acc1 = acc0;
                  for (int w = 0; w < NWAVES; ++w) { const LAS float* o = part + (w * 9) * 64 + lane; ss += o[0];
#pragma unroll
                      for (int e = 0; e < 4; ++e) { acc0[e] += o[(1 + e) * 64]; acc1[e] += o[(5 + e) * 64]; } }
                  P0_FINISH(R0);
              }
              __syncthreads();
            } }
#undef P0_LOAD4
#undef P0_PROC4
#undef P0_FINISH
          __syncthreads();
        }
        LAS float* scr = (LAS float*)(lds + RING_OFF + wave * 16384);
        int it = gw;
#define WJ(W, K, N, gain, dst, ldw, coff, mode) do { const int nblk = (N) / 32, nitems = ((K) / 64) * nblk; \
            for (; it < nitems; it += NGW) { const int kb = it / nblk, nb = it % nblk, n0 = nb * 32; transpose_item(W, N, gain, dst, (size_t)(ldw), coff, kb * 64, n0, (mode) ? win_row(n0) : n0, scr, lane); } \
            it -= nitems; } while (0)
        WJ(w_in, 1024, NIN, g_mix, Win_t, 1024, 0, 1);
        WJ(w_conv_out, 1024, 1024, (const float*)nullptr, Wco_t, 1024, 0, 0);
        WJ(w_uq, 512, QW, g_q, Wuq_t, 512, 0, 0);
        WJ(w_ukv, 256, KVW, (const float*)nullptr, Wukv_t, 256, 0, 0);
        WJ(w_mla_out, 1024, 1024, (const float*)nullptr, Wmo_t, 1024, 0, 0);
        WJ(w_mix_out, 1024, 1024, (const float*)nullptr, Wmx_t, 1024, 0, 0);
        WJ(w_km, 1024, 1024, g_mem_kv, Wkv_t, 1024, 0, 0);
        WJ(w_vm, 1024, 1024, g_mem_kv, Wkv_t + (size_t)1024 * 1024, 1024, 0, 0);
        WJ(w_om, 1024, 1024, (const float*)nullptr, Wom_t, 1024, 0, 0);
        WJ(w_up, 1024, DFF, g_mlp, Wup_t, 1024, 0, 0);
        WJ(w_down, DFF, 1024, (const float*)nullptr, Wdn_t, DFF, 0, 0);
#undef WJ
        for (int r = MT + gw; r < MT + 2048; r += NGW) {
            const float* src = r < MP ? x_prompt + (size_t)r * 1024 : (r < MT ? x_sample + (size_t)(r - MP) * 1024 : mem_prompt + (size_t)(r - MT) * 1024);
            bf16_t* dst = r < MT ? R1 + (size_t)r * 1024 : mb + (size_t)(r - MT) * 1024;
            f32x4 v[4]; float s = 0.f;
#pragma unroll
            for (int j = 0; j < 4; ++j) { v[j] = *(const f32x4*)(src + 256 * j + 4 * lane); s += (v[j][0] * v[j][0] + v[j][1] * v[j][1]) + (v[j][2] * v[j][2] + v[j][3] * v[j][3]); }
            s = wave_sum(s); const float rs = 1.0f / sqrtf(s * (1.0f / 1024.0f) + EPS);
            if (lane == 0) { if (r < MT) rstd0[r] = rs; else rstdm[r - MT] = rs; }
#pragma unroll
            for (int j = 0; j < 4; ++j) *(u32x2*)(dst + 256 * j + 4 * lane) = (u32x2){cvt_pk_bf16(v[j][0], v[j][1]), cvt_pk_bf16(v[j][2], v[j][3])};
        }
        for (int i = gw * 64 + lane; i < NB * PAST * 256 / 8; i += NGW * 64) { const int e = i * 8, row = e >> 8, c = e & 255, b = row >> 10, t = row & 1023;
            const f32x4 a = *(const f32x4*)(cache_ckv + e), bb = *(const f32x4*)(cache_ckv + e + 4); *(u32x4*)(ckvb + (size_t)(MP + b * KVS + t) * 256 + c) = pack8(a, bb); }
        for (int i = gw * 64 + lane; i < NB * PAST * 32 / 8; i += NGW * 64) { const int e = i * 8, row = e >> 5, c = e & 31, b = row >> 10, t = row & 1023;
            const f32x4 a = *(const f32x4*)(cache_krope + e), bb = *(const f32x4*)(cache_krope + e + 4); *(u32x4*)(krb + (size_t)(MP + b * KVS + t) * 32 + c) = pack8(a, bb); }
        for (int i = gw * 64 + lane; i < 2048 * 1024 / 8; i += NGW * 64) { const size_t e = (size_t)i * 8;
            const f32x4 a = *(const f32x4*)(cache_mem_k + e), bb = *(const f32x4*)(cache_mem_k + e + 4); *(u32x4*)(memk + (size_t)2048 * 1024 + e) = pack8(a, bb); }
        for (int i = gw * 64 + lane; i < 2048 * 1024 / 8; i += NGW * 64) { const size_t e = (size_t)i * 8;
            const f32x4 a = *(const f32x4*)(cache_mem_v + e), bb = *(const f32x4*)(cache_mem_v + e + 4); *(u32x4*)(memv + (size_t)2048 * 1024 + e) = pack8(a, bb); }
        for (int i = gw * 64 + lane; i < 1024 * 1024 / 8; i += NGW * 64) { const size_t e = (size_t)i * 8; const float gk = g_mem_q[e >> 10];
            const f32x4 a = *(const f32x4*)(w_qm + e) * gk, bb = *(const f32x4*)(w_qm + e + 4) * gk; *(u32x4*)(Wqm_g + e) = pack8(a, bb); }
        for (int i = gw * 64 + lane; i < SEQ * 16; i += NGW * 64) { float c, s; rope_cs(i >> 4, i & 15, c, s); tab[i] = (f32x2){c, s}; }
    }
    SEAM(0);

    if (IN(1)) {
        { pg8::Dense P{R1, Win_t, 1024, 1024, 1024}; pg8::StaticOrder S; S.init(MP, NIN1, G, bx);
          pg8::EpiIn E{rstd0, R2, R3, cqb, R5, R6, R7}; pg8::gemm_phase(lds + RING_OFF, P, S, E);
          { pg8::Piece pc; if (pg8::piece_of(NIN1, 1024, G, bx, 2, 128, pc)) pg8::gemm_piece(lds + RING_OFF, P, E, pc, pg8::SplitCtx{out + OUT_Y, ctl + 4096, MISC + 16}); } }
        if (G != 256) { pg8::Dense P{mb, Wkv_t, 1024, 1024, 1024}; pg8::StaticOrder S; S.init(2048, 2048, G, (bx + G - 96) % G);
          pg8::EpiMemKV E{rstdm, out + OUT_MEMK, out + OUT_MEMV, memk, memv}; pg8::gemm_phase(lds + RING_OFF, P, S, E); }
    }
    SEAM(1);

    if (IN(2)) {
        const bool kvcu = G == 256 && (vcu & 31) < 8;
        if (kvcu) { pg8::Dense P{mb, Wkv_t, 1024, 1024, 1024}; pg8::StaticOrder S; S.init(2048, 2048, 64, (vcu >> 5) * 8 + (vcu & 31));
            pg8::EpiMemKV E{rstdm, out + OUT_MEMK, out + OUT_MEMV, memk, memv}; pg8::gemm_phase(lds + RING_OFF, P, S, E); }
        TID_LANE
        int h0, h1, nh;
        if (G == 256) { nh = 3584; if (kvcu) { h0 = 3072 + ((vcu >> 5) * 8 + (vcu & 31)) * NWAVES + wave; h1 = h0 + 1; } else { h0 = 2 * (((vcu >> 5) * 24 + (vcu & 31) - 8) * NWAVES + wave); h1 = h0 + 2; } }
        else { nh = G * NWAVES; h0 = vcu * NWAVES + wave; h1 = h0 + 1; }
        const int rbeg = (int)(((long)h0 * MT) / nh), rend = (int)(((long)h1 * MT) / nh);
        f32x4 wc_[2][6];
#pragma unroll
        for (int hh = 0; hh < 2; ++hh) { const int c = hh * 512 + lane * 8;
#pragma unroll
            for (int k = 0; k < 3; ++k) { wc_[hh][2 * k] = *(const f32x4*)(w_conv + k * 1024 + c); wc_[hh][2 * k + 1] = *(const f32x4*)(w_conv + k * 1024 + c + 4); } }
        const f32x4 gkv = *(const f32x4*)(g_kv + lane * 4);
        f32x4 p1[2][2] = {}, p2[2][2] = {};
        u32x4 cv[2], cb[2], ccq; u32x2 cck; unsigned short ckr;
#define P2_LOAD(r_, V, B, CQ, CK, KR) do { _Pragma("unroll") for (int hh = 0; hh < 2; ++hh) { V[hh] = *(const u32x4*)(R2 + (size_t)(r_) * 1024 + hh * 512 + lane * 8); B[hh] = *(const u32x4*)(R3 + (size_t)(r_) * 1024 + hh * 512 + lane * 8); } \
            CQ = *(const u32x4*)(cqb + (size_t)(r_) * 512 + lane * 8); CK = *(const u32x2*)(R5 + (size_t)(r_) * 256 + lane * 4); KR = R8[(size_t)(r_) * 32 + (lane & 31)]; } while (0)
        if (rbeg < rend) {
            P2_LOAD(rbeg, cv, cb, ccq, cck, ckr);
            { const bool isP = rbeg < MP; const int rr = isP ? rbeg : rbeg - MP; const int b = isP ? rr >> 12 : rr >> 6, t = isP ? rr & (SEQ - 1) : rr & (DSEQ - 1);
#pragma unroll
              for (int hh = 0; hh < 2; ++hh) { const int c = hh * 512 + lane * 8;
                  if (t >= 1) unpack8(*(const u32x4*)(R2 + (size_t)(rbeg - 1) * 1024 + c), p1[hh][0], p1[hh][1]);
                  else if (!isP) { p1[hh][0] = *(const f32x4*)(cache_conv + (size_t)(b * 2 + 1) * 1024 + c); p1[hh][1] = *(const f32x4*)(cache_conv + (size_t)(b * 2 + 1) * 1024 + c + 4); }
                  if (t >= 2) unpack8(*(const u32x4*)(R2 + (size_t)(rbeg - 2) * 1024 + c), p2[hh][0], p2[hh][1]);
                  else if (!isP) { p2[hh][0] = *(const f32x4*)(cache_conv + (size_t)(b * 2 + t) * 1024 + c); p2[hh][1] = *(const f32x4*)(cache_conv + (size_t)(b * 2 + t) * 1024 + c + 4); } } }
        }
        for (int r = rbeg; r < rend; ++r) {
            u32x4 nv[2], nb[2], ncq; u32x2 nck; unsigned short nkr;
            const int rn = r + 1 < rend ? r + 1 : r;
            P2_LOAD(rn, nv, nb, ncq, nck, nkr);
            const bool isP = r < MP; const int rr = isP ? r : r - MP; const int b = isP ? rr >> 12 : rr >> 6, t = isP ? rr & (SEQ - 1) : rr & (DSEQ - 1), T = isP ? SEQ : DSEQ;
            const int kvrow = isP ? r : MP + b * KVS + PAST + t, pos = isP ? t : PAST + t;
            float* oconv = out + (isP ? OUT_CONVP : OUT_CONVS); float* ockv = out + (isP ? OUT_CKVP : OUT_CKVS); float* okr = out + (isP ? OUT_KRP : OUT_KRS);
            if (t == 0) {
#pragma unroll
                for (int hh = 0; hh < 2; ++hh) { const int c = hh * 512 + lane * 8;
                    if (isP) { p1[hh][0] = p1[hh][1] = p2[hh][0] = p2[hh][1] = (f32x4){0.f, 0.f, 0.f, 0.f}; }
                    else { p1[hh][0] = *(const f32x4*)(cache_conv + (size_t)(b * 2 + 1) * 1024 + c); p1[hh][1] = *(const f32x4*)(cache_conv + (size_t)(b * 2 + 1) * 1024 + c + 4);
                           p2[hh][0] = *(const f32x4*)(cache_conv + (size_t)(b * 2) * 1024 + c); p2[hh][1] = *(const f32x4*)(cache_conv + (size_t)(b * 2) * 1024 + c + 4); } }
            }
#pragma unroll
            for (int hh = 0; hh < 2; ++hh) {
                const int c = hh * 512 + lane * 8;
                f32x4 v0a, v0b, ba, bb; unpack8(cv[hh], v0a, v0b); unpack8(cb[hh], ba, bb);
                const f32x4 ga = ba * (wc_[hh][0] * p2[hh][0] + wc_[hh][2] * p1[hh][0] + wc_[hh][4] * v0a), gb = bb * (wc_[hh][1] * p2[hh][1] + wc_[hh][3] * p1[hh][1] + wc_[hh][5] * v0b);
                *(u32x4*)(R1 + (size_t)r * 1024 + c) = pack8(ga, gb);
                if (t >= T - 2) { float* o = oconv + (size_t)(b * 2 + (t - (T - 2))) * 1024 + c; *(f32x4*)o = v0a; *(f32x4*)(o + 4) = v0b; }
                p2[hh][0] = p1[hh][0]; p2[hh][1] = p1[hh][1]; p1[hh][0] = v0a; p1[hh][1] = v0b;
            }
            f32x4 qa, qb; unpack8(ccq, qa, qb);
            float s1 = (qa[0] * qa[0] + qa[1] * qa[1]) + (qa[2] * qa[2] + qa[3] * qa[3]) + (qb[0] * qb[0] + qb[1] * qb[1]) + (qb[2] * qb[2] + qb[3] * qb[3]);
            f32x4 ka = (f32x4){bf_lo(cck.x), bf_hi(cck.x), bf_lo(cck.y), bf_hi(cck.y)};
            float s2 = (ka[0] * ka[0] + ka[1] * ka[1]) + (ka[2] * ka[2] + ka[3] * ka[3]);
#pragma unroll
            for (int o = 1; o < 64; o <<= 1) { s1 += shx(s1, o); s2 += shx(s2, o); }
            if (lane == 0) rq[r] = 1.0f / sqrtf(s1 * (1.0f / 512.0f) + EPS);
            { const float rs = 1.0f / sqrtf(s2 * (1.0f / 256.0f) + EPS); ka = ka * rs * gkv;
              *(f32x4*)(ockv + (size_t)rr * 256 + lane * 4) = ka; *(u32x2*)(ckvb + (size_t)kvrow * 256 + lane * 4) = (u32x2){cvt_pk_bf16(ka[0], ka[1]), cvt_pk_bf16(ka[2], ka[3])}; }
            { const int i = lane & 31; const float xv = __builtin_bit_cast(float, (unsigned)ckr << 16);
              const float pv = shx(xv, 16); const f32x2 cs = tab[pos * 16 + (i & 15)];
              const float o = (i < 16) ? xv * cs.x - pv * cs.y : xv * cs.x + pv * cs.y;
              if (lane < 32) { okr[(size_t)rr * 32 + i] = o; krb[(size_t)kvrow * 32 + i] = (bf16_t)f2bf(o); } }
#pragma unroll
            for (int hh = 0; hh < 2; ++hh) { cv[hh] = nv[hh]; cb[hh] = nb[hh]; }
            ccq = ncq; cck = nck; ckr = nkr;
        }
#undef P2_LOAD
    }
    SEAM(2);

    if (IN(3)) {
        { pg8::Dense P{R1, Wco_t, 1024, 1024, 1024}; pg8::StaticOrder S; S.init(MP, 1024, G, bx);
          pg8::EpiGate E{R6}; pg8::gemm_phase(lds + RING_OFF, P, S, E);
          { pg8::Piece pc; if (pg8::piece_of(1024, 1024, G, bx, 4, 0, pc)) pg8::gemm_piece(lds + RING_OFF, P, E, pc, pg8::SplitCtx{slabs, ctl + 4096 + 64, MISC + 16}); } }
        { pg8::Dense P{cqb, Wuq_t, 512, 512, 512}; pg8::StaticOrder S; S.init(MP, QW, G, bx);
          pg8::EpiQ E{rq, tab, qbuf}; pg8::gemm_phase(lds + RING_OFF, P, S, E);
          { pg8::Piece pc; if (pg8::piece_of(QW, 512, G, bx, 2, 128, pc)) pg8::gemm_piece(lds + RING_OFF, P, E, pc, pg8::SplitCtx{slabs + (size_t)32 * 65536, ctl + 4096 + 128, MISC + 16}); } }
        { pg8::Dense P{ckvb, Wukv_t, 256, 256, 256}; pg8::StaticOrder S; S.init(KVROWS, KVW, G, (bx + 64) % G);
          pg8::EpiPlain E{R2, KVW}; pg8::gemm_phase(lds + RING_OFF, P, S, E); }
    }
    SEAM(3);

    if (IN(5)) attn::phase(vcu, G, qbuf, R2, krb, R1, lds + RING_OFF);
    SEAM(5);

    if (IN(6)) {
        pg8::Dense P{R1, Wmo_t, 1024, 1024, 1024}; pg8::StaticOrder S; S.init(MP, 1024, G, bx);
        pg8::EpiMix E{R6, R7}; pg8::gemm_phase(lds + RING_OFF, P, S, E);
          { pg8::Piece pc; if (pg8::piece_of(1024, 1024, G, bx, 4, 0, pc)) pg8::gemm_piece(lds + RING_OFF, P, E, pc, pg8::SplitCtx{slabs, ctl + 4096 + 192, MISC + 16}); }
        { pg8::ProbWp Pw{memk, Wqm_g, 256, 1024, 1024}; pg8::PreOrder So{G - 32, (int)bx - 32}; pg8::EpiPlain Ew{Wp, 1024}; pg8::gemm_phase(lds + RING_OFF, Pw, So, Ew); }
    }
    SEAM(6);

    if (IN(7)) {
        pg8::Dense P{R7, Wmx_t, 1024, 1024, 1024}; pg8::StaticOrder S; S.init(MP, 1024, G, bx);
        pg8::EpiRes E{x_prompt, x_sample, out + OUT_Y, R1, st1}; pg8::gemm_phase(lds + RING_OFF, P, S, E);
          { pg8::Piece pc; if (pg8::piece_of(1024, 1024, G, bx, 4, 0, pc)) pg8::gemm_piece(lds + RING_OFF, P, E, pc, pg8::SplitCtx{slabs, ctl + 4096 + 256, MISC + 16}); }
        { pg8::ProbVp Pv{Wom_t, memv, 256, 1024, 1024}; pg8::PreOrder So{G - 32, (int)bx - 32}; pg8::EpiPlain Ev{Vp, 1024}; pg8::gemm_phase(lds + RING_OFF, Pv, So, Ev); }
    }
    SEAM(7);

    if (IN(8)) {
        pg8::ProbMA P{R1, Wp, 1024, 1024, 1024}; pg8::StaticOrder S; S.init(MP, 1024, G, bx);
        LAS float* rt8 = (LAS float*)(lds + MISC_OFF + 512); LAS int* pmt8 = (LAS int*)(lds + MISC_OFF + 256);
        { TID_LANE (void)lane;
          if (tid == 0) { int n = 0;
              for (int i = 0; ; ++i) { const int pmi = S.pm_of(i); if (pmi < 0) break; bool seen = false; for (int k = 0; k < n; ++k) seen = seen || (pmt8[k] == pmi); if (!seen && n < 7) pmt8[n++] = pmi; }
              pmt8[8] = n; for (int k = n; k < 8; ++k) pmt8[k] = -1; }
          __syncthreads();
          const int n_ = pmt8[8];
          for (int idx = tid; idx < n_ * 256; idx += NWAVES * 64) rt8[idx] = pg8::row_rstd(st1, pmt8[idx >> 8] * 256 + (idx & 255));
          __syncthreads(); }
        pg8::EpiSoftmaxS E{st1, MSCALE, R3, (LAS float*)(lds + SCR_OFF), (unsigned)(size_t)rt8, (unsigned)(size_t)pmt8}; pg8::gemm_phase(lds + RING_OFF, P, S, E);
          { pg8::Piece pc; if (pg8::piece_of_mem(G, bx, 4, 0, pc)) pg8::gemm_piece(lds + RING_OFF, P, E, pc, pg8::SplitCtx{slabs, ctl + 4096 + 320, MISC + 16}); }
    }
    SEAM(8);

    if (IN(9)) {
        pg8::ProbMA P{R3, Vp, 1024, 1024, 1024}; pg8::StaticOrder S; S.init(MP, 1024, G, bx);
        pg8::EpiResM E{out + OUT_Y, R1, st2}; pg8::gemm_phase(lds + RING_OFF, P, S, E);
          { pg8::Piece pc; if (pg8::piece_of_mem(G, bx, 4, 0, pc)) pg8::gemm_piece(lds + RING_OFF, P, E, pc, pg8::SplitCtx{slabs, ctl + 4096 + 384, MISC + 16}); }
    }
    SEAM(9);

    if (IN(12)) {
        pg8::Dense P{R1, Wup_t, 1024, 1024, 1024}; pg8::StaticOrder S; S.init(MP, DFF, G, bx);
        LAS float* rt = (LAS float*)(lds + SCR_OFF); LAS int* pmt = (LAS int*)(lds + MISC_OFF + 128);
        { TID_LANE
          if (tid == 0) { int n = 0;
              for (int i = 0; ; ++i) { const int pmi = S.pm_of(i); if (pmi < 0) break; bool seen = false; for (int k = 0; k < n; ++k) seen = seen || (pmt[k] == pmi); if (!seen && n < 8) pmt[n++] = pmi; }
              pmt[8] = n; for (int k = n; k < 8; ++k) pmt[k] = -1; }
          __syncthreads();
          const int n = pmt[8];
          for (int idx = tid; idx < n * 256; idx += NWAVES * 64) rt[idx] = pg8::row_rstd(st2, pmt[idx >> 8] * 256 + (idx & 255));
          __syncthreads(); (void)lane; }
        pg8::EpiNormAct<1> E{st2, R2, DFF, 1.0f, (unsigned)(size_t)rt, (unsigned)(size_t)pmt}; pg8::gemm_phase(lds + RING_OFF, P, S, E);
          { pg8::Piece pc; if (pg8::piece_of(DFF, 1024, G, bx, 4, 0, pc)) pg8::gemm_piece(lds + RING_OFF, P, E, pc, pg8::SplitCtx{slabs, ctl + 4096 + 448, MISC + 16}); }
    }
    SEAM(12);

    if (IN(13)) {
        pg8::Dense P{R2, Wdn_t, DFF, DFF, DFF}; pg8::StaticOrder S; S.init(MP, 1024, G, bx);
        if (G == 256) {
            pg8::EpiResFinal E{out + OUT_Y, out + OUT_Y + (size_t)MP * 1024, out + OUT_Y, st3, ctl + 8192, g_final}; pg8::gemm_phase(lds + RING_OFF, P, S, E);
            { pg8::Piece pc; if (pg8::piece_of(1024, DFF, G, bx, 8, 0, pc)) pg8::gemm_piece(lds + RING_OFF, P, E, pc, pg8::SplitCtx{slabs, ctl + 4096 + 512, MISC + 16}); }
        } else {
            pg8::EpiRes E{out + OUT_Y, out + OUT_Y + (size_t)MP * 1024, out + OUT_Y, nullptr, st3}; pg8::gemm_phase(lds + RING_OFF, P, S, E);
            { pg8::Piece pc; if (pg8::piece_of(1024, DFF, G, bx, 8, 0, pc)) pg8::gemm_piece(lds + RING_OFF, P, E, pc, pg8::SplitCtx{slabs, ctl + 4096 + 512, MISC + 16}); }
        }
    }
    if (G != 256) SEAM(13);

    if (IN(14) && G != 256) { TID_LANE
        for (int r = gw; r < MT; r += NGW) {
            const float rs = pg8::row_rstd(st3, r); float* p = out + OUT_Y + (size_t)r * 1024;
#pragma unroll
            for (int j = 0; j < 4; ++j) { const int c = 256 * j + 4 * lane; *(f32x4*)(p + c) = *(const f32x4*)(p + c) * rs * *(const f32x4*)(g_final + c); }
        }
    }
#undef IN
#undef SEAM
#undef x_prompt
#undef x_sample
#undef cache_conv
#undef cache_ckv
#undef cache_krope
#undef cache_mem_k
#undef cache_mem_v
#undef mem_prompt
#undef g_mix
#undef w_in
#undef w_conv
#undef w_conv_out
#undef g_q
#undef w_uq
#undef g_kv
#undef w_ukv
#undef w_mla_out
#undef w_mix_out
#undef g_mem_q
#undef g_mem_kv
#undef w_qm
#undef w_km
#undef w_vm
#undef w_om
#undef g_mlp
#undef w_up
#undef w_down
#undef g_final
#undef KIN
}

#ifndef MK_PER_PHASE
#define MK_PER_PHASE 0
#endif
constexpr int NPHASE = 15;
extern "C" void kernel_launch(void* const* d_in, const int* in_sizes, int n_in, void* d_out, int out_size, void* d_ws, size_t ws_size, hipStream_t stream) {
    static int grid = 0;
    if (grid == 0) {
        if (n_in != 28 || (size_t)out_size != OUT_TOTAL || ws_size < WS_END) { fprintf(stderr, "kernel_launch: unexpected problem (n_in %d, out %d, ws %zu)\n", n_in, out_size, ws_size); grid = -1; return; }
        int dev = 0, cus = 0, per_cu = 0;
        if (hipGetDevice(&dev) != hipSuccess || hipDeviceGetAttribute(&cus, hipDeviceAttributeMultiprocessorCount, dev) != hipSuccess) { grid = -1; return; }
        if (hipFuncSetAttribute((const void*)fwd_kernel, hipFuncAttributeMaxDynamicSharedMemorySize, LDS_BYTES) != hipSuccess) { fprintf(stderr, "kernel_launch: hipFuncSetAttribute failed\n"); grid = -1; return; }
        if (hipOccupancyMaxActiveBlocksPerMultiprocessor(&per_cu, (const void*)fwd_kernel, NWAVES * 64, LDS_BYTES) != hipSuccess || per_cu < 1) { fprintf(stderr, "kernel_launch: occupancy query says %d\n", per_cu); per_cu = 1; }
        (void)hipGetLastError();
        grid = cus;
    }
    if (grid < 0) return;
    (void)hipMemsetAsync((char*)d_ws + WS_CTL, 0, CTL_ZERO_BYTES, stream);
    Args a{};
    for (int i = 0; i < 28; ++i) a.in[i] = (const float*)d_in[i];
    a.out = (float*)d_out; a.ws = (unsigned char*)d_ws;
#if MK_PER_PHASE
    for (int p = 0; p < NPHASE; ++p) { a.ph_lo = p; a.ph_hi = p + 1; hipLaunchKernelGGL(fwd_kernel, dim3(grid), dim3(NWAVES * 64), LDS_BYTES, stream, a); }
#else
    a.ph_lo = 0; a.ph_hi = NPHASE;
    hipLaunchKernelGGL(fwd_kernel, dim3(grid), dim3(NWAVES * 64), LDS_BYTES, stream, a);
#endif
}
```

```cpp
#include <hip/hip_runtime.h>
#include <cstdio>
#include <cstdint>

#define LAS __attribute__((address_space(3)))
#define GAS __attribute__((address_space(1)))
typedef unsigned short bf16_t;
typedef short bf16x8 __attribute__((ext_vector_type(8)));
typedef short s16x4 __attribute__((ext_vector_type(4)));
typedef float f32x4 __attribute__((ext_vector_type(4)));
typedef float f32x2 __attribute__((ext_vector_type(2)));
typedef float f32x16 __attribute__((ext_vector_type(16)));
typedef unsigned u32x4 __attribute__((ext_vector_type(4)));
typedef unsigned u32x2 __attribute__((ext_vector_type(2)));

constexpr int DM = 1024, NB = 8, SEQ = 4096, DSEQ = 64, PAST = 1024;
constexpr int MP = NB * SEQ;
constexpr int MS = NB * DSEQ;
constexpr int MT = MP + MS;
constexpr int KVS = PAST + DSEQ;
constexpr int KVROWS = MP + NB * KVS;
constexpr int NIN = 5920, NINP = 6144, NIN1 = 5888;
constexpr int QW = 1536, KVW = 2048, DFF = 4096, NMEM = 256;
constexpr float EPS = 1e-6f;
constexpr float LOG2E = 1.4426950408889634f;
constexpr float QSCALE = 0.10206207261596577f * LOG2E;
constexpr float MSCALE = 0.0625f * LOG2E;

typedef __bf16 bf16x2_t __attribute__((ext_vector_type(2)));
__device__ __forceinline__ unsigned cvt_pk_bf16(float lo, float hi) { f32x2 v = {lo, hi}; bf16x2_t b = __builtin_convertvector(v, bf16x2_t); return __builtin_bit_cast(unsigned, b); }
__device__ __forceinline__ float bf_lo(unsigned w) { return __builtin_bit_cast(float, w << 16); }
__device__ __forceinline__ float bf_hi(unsigned w) { return __builtin_bit_cast(float, w & 0xffff0000u); }
__device__ __forceinline__ u32x4 pack8(f32x4 a, f32x4 b) { u32x4 w; w.x = cvt_pk_bf16(a[0], a[1]); w.y = cvt_pk_bf16(a[2], a[3]); w.z = cvt_pk_bf16(b[0], b[1]); w.w = cvt_pk_bf16(b[2], b[3]); return w; }
__device__ __forceinline__ void unpack8(u32x4 w, f32x4& a, f32x4& b) { a = (f32x4){bf_lo(w.x), bf_hi(w.x), bf_lo(w.y), bf_hi(w.y)}; b = (f32x4){bf_lo(w.z), bf_hi(w.z), bf_lo(w.w), bf_hi(w.w)}; }
__device__ __forceinline__ float fast_sigmoid(float x) { return __builtin_amdgcn_rcpf(1.0f + __builtin_amdgcn_exp2f(-x * LOG2E)); }
__device__ __forceinline__ float shx(float v, int m) { int z = 0; asm volatile("" : "+v"(z)); const int l = __builtin_amdgcn_mbcnt_hi(~0u, __builtin_amdgcn_mbcnt_lo(~0u, z));
    return __builtin_bit_cast(float, __builtin_amdgcn_ds_bpermute((l ^ m) << 2, __builtin_bit_cast(int, v))); }
__device__ __forceinline__ float wave_sum(float v) {
#pragma unroll
    for (int o = 1; o < 64; o <<= 1) v += shx(v, o);
    return v;
}

namespace pg8 {
constexpr int BM = 256, BK = 64, HALF = 128, HTB = HALF * BK * 2  , STAGE_BYTES = 8 * HTB, NXCD = 8, WGM = 4;
static_assert(WGM * 4 <= 32, "EpiResFinal: a row panel's four owners must share a round");
__host__ __device__ __forceinline__ int lds_byte(int r, int c) { const int st = (r >> 4) * 2 + (c >> 5), rr = r & 15, cc = c & 31, ob = rr * 64 + cc * 2; return st * 1024 + (ob ^ (((ob >> 9) & 1) << 5)); }
__host__ __device__ __forceinline__ void stage_rc(int b, int& R, int& C) { const int st = b / 1024, sb = b % 1024, swz = sb ^ (((sb >> 9) & 1) << 5); R = (st >> 1) * 16 + swz / 64; C = (st & 1) * 32 + (swz % 64) / 2; }
__host__ __device__ __forceinline__ int perm32(int rho) { const int n = rho >> 4, i = rho & 15; return 8 * (i >> 2) + 4 * n + (i & 3); }

struct Unit { int pm, pn; };
struct Dense {
    const bf16_t* A; const bf16_t* Bt; int K, lda, ldb;
    __device__ __forceinline__ const char* aptr(const Unit& u) const { return (const char*)(A + (size_t)u.pm * 256 * lda); }
    __device__ __forceinline__ const char* bptr(const Unit& u) const { return (const char*)(Bt + (size_t)u.pn * 256 * ldb); }
};
struct StaticOrder {
    int nM, nN, nwg, G, c;
    __host__ __device__ void init(int M, int N, int G_, int c_) { nM = M / BM; nN = N / BM; nwg = nM * nN; G = G_; c = c_; }
    __host__ __device__ bool next(int i, Unit& u) const {
        const long L = (long)i * G + c; if (L >= nwg) return false;
        int wgid = (int)L; { const int q = nwg / NXCD, r = nwg % NXCD, xcd = wgid % NXCD, off = wgid / NXCD; wgid = (xcd < r ? xcd * (q + 1) : r * (q + 1) + (xcd - r) * q) + off; }
        const int nig = WGM * nN, gid = wgid / nig, fm = gid * WGM, gsz = (nM - fm) < WGM ? (nM - fm) : WGM;
        u.pm = fm + ((wgid % nig) % gsz); u.pn = (wgid % nig) / gsz; return true;
    }
    __host__ __device__ __forceinline__ int pm_of(int i) const {
        const long L = (long)i * G + c; if (L >= nwg) return -1;
        int wgid = (int)L; { const int q = nwg / NXCD, r = nwg % NXCD, xcd = wgid % NXCD, off = wgid / NXCD; wgid = (xcd < r ? xcd * (q + 1) : r * (q + 1) + (xcd - r) * q) + off; }
        const int nig = WGM * nN, gid = wgid / nig, fm = gid * WGM, gsz = (nM - fm) < WGM ? (nM - fm) : WGM;
        return fm + ((wgid % nig) % gsz);
    }
};

typedef f32x4 Acc[2][2][4][2];

template <class Prob, class Epi, class Sched>
__device__ __forceinline__ void gemm_phase(LAS unsigned char* lds, const Prob& P, const Sched& S, const Epi& E) {
    const int tid = threadIdx.x, wid = __builtin_amdgcn_readfirstlane(tid >> 6), lane = tid & 63, wr = wid >> 2, wc = wid & 3, fr = lane & 15, fq = lane >> 4;
    const int nt = P.K / BK;
    unsigned voffA[2], voffB[2];
#pragma unroll
    for (int i = 0; i < 2; ++i) { int R, C; stage_rc(tid * 16 + i * 8192, R, C); const int Rb = (R & ~31) + perm32(R & 31);
        voffA[i] = (unsigned)(R * P.lda + C) * 2u; voffB[i] = (unsigned)(Rb * P.ldb + C) * 2u; }
    const size_t kstep = (size_t)(BK * 2);
    const size_t hstepA = (size_t)HALF * P.lda * 2, hstepB = (size_t)HALF * P.ldb * 2;
    const unsigned ldsw = (unsigned)wid * 1024u;
    const int aoff = lds_byte(wr * 64 + fr, fq * 8), boff = lds_byte(wc * 32 + fr, fq * 8);
#define PG8_SA(b, h) (((b) * 2 + (h)) * HTB)
#define PG8_SB(b, h) ((4 + (b) * 2 + (h)) * HTB)
#define PG8_STAGE(bufoff, gbase, voff) do { _Pragma("unroll") for (int _i = 0; _i < 2; ++_i) \
        __builtin_amdgcn_global_load_lds((const unsigned*)((const char*)(gbase) + (voff)[_i]), (LAS unsigned*)(lds + (bufoff) + ldsw + _i * 8192), 16, 0, 0); } while (0)
#define PG8_LDA(dst, b, h) do { _Pragma("unroll") for (int m = 0; m < 4; ++m) _Pragma("unroll") for (int k = 0; k < 2; ++k) dst[m][k] = *(const LAS bf16x8*)(lds + PG8_SA(b, h) + aoff + m * 2048 + k * 1024); } while (0)
#define PG8_LDB(dst, b, h) do { _Pragma("unroll") for (int n = 0; n < 2; ++n) _Pragma("unroll") for (int k = 0; k < 2; ++k) dst[n][k] = *(const LAS bf16x8*)(lds + PG8_SB(b, h) + boff + n * 2048 + k * 1024); } while (0)
#define PG8_MMA(ai, bj, At, Bt) do { __builtin_amdgcn_s_setprio(1); _Pragma("unroll") for (int m = 0; m < 4; ++m) _Pragma("unroll") for (int n = 0; n < 2; ++n) _Pragma("unroll") for (int k = 0; k < 2; ++k) \
        acc[ai][bj][m][n] = __builtin_amdgcn_mfma_f32_16x16x32_bf16(Bt[n][k], At[m][k], acc[ai][bj][m][n], 0, 0, 0); __builtin_amdgcn_s_setprio(0); } while (0)
#define PG8_WAIT_V(n) asm volatile("s_waitcnt vmcnt(" #n ")" ::: "memory")
#define PG8_WAIT_L(n) asm volatile("s_waitcnt lgkmcnt(" #n ")" ::: "memory")
#define PG8_BAR __builtin_amdgcn_s_barrier()
#define PG8_SCHED __builtin_amdgcn_sched_barrier(0)
    Unit cur, nxt; int ui = 0;
    if (!S.next(0, cur)) return;
    Acc acc;
#pragma unroll
    for (int a = 0; a < 2; ++a)
#pragma unroll
        for (int b = 0; b < 2; ++b)
#pragma unroll
            for (int m = 0; m < 4; ++m)
#pragma unroll
                for (int n = 0; n < 2; ++n) acc[a][b][m][n] = (f32x4){0.f, 0.f, 0.f, 0.f};
    bf16x8 At[4][2], B0[2][2], B1[2][2];
    const char* cA = P.aptr(cur); const char* cB = P.bptr(cur);
    PG8_STAGE(PG8_SB(0, 0), cB, voffB); PG8_STAGE(PG8_SB(0, 1), cB + hstepB, voffB); PG8_STAGE(PG8_SA(0, 0), cA, voffA); PG8_STAGE(PG8_SA(0, 1), cA + hstepA, voffA);
    if (wr == 1) PG8_BAR;
    PG8_WAIT_V(2); PG8_BAR;
    PG8_STAGE(PG8_SB(1, 0), cB + kstep, voffB); PG8_STAGE(PG8_SA(1, 0), cA + kstep, voffA); PG8_STAGE(PG8_SB(1, 1), cB + hstepB + kstep, voffB);
    PG8_WAIT_V(6); PG8_BAR;
    for (;;) {
        const bool has_next = S.next(ui + 1, nxt);
        const char* nA = has_next ? P.aptr(nxt) : cA; const char* nB = has_next ? P.bptr(nxt) : cB;
        for (int t = 0; t < nt; t += 2) {
            const bool last = (t == nt - 2);
            const char* a1 = cA + (size_t)(t + 1) * kstep;
            const char* a2 = last ? nA : cA + (size_t)(t + 2) * kstep; const char* b2 = last ? nB : cB + (size_t)(t + 2) * kstep;
            const char* a3 = a2 + kstep; const char* b3 = b2 + kstep;
            PG8_LDB(B0, 0, 0); PG8_LDB(B1, 0, 1); PG8_SCHED; PG8_LDA(At, 0, 0); PG8_STAGE(PG8_SA(1, 1), a1 + hstepA, voffA);
            PG8_WAIT_V(8); PG8_WAIT_L(0); PG8_BAR; PG8_MMA(0, 0, At, B0); PG8_MMA(0, 1, At, B1); PG8_BAR; PG8_SCHED;
            PG8_LDA(At, 0, 1); PG8_STAGE(PG8_SB(0, 0), b2, voffB); PG8_STAGE(PG8_SB(0, 1), b2 + hstepB, voffB); PG8_STAGE(PG8_SA(0, 0), a2, voffA);
            PG8_WAIT_V(8); PG8_WAIT_L(0); PG8_BAR; PG8_MMA(1, 0, At, B0); PG8_MMA(1, 1, At, B1); PG8_BAR; PG8_SCHED;
            PG8_LDB(B0, 1, 0); PG8_LDB(B1, 1, 1); PG8_SCHED; PG8_LDA(At, 1, 0); PG8_STAGE(PG8_SA(0, 1), a2 + hstepA, voffA);
            PG8_WAIT_V(8); PG8_WAIT_L(0); PG8_BAR; PG8_MMA(0, 0, At, B0); PG8_MMA(0, 1, At, B1); PG8_BAR; PG8_SCHED;
            PG8_LDA(At, 1, 1); PG8_STAGE(PG8_SB(1, 0), b3, voffB); PG8_STAGE(PG8_SB(1, 1), b3 + hstepB, voffB); PG8_STAGE(PG8_SA(1, 0), a3, voffA);
            PG8_WAIT_V(8); PG8_WAIT_L(0); PG8_BAR; PG8_MMA(1, 0, At, B0); PG8_MMA(1, 1, At, B1); PG8_BAR; PG8_SCHED;
        }
        if (wr == 0) PG8_BAR;
        E(acc, cur, wr, wc, fr, fq);
        if (!has_next) break;
#pragma unroll
        for (int a = 0; a < 2; ++a)
#pragma unroll
            for (int b = 0; b < 2; ++b)
#pragma unroll
                for (int m = 0; m < 4; ++m)
#pragma unroll
                    for (int n = 0; n < 2; ++n) acc[a][b][m][n] = (f32x4){0.f, 0.f, 0.f, 0.f};
        cur = nxt; cA = nA; cB = nB; ++ui;
        if (wr == 1) PG8_BAR;
    }
    PG8_WAIT_V(0);
    PG8_BAR;
#undef PG8_SA
#undef PG8_SB
#undef PG8_STAGE
#undef PG8_LDA
#undef PG8_LDB
#undef PG8_MMA
#undef PG8_WAIT_V
#undef PG8_WAIT_L
#undef PG8_BAR
#undef PG8_SCHED
}

struct SplitCtx { float* slabs; unsigned* cnt; volatile LAS unsigned* flag; };
struct Piece { int pm, pn, k0, nk, split, slot, uid, rm; };
__device__ __forceinline__ bool piece_of(int N, int K, int G, int c, int split, int coff, Piece& p) {
    const int nN = N / BM, j = (c + coff) % G, un = j / split; p.slot = j % split; p.uid = un; p.pm = 128 + un / nN; p.pn = un % nN; p.nk = K / BK / split; p.k0 = p.slot * p.nk; p.split = split; p.rm = 0;
    return j < 2 * nN * split;
}
__device__ __forceinline__ bool piece_of_mem(int G, int c, int split, int coff, Piece& p) {
    const int j = (c + coff) % G, un = j / split; p.slot = j % split; p.uid = un; p.pm = 128 + (un >> 2); p.pn = un & 3; p.nk = 16 / split; p.k0 = p.slot * p.nk; p.split = split;
    p.rm = split == 4 ? (1 << p.slot) : 0;
    return j < 32 * split;
}
template <class Prob, class Epi>
__device__ __forceinline__ void gemm_piece(LAS unsigned char* lds, const Prob& P, const Epi& E, const Piece pc, const SplitCtx X) {
    int tid_ = threadIdx.x; asm volatile("" : "+v"(tid_));
    const int tid = tid_, wid = __builtin_amdgcn_readfirstlane(tid >> 6), lane = tid & 63, wr = wid >> 2, wc = wid & 3, fr = lane & 15, fq = lane >> 4;
    unsigned voffA[2], voffB[2];
#pragma unroll
    for (int i = 0; i < 2; ++i) { int R, C; stage_rc(tid * 16 + i * 8192, R, C); const int Rb = (R & ~31) + perm32(R & 31);
        voffA[i] = (unsigned)(R * P.lda + C) * 2u; voffB[i] = (unsigned)(Rb * P.ldb + C) * 2u; }
    const size_t kstep = (size_t)(BK * 2);
    const size_t hstepA = (size_t)HALF * P.lda * 2, hstepB = (size_t)HALF * P.ldb * 2;
    const unsigned ldsw = (unsigned)wid * 1024u;
    const int aoff = lds_byte(wr * 64 + fr, fq * 8), boff = lds_byte(wc * 32 + fr, fq * 8);
#define PG8_SA(b, h) (((b) * 2 + (h)) * HTB)
#define PG8_SB(b, h) ((4 + (b) * 2 + (h)) * HTB)
#define PG8_STAGE(bufoff, gbase, voff) do { _Pragma("unroll") for (int _i = 0; _i < 2; ++_i) \
        __builtin_amdgcn_global_load_lds((const unsigned*)((const char*)(gbase) + (voff)[_i]), (LAS unsigned*)(lds + (bufoff) + ldsw + _i * 8192), 16, 0, 0); } while (0)
#define PG8_LDA(dst, b, h) do { _Pragma("unroll") for (int m = 0; m < 4; ++m) _Pragma("unroll") for (int k = 0; k < 2; ++k) dst[m][k] = *(const LAS bf16x8*)(lds + PG8_SA(b, h) + aoff + m * 2048 + k * 1024); } while (0)
#define PG8_LDB(dst, b, h) do { _Pragma("unroll") for (int n = 0; n < 2; ++n) _Pragma("unroll") for (int k = 0; k < 2; ++k) dst[n][k] = *(const LAS bf16x8*)(lds + PG8_SB(b, h) + boff + n * 2048 + k * 1024); } while (0)
#define PG8_MMA(ai, bj, At, Bt) do { __builtin_amdgcn_s_setprio(1); _Pragma("unroll") for (int m = 0; m < 4; ++m) _Pragma("unroll") for (int n = 0; n < 2; ++n) _Pragma("unroll") for (int k = 0; k < 2; ++k) \
        acc[ai][bj][m][n] = __builtin_amdgcn_mfma_f32_16x16x32_bf16(Bt[n][k], At[m][k], acc[ai][bj][m][n], 0, 0, 0); __builtin_amdgcn_s_setprio(0); } while (0)
#define PG8_WAIT_V(n) asm volatile("s_waitcnt vmcnt(" #n ")" ::: "memory")
#define PG8_WAIT_L(n) asm volatile("s_waitcnt lgkmcnt(" #n ")" ::: "memory")
#define PG8_BAR __builtin_amdgcn_s_barrier()
#define PG8_SCHED __builtin_amdgcn_sched_barrier(0)
    Unit cur; cur.pm = pc.pm; cur.pn = pc.pn;
    Acc acc;
#pragma unroll
    for (int a = 0; a < 2; ++a)
#pragma unroll
        for (int b = 0; b < 2; ++b)
#pragma unroll
            for (int m = 0; m < 4; ++m)
#pragma unroll
                for (int n = 0; n < 2; ++n) acc[a][b][m][n] = (f32x4){0.f, 0.f, 0.f, 0.f};
    {
    bf16x8 At[4][2], B0[2][2], B1[2][2];
    const char* cA = P.aptr(cur) + (size_t)pc.k0 * kstep; const char* cB = P.bptr(cur) + (size_t)pc.k0 * kstep;
    PG8_STAGE(PG8_SB(0, 0), cB, voffB); PG8_STAGE(PG8_SB(0, 1), cB + hstepB, voffB); PG8_STAGE(PG8_SA(0, 0), cA, voffA); PG8_STAGE(PG8_SA(0, 1), cA + hstepA, voffA);
    if (wr == 1) PG8_BAR;
    PG8_WAIT_V(2); PG8_BAR;
    PG8_STAGE(PG8_SB(1, 0), cB + kstep, voffB); PG8_STAGE(PG8_SA(1, 0), cA + kstep, voffA); PG8_STAGE(PG8_SB(1, 1), cB + hstepB + kstep, voffB);
    PG8_WAIT_V(6); PG8_BAR;
    const int nt = pc.nk;
    for (int t = 0; t < nt; t += 2) {
        const bool last = (t == nt - 2);
        const char* a1 = cA + (size_t)(t + 1) * kstep;
        const char* a2 = last ? cA : cA + (size_t)(t + 2) * kstep; const char* b2 = last ? cB : cB + (size_t)(t + 2) * kstep;
        const char* a3 = a2 + kstep; const char* b3 = b2 + kstep;
        PG8_LDB(B0, 0, 0); PG8_LDB(B1, 0, 1); PG8_SCHED; PG8_LDA(At, 0, 0); PG8_STAGE(PG8_SA(1, 1), a1 + hstepA, voffA);
        PG8_WAIT_V(8); PG8_WAIT_L(0); PG8_BAR; PG8_MMA(0, 0, At, B0); PG8_MMA(0, 1, At, B1); PG8_BAR; PG8_SCHED;
        PG8_LDA(At, 0, 1); PG8_STAGE(PG8_SB(0, 0), b2, voffB); PG8_STAGE(PG8_SB(0, 1), b2 + hstepB, voffB); PG8_STAGE(PG8_SA(0, 0), a2, voffA);
        PG8_WAIT_V(8); PG8_WAIT_L(0); PG8_BAR; PG8_MMA(1, 0, At, B0); PG8_MMA(1, 1, At, B1); PG8_BAR; PG8_SCHED;
        PG8_LDB(B0, 1, 0); PG8_LDB(B1, 1, 1); PG8_SCHED; PG8_LDA(At, 1, 0); PG8_STAGE(PG8_SA(0, 1), a2 + hstepA, voffA);
        PG8_WAIT_V(8); PG8_WAIT_L(0); PG8_BAR; PG8_MMA(0, 0, At, B0); PG8_MMA(0, 1, At, B1); PG8_BAR; PG8_SCHED;
        PG8_LDA(At, 1, 1); PG8_STAGE(PG8_SB(1, 0), b3, voffB); PG8_STAGE(PG8_SB(1, 1), b3 + hstepB, voffB); PG8_STAGE(PG8_SA(1, 0), a3, voffA);
        PG8_WAIT_V(8); PG8_WAIT_L(0); PG8_BAR; PG8_MMA(1, 0, At, B0); PG8_MMA(1, 1, At, B1); PG8_BAR; PG8_SCHED;
    }
    if (wr == 0) PG8_BAR;
    }
    float* ubase = X.slabs + (size_t)pc.uid * pc.split * 65536;
    const __amdgpu_buffer_rsrc_t rs = __builtin_amdgcn_make_buffer_rsrc((void*)ubase, (short)0, pc.split * 262144, 0x00020000);
    { const int so = pc.slot * 262144;
#pragma unroll
      for (int a = 0; a < 2; ++a)
#pragma unroll
          for (int b = 0; b < 2; ++b)
#pragma unroll
              for (int m = 0; m < 4; ++m)
#pragma unroll
                  for (int n = 0; n < 2; ++n) __builtin_amdgcn_raw_buffer_store_b128(__builtin_bit_cast(u32x4, acc[a][b][m][n]), rs, tid * 16, so + ((((a * 2 + b) * 4 + m) * 2 + n) * 8192), 16); }
    asm volatile("s_waitcnt vmcnt(0)" ::: "memory"); __syncthreads();
    if (tid == 0) { (void)__hip_atomic_fetch_add(X.cnt + pc.uid, 1u, __ATOMIC_RELAXED, __HIP_MEMORY_SCOPE_AGENT);
        unsigned sp = 0u; while (__hip_atomic_load(X.cnt + pc.uid, __ATOMIC_RELAXED, __HIP_MEMORY_SCOPE_AGENT) < (unsigned)pc.split) { __builtin_amdgcn_s_sleep(2); if (++sp > (1u << 22)) break; } }
    __syncthreads();
    const int gsz = 8 / pc.split, g0 = pc.slot * gsz;
    const unsigned rowmask = pc.rm ? (unsigned)pc.rm : ((1u << gsz) - 1u) << g0;
#pragma unroll
    for (int a = 0; a < 2; ++a)
#pragma unroll
        for (int b = 0; b < 2; ++b)
#pragma unroll
            for (int m = 0; m < 4; ++m)
#pragma unroll
                for (int n = 0; n < 2; ++n) acc[a][b][m][n] = (f32x4){0.f, 0.f, 0.f, 0.f};
    int nsp = pc.split; asm volatile("" : "+s"(nsp));
    for (int s = 0; s < nsp; ++s) {
#pragma unroll
        for (int a = 0; a < 2; ++a)
#pragma unroll
            for (int m = 0; m < 4; ++m)
                if ((rowmask >> (a * 4 + m)) & 1u) {
#pragma unroll
                    for (int b = 0; b < 2; ++b)
#pragma unroll
                        for (int n = 0; n < 2; ++n) acc[a][b][m][n] += __builtin_bit_cast(f32x4, __builtin_amdgcn_raw_buffer_load_b128(rs, tid * 16, s * 262144 + ((((a * 2 + b) * 4 + m) * 2 + n) * 8192), 16));
                }
    }
    E(acc, cur, wr, wc, fr, fq, rowmask);
    return;
    E(acc, cur, wr, wc, fr, fq);
#undef PG8_SA
#undef PG8_SB
#undef PG8_STAGE
#undef PG8_LDA
#undef PG8_LDB
#undef PG8_MMA
#undef PG8_WAIT_V
#undef PG8_WAIT_L
#undef PG8_BAR
#undef PG8_SCHED
}
}

constexpr size_t MiB = 1u << 20;
constexpr size_t UB = (size_t)MT * 1024 * 2;
constexpr size_t WS_CTL = 0, CTL_ZERO_BYTES = 64 * 1024;
constexpr size_t WS_TAB = 1 * MiB;
constexpr size_t WS_RSTD0 = 2 * MiB;
constexpr size_t WS_RQ = WS_RSTD0 + 256 * 1024;
constexpr size_t WS_RSTDM = WS_RQ + 256 * 1024;
constexpr size_t WS_ST1 = 3 * MiB;
constexpr size_t WS_ST2 = WS_ST1 + 2304 * 1024;
constexpr size_t WS_ST3 = WS_ST2 + 2304 * 1024;
constexpr size_t WS_W = 12 * MiB;
constexpr size_t WS_WIN = WS_W;
constexpr size_t WS_WCO = WS_WIN + (size_t)NINP * 1024 * 2;
constexpr size_t WS_WUQ = WS_WCO + 2 * MiB;
constexpr size_t WS_WUKV = WS_WUQ + (size_t)QW * 512 * 2;
constexpr size_t WS_WMO = WS_WUKV + (size_t)KVW * 256 * 2;
constexpr size_t WS_WMX = WS_WMO + 2 * MiB;
constexpr size_t WS_WQM = WS_WMX + 2 * MiB;
constexpr size_t WS_WKV = WS_WQM + 2 * MiB;
constexpr size_t WS_WOM = WS_WKV + 4 * MiB;
constexpr size_t WS_WUP = WS_WOM + 2 * MiB;
constexpr size_t WS_WDN = WS_WUP + 8 * MiB;
constexpr size_t WS_WEND = WS_WDN + 8 * MiB;
constexpr size_t WS_MB = 57 * MiB;
constexpr size_t WS_MEMK = 61 * MiB;
constexpr size_t WS_MEMV = 69 * MiB;
constexpr size_t WS_CKVB = 77 * MiB;
constexpr size_t WS_KRB = 98 * MiB;
constexpr size_t WS_R1 = 101 * MiB;
constexpr size_t WS_R2 = WS_R1 + UB;
constexpr size_t WS_R3 = WS_R2 + UB;
constexpr size_t WS_R4 = WS_R3 + UB;
constexpr size_t WS_R5 = WS_R4 + UB / 2;
constexpr size_t WS_R6 = WS_R5 + UB / 4;
constexpr size_t WS_R7 = WS_R6 + UB;
constexpr size_t WS_R8 = WS_R7 + UB;
constexpr size_t WS_END = WS_R8 + (size_t)MT * 32 * 2;
constexpr size_t WS_WP = WS_R2, WS_VP = WS_R2 + 32 * MiB;
static_assert(64 * MiB <= UB, "Wp | Vp fit R2");
constexpr size_t WS_SLAB = 477 * MiB;
static_assert(WS_WEND <= WS_MB && WS_END <= WS_SLAB && WS_SLAB + 32 * MiB <= 512 * MiB, "d_ws map");
static_assert(WS_R2 + (size_t)KVROWS * KVW * 2 <= WS_R5, "kv overlays v | g | cq");
static_assert(WS_R2 + 4 * UB <= 512 * MiB, "hmid");

constexpr size_t OUT_Y = 0;
constexpr size_t OUT_CONVP = (size_t)MT * 1024;
constexpr size_t OUT_CKVP = OUT_CONVP + 16384;
constexpr size_t OUT_KRP = OUT_CKVP + (size_t)MP * 256;
constexpr size_t OUT_MEMK = OUT_KRP + (size_t)MP * 32;
constexpr size_t OUT_MEMV = OUT_MEMK + 2097152;
constexpr size_t OUT_CONVS = OUT_MEMV + 2097152;
constexpr size_t OUT_CKVS = OUT_CONVS + 16384;
constexpr size_t OUT_KRS = OUT_CKVS + (size_t)MS * 256;
constexpr size_t OUT_TOTAL = OUT_KRS + (size_t)MS * 32;

constexpr int RING_OFF = 0, RING_BYTES = 131072;
constexpr int SCR_OFF = RING_BYTES;
constexpr int LDSCTL_OFF = SCR_OFF + 8192, MISC_OFF = LDSCTL_OFF + 320;
constexpr int LDS_BYTES = 147456;
constexpr int NWAVES = 8;

#define XB_TMO      128
#define XB_XCNT(j)  (256  + 64 * (j))
#define XB_XSUB(j)  (1280 + 64 * (j))
#define XB_XGEN(j)  (2304 + 64 * (j))
#define XB_TOP      3328
#define XB_TOPGEN   3392
#define XCD_BAR_WORDS 3456
#define XB_SPIN_CAP (1u << 20)
__device__ __forceinline__ unsigned xb_ld(unsigned* p)              { return __hip_atomic_load(p, __ATOMIC_RELAXED, __HIP_MEMORY_SCOPE_AGENT); }
__device__ __forceinline__ unsigned xb_add(unsigned* p, unsigned v) { return __hip_atomic_fetch_add(p, v, __ATOMIC_RELAXED, __HIP_MEMORY_SCOPE_AGENT); }
__device__ __forceinline__ unsigned xb_xcc_id() { return (unsigned)__builtin_amdgcn_s_getreg((3 << 11) | 20) & 0xFu; }
#define XB_SPIN(cond, bar) do { unsigned _sp = 0; while (cond) { __builtin_amdgcn_s_sleep(1); \
    if ((++_sp & 255u) == 0u) { if (xb_ld(&(bar)[XB_TMO])) break; if (_sp > XB_SPIN_CAP) { atomicAdd(&(bar)[XB_TMO], 1u); break; } } } } while (0)
struct XcdBarrier { unsigned* bar; unsigned x; volatile LAS unsigned* st; };
__device__ __forceinline__ XcdBarrier xcd_barrier_post(unsigned* bar, volatile LAS unsigned* st) {
    XcdBarrier b; b.bar = bar; b.x = xb_xcc_id(); b.st = st;
    if (threadIdx.x == 0) (void)xb_add(&bar[XB_XCNT(b.x)], 1u);
    return b;
}
__device__ __forceinline__ void xcd_barrier_complete(unsigned* bar, unsigned x, unsigned& nloc, unsigned& nx) {
    const unsigned G = gridDim.x * gridDim.y * gridDim.z;
    unsigned sum, cnt, mine, sp = 0u;
    for (;;) {
        sum = 0u; cnt = 0u; mine = 0u;
#pragma unroll
        for (unsigned j = 0; j < 16; ++j) { const unsigned c = xb_ld(&bar[XB_XCNT(j)]); sum += c; cnt += (c > 0u) ? 1u : 0u; mine = (j == x) ? c : mine; }
        if (sum == G) break;
        __builtin_amdgcn_s_sleep(1);
        if ((++sp & 255u) == 0u) { if (xb_ld(&bar[XB_TMO])) break; if (sp > XB_SPIN_CAP) { atomicAdd(&bar[XB_TMO], 1u); break; } }
    }
    nloc = mine > 0u ? mine : 1u; nx = cnt > 0u ? cnt : 1u;
}
__device__ __forceinline__ void xcd_barrier(const XcdBarrier& b) {
    asm volatile("s_waitcnt vmcnt(0)" ::: "memory");
    __syncthreads();
    if (threadIdx.x == 0) {
        unsigned* bar = b.bar;
        __builtin_amdgcn_s_waitcnt(0);
        unsigned nloc = b.st[0], nx = b.st[1];
        if (nloc == 0u) { xcd_barrier_complete(bar, b.x, nloc, nx); b.st[0] = nloc; b.st[1] = nx; }
        const unsigned old = xb_add(&bar[XB_XSUB(b.x)], 1u);
        const unsigned gen = old / nloc;
        if (old + 1u == (gen + 1u) * nloc) {
            __builtin_amdgcn_fence(__ATOMIC_RELEASE, "agent");
            asm volatile("s_waitcnt vmcnt(0)" ::: "memory");
            const unsigned og = xb_add(&bar[XB_TOP], 1u);
            const unsigned tg = og / nx;
            if (og + 1u == (tg + 1u) * nx) xb_add(&bar[XB_TOPGEN], 1u);
            else XB_SPIN(xb_ld(&bar[XB_TOPGEN]) == tg, bar);
            __builtin_amdgcn_fence(__ATOMIC_ACQUIRE, "agent");
            xb_add(&bar[XB_XGEN(b.x)], 1u);
            asm volatile("s_waitcnt vmcnt(0)" ::: "memory");
        } else {
            XB_SPIN(xb_ld(&bar[XB_XGEN(b.x)]) == gen, bar);
            __builtin_amdgcn_fence(__ATOMIC_ACQUIRE, "agent");
            asm volatile("s_waitcnt vmcnt(0)" ::: "memory");
        }
    }
    __syncthreads();
}

namespace pg8 {
#define EPI_ROWS(ai, m) (u.pm * 256 + (ai) * 128 + wr * 64 + (m) * 16 + fr)
#define FOR_AI_M _Pragma("unroll") for (int ai = 0; ai < 2; ++ai) _Pragma("unroll") for (int m = 0; m < 4; ++m) if ((rowmask >> (ai * 4 + m)) & 1u)

struct EpiIn {
    const float* rstd0; bf16_t *v, *Bg, *cq, *ckvraw, *sigc, *siga;
    static __device__ __forceinline__ void plain(const Acc& acc, bf16_t* dst, int ld, int ai, int m, float rs) {
#pragma unroll
        for (int bj = 0; bj < 2; ++bj) *(u32x4*)(dst + bj * 128) = pack8(acc[ai][bj][m][0] * rs, acc[ai][bj][m][1] * rs);
    }
    static __device__ __forceinline__ void sigm(const Acc& acc, bf16_t* dst, int ai, int m, float rs) {
#pragma unroll
        for (int bj = 0; bj < 2; ++bj) { f32x4 a = acc[ai][bj][m][0] * rs, b = acc[ai][bj][m][1] * rs;
#pragma unroll
            for (int e = 0; e < 4; ++e) { a[e] = fast_sigmoid(a[e]); b[e] = fast_sigmoid(b[e]); }
            *(u32x4*)(dst + bj * 128) = pack8(a, b); }
    }
    __device__ __forceinline__ void operator()(Acc& acc, const Unit& u, int wr, int wc, int fr, int fq, unsigned rowmask = 0xffu) const {
        const int pn = u.pn, cw = wc * 32 + 8 * fq;
        FOR_AI_M {
            const int r = EPI_ROWS(ai, m); const float rs = rstd0[r];
            if (pn < 8) {
                const float rs2 = rs * rs;
                *(u32x4*)(v + (size_t)r * 1024 + pn * 128 + cw) = pack8(acc[ai][0][m][0] * acc[ai][1][m][0] * rs2, acc[ai][0][m][1] * acc[ai][1][m][1] * rs2);
            } else if (pn < 12) { plain(acc, Bg + (size_t)r * 1024 + (pn - 8) * 256 + cw, 1024, ai, m, rs);
            } else if (pn < 14) { plain(acc, cq + (size_t)r * 512 + (pn - 12) * 256 + cw, 512, ai, m, rs);
            } else if (pn < 15) { plain(acc, ckvraw + (size_t)r * 256 + cw, 256, ai, m, rs);
            } else if (pn < 19) { sigm(acc, sigc + (size_t)r * 1024 + (pn - 15) * 256 + cw, ai, m, rs);
            } else { sigm(acc, siga + (size_t)r * 1024 + (pn - 19) * 256 + cw, ai, m, rs); }
        }
    }
};
struct EpiMemKV {
    const float* rstdm; float *outk, *outv; bf16_t *memk, *memv;
    __device__ __forceinline__ void operator()(Acc& acc, const Unit& u, int wr, int wc, int fr, int fq, unsigned rowmask = 0xffu) const {
        const bool isk = u.pn < 4; const int c0 = (u.pn & 3) * 256 + wc * 32 + 8 * fq; float* out = isk ? outk : outv; bf16_t* cp = isk ? memk : memv;
        FOR_AI_M {
            const int r = EPI_ROWS(ai, m); const float rs = rstdm[r];
#pragma unroll
            for (int bj = 0; bj < 2; ++bj) { const f32x4 a = acc[ai][bj][m][0] * rs, b = acc[ai][bj][m][1] * rs; const size_t off = (size_t)r * 1024 + c0 + bj * 128;
                *(f32x4*)(out + off) = a; *(f32x4*)(out + off + 4) = b; *(u32x4*)(cp + off) = pack8(a, b); }
        }
    }
};
struct EpiGate {
    bf16_t* buf;
    __device__ __forceinline__ void operator()(Acc& acc, const Unit& u, int wr, int wc, int fr, int fq, unsigned rowmask = 0xffu) const {
        const int c0 = u.pn * 256 + wc * 32 + 8 * fq;
        FOR_AI_M { const int r = EPI_ROWS(ai, m);
#pragma unroll
            for (int bj = 0; bj < 2; ++bj) { bf16_t* p = buf + (size_t)r * 1024 + c0 + bj * 128; f32x4 a, b; unpack8(*(const u32x4*)p, a, b);
                *(u32x4*)p = pack8(a * acc[ai][bj][m][0], b * acc[ai][bj][m][1]); } }
    }
};
struct EpiMix {
    const bf16_t* ya; bf16_t* buf;
    __device__ __forceinline__ void operator()(Acc& acc, const Unit& u, int wr, int wc, int fr, int fq, unsigned rowmask = 0xffu) const {
        const int c0 = u.pn * 256 + wc * 32 + 8 * fq;
        FOR_AI_M { const int r = EPI_ROWS(ai, m);
#pragma unroll
            for (int bj = 0; bj < 2; ++bj) { const size_t off = (size_t)r * 1024 + c0 + bj * 128; f32x4 a, b, ya0, ya1; unpack8(*(const u32x4*)(buf + off), a, b); unpack8(*(const u32x4*)(ya + off), ya0, ya1);
                *(u32x4*)(buf + off) = pack8(ya0 + a * acc[ai][bj][m][0], ya1 + b * acc[ai][bj][m][1]); } }
    }
};
struct EpiQ {
    const float* rq; const f32x2* tab; bf16_t* q;
    __device__ __forceinline__ void operator()(Acc& acc, const Unit& u, int wr, int wc, int fr, int fq, unsigned rowmask = 0xffu) const {
        FOR_AI_M {
            const int r = EPI_ROWS(ai, m); const float rs = rq[r];
            const int pos = r < MP ? (r & (SEQ - 1)) : PAST + ((r - MP) & (DSEQ - 1));
#pragma unroll
            for (int bj = 0; bj < 2; ++bj) {
                const int g = u.pn * 8 + bj * 4 + wc;
                f32x4 a = acc[ai][bj][m][0] * rs, b = acc[ai][bj][m][1] * rs;
                if (g % 3 == 2) {
                    const f32x2* t = tab + pos * 16 + 8 * (fq & 1);
                    const float sgn = fq < 2 ? -1.f : 1.f;
#pragma unroll
                    for (int e = 0; e < 4; ++e) { const f32x2 cs0 = t[e], cs1 = t[4 + e];
                        const float pa = shx(a[e], 32), pb = shx(b[e], 32);
                        a[e] = a[e] * cs0.x + sgn * pa * cs0.y; b[e] = b[e] * cs1.x + sgn * pb * cs1.y; }
                }
                *(u32x4*)(q + (size_t)r * QW + g * 32 + 8 * fq) = pack8(a * QSCALE, b * QSCALE);
            }
        }
    }
};
struct EpiPlain {
    bf16_t* out; int ld;
    __device__ __forceinline__ void operator()(Acc& acc, const Unit& u, int wr, int wc, int fr, int fq, unsigned rowmask = 0xffu) const {
        const int c0 = u.pn * 256 + wc * 32 + 8 * fq;
        FOR_AI_M { const int r = EPI_ROWS(ai, m);
#pragma unroll
            for (int bj = 0; bj < 2; ++bj) *(u32x4*)(out + (size_t)r * ld + c0 + bj * 128) = pack8(acc[ai][bj][m][0], acc[ai][bj][m][1]); }
    }
};
struct EpiRes {
    const float* xold_p; const float* xold_s; float* xout; bf16_t* xb; float* stats;
    __device__ __forceinline__ void operator()(Acc& acc, const Unit& u, int wr, int wc, int fr, int fq, unsigned rowmask = 0xffu) const {
        const int c0 = u.pn * 256 + wc * 32 + 8 * fq;
        FOR_AI_M { const int r = EPI_ROWS(ai, m); const float* xo = r < MP ? xold_p + (size_t)r * 1024 : xold_s + (size_t)(r - MP) * 1024; float ss = 0.f;
#pragma unroll
            for (int bj = 0; bj < 2; ++bj) { const int c = c0 + bj * 128; const f32x4 a = *(const f32x4*)(xo + c) + acc[ai][bj][m][0], b = *(const f32x4*)(xo + c + 4) + acc[ai][bj][m][1];
                *(f32x4*)(xout + (size_t)r * 1024 + c) = a; *(f32x4*)(xout + (size_t)r * 1024 + c + 4) = b;
                if (xb) *(u32x4*)(xb + (size_t)r * 1024 + c) = pack8(a, b);
                ss += (a[0] * a[0] + a[1] * a[1]) + (a[2] * a[2] + a[3] * a[3]) + (b[0] * b[0] + b[1] * b[1]) + (b[2] * b[2] + b[3] * b[3]); }
            ss += shx(ss, 16); ss += shx(ss, 32);
            if (fq == 0) stats[(size_t)r * 16 + u.pn * 4 + wc] = ss; }
    }
};
struct EpiResFinal {
    const float* xold_p; const float* xold_s; float* out; float* stats; unsigned* cnt; const float* gfin;
    __device__ __forceinline__ void operator()(Acc& acc, const Unit& u, int wr, int wc, int fr, int fq, unsigned rowmask = 0xffu) const {
        const int c0 = u.pn * 256 + wc * 32 + 8 * fq;
        FOR_AI_M { const int r = EPI_ROWS(ai, m); const float* xo = r < MP ? xold_p + (size_t)r * 1024 : xold_s + (size_t)(r - MP) * 1024; float ss = 0.f;
#pragma unroll
            for (int bj = 0; bj < 2; ++bj) { const int c = c0 + bj * 128; const f32x4 a = *(const f32x4*)(xo + c) + acc[ai][bj][m][0], b = *(const f32x4*)(xo + c + 4) + acc[ai][bj][m][1];
                acc[ai][bj][m][0] = a; acc[ai][bj][m][1] = b;
                ss += (a[0] * a[0] + a[1] * a[1]) + (a[2] * a[2] + a[3] * a[3]) + (b[0] * b[0] + b[1] * b[1]) + (b[2] * b[2] + b[3] * b[3]); }
            ss += shx(ss, 16); ss += shx(ss, 32);
            if (fq == 0) __hip_atomic_store(stats + (size_t)r * 16 + u.pn * 4 + wc, ss, __ATOMIC_RELAXED, __HIP_MEMORY_SCOPE_AGENT); }
        asm volatile("s_waitcnt vmcnt(0)" ::: "memory"); __builtin_amdgcn_s_barrier(); asm volatile("" ::: "memory");
        if (threadIdx.x == 0) { unsigned* cw = cnt + u.pm * 8 + __builtin_ctz(rowmask);
            (void)__hip_atomic_fetch_add(cw, 1u, __ATOMIC_RELAXED, __HIP_MEMORY_SCOPE_AGENT);
            unsigned sp = 0u; while (__hip_atomic_load(cw, __ATOMIC_RELAXED, __HIP_MEMORY_SCOPE_AGENT) < 4u) { __builtin_amdgcn_s_sleep(2); if (++sp > (1u << 22)) break; } }
        asm volatile("s_waitcnt vmcnt(0)" ::: "memory"); __builtin_amdgcn_s_barrier(); asm volatile("" ::: "memory");
        const __amdgpu_buffer_rsrc_t rs = __builtin_amdgcn_make_buffer_rsrc((void*)stats, (short)0, MT * 64, 0x00020000);
        FOR_AI_M { const int r = EPI_ROWS(ai, m);
            const f32x4 s0 = __builtin_bit_cast(f32x4, __builtin_amdgcn_raw_buffer_load_b128(rs, r * 64, 0, 16)), s1 = __builtin_bit_cast(f32x4, __builtin_amdgcn_raw_buffer_load_b128(rs, r * 64 + 16, 0, 16)),
                        s2 = __builtin_bit_cast(f32x4, __builtin_amdgcn_raw_buffer_load_b128(rs, r * 64 + 32, 0, 16)), s3 = __builtin_bit_cast(f32x4, __builtin_amdgcn_raw_buffer_load_b128(rs, r * 64 + 48, 0, 16));
            const float t = ((s0[0] + s0[1]) + (s0[2] + s0[3])) + ((s1[0] + s1[1]) + (s1[2] + s1[3])) + ((s2[0] + s2[1]) + (s2[2] + s2[3])) + ((s3[0] + s3[1]) + (s3[2] + s3[3]));
            const float rsd = __builtin_amdgcn_rsqf(t * (1.0f / 1024.0f) + EPS);
#pragma unroll
            for (int bj = 0; bj < 2; ++bj) { const int c = c0 + bj * 128; const f32x4 g0 = *(const f32x4*)(gfin + c), g1 = *(const f32x4*)(gfin + c + 4);
                *(f32x4*)(out + (size_t)r * 1024 + c) = acc[ai][bj][m][0] * rsd * g0; *(f32x4*)(out + (size_t)r * 1024 + c + 4) = acc[ai][bj][m][1] * rsd * g1; } }
    }
};
__device__ __forceinline__ float row_rstd(const float* stats, int r) {
    const f32x4* s = (const f32x4*)(stats + (size_t)r * 16); const f32x4 a = s[0], b = s[1], c = s[2], d = s[3];
    const float t = ((a[0] + a[1]) + (a[2] + a[3])) + ((b[0] + b[1]) + (b[2] + b[3])) + ((c[0] + c[1]) + (c[2] + c[3])) + ((d[0] + d[1]) + (d[2] + d[3]));
    return __builtin_amdgcn_rsqf(t * (1.0f / 1024.0f) + EPS);
}
template <int ACT> struct EpiNormAct {
    const float* stats; bf16_t* out; int ld; float scale; unsigned rt, pmt;
    __device__ __forceinline__ void operator()(Acc& acc, const Unit& u, int wr, int wc, int fr, int fq, unsigned rowmask = 0xffu) const {
        const int c0 = u.pn * 256 + wc * 32 + 8 * fq;
        int slot = -1;
#pragma unroll
        for (int k = 0; k < 8; ++k) slot = (*reinterpret_cast<const LAS int*>(pmt + 4 * k) == u.pm) ? k : slot;
        slot = __builtin_amdgcn_readfirstlane(slot);
        if (slot >= 0) {
            const LAS float* rp = reinterpret_cast<const LAS float*>(rt + (unsigned)(slot * 256 + wr * 64 + fr) * 4u);
            FOR_AI_M { const int r = EPI_ROWS(ai, m); const float rs = rp[ai * 128 + m * 16] * scale;
#pragma unroll
                for (int bj = 0; bj < 2; ++bj) { f32x4 a = acc[ai][bj][m][0] * rs, b = acc[ai][bj][m][1] * rs;
                    if (ACT == 1) {
#pragma unroll
                        for (int e = 0; e < 4; ++e) { const float x = fmaxf(a[e], 0.f), y = fmaxf(b[e], 0.f); a[e] = x * x; b[e] = y * y; } }
                    *(u32x4*)(out + (size_t)r * ld + c0 + bj * 128) = pack8(a, b); } }
        } else {
            FOR_AI_M { const int r = EPI_ROWS(ai, m); const float rs = row_rstd(stats, r) * scale;
#pragma unroll
                for (int bj = 0; bj < 2; ++bj) { f32x4 a = acc[ai][bj][m][0] * rs, b = acc[ai][bj][m][1] * rs;
                    if (ACT == 1) {
#pragma unroll
                        for (int e = 0; e < 4; ++e) { const float x = fmaxf(a[e], 0.f), y = fmaxf(b[e], 0.f); a[e] = x * x; b[e] = y * y; } }
                    *(u32x4*)(out + (size_t)r * ld + c0 + bj * 128) = pack8(a, b); } }
        }
    }
};

__device__ __forceinline__ int ma_row0(int pm) { return pm < 128 ? pm * 256 : MP + (pm - 128) * DSEQ; }
__device__ __forceinline__ int ma_batch(int pm) { return pm < 128 ? pm >> 4 : 8 + (pm - 128); }
struct ProbMA {
    const bf16_t* A; const bf16_t* W; int K, lda, ldb;
    __device__ __forceinline__ const char* aptr(const Unit& u) const { return (const char*)(A + (size_t)ma_row0(u.pm) * 1024); }
    __device__ __forceinline__ const char* bptr(const Unit& u) const { return (const char*)(W + ((size_t)ma_batch(u.pm) * 1024 + u.pn * 256) * 1024); }
};
struct PreOrder {
    int G, c;
    __device__ __forceinline__ bool next(int i, Unit& u) const { const int L = i * G + c; u.pm = L >> 2; u.pn = L & 3; return c >= 0 && L < 256; }
};
struct ProbWp {
    const bf16_t* memk; const bf16_t* wqg; int K, lda, ldb;
    __device__ __forceinline__ const char* aptr(const Unit& u) const { return (const char*)(memk + (size_t)((u.pm >> 2) * 256) * 1024 + (u.pm & 3) * 256); }
    __device__ __forceinline__ const char* bptr(const Unit& u) const { return (const char*)(wqg + (size_t)(u.pn * 256) * 1024 + (u.pm & 3) * 256); }
};
struct ProbVp {
    const bf16_t* womt; const bf16_t* memv; int K, lda, ldb;
    __device__ __forceinline__ const char* aptr(const Unit& u) const { return (const char*)(womt + (size_t)((u.pm & 3) * 256) * 1024 + u.pn * 256); }
    __device__ __forceinline__ const char* bptr(const Unit& u) const { return (const char*)(memv + (size_t)((u.pm >> 2) * 256) * 1024 + u.pn * 256); }
};
struct EpiSoftmaxS {
    const float* stats; float scale; bf16_t* P; LAS float* scr; unsigned rt, pmt;
    __device__ __forceinline__ void operator()(Acc& acc, const Unit& u, int wr, int wc, int fr, int fq, unsigned rowmask = 0xffu) const {
        const int row0 = ma_row0(u.pm), valid = u.pm < 128 ? 256 : DSEQ;
        int slot = -1;
#pragma unroll
        for (int k = 0; k < 8; ++k) slot = (*reinterpret_cast<const LAS int*>(pmt + 4 * k) == u.pm) ? k : slot;
        slot = __builtin_amdgcn_readfirstlane(slot);
        const LAS float* rp = reinterpret_cast<const LAS float*>(rt + (unsigned)((slot < 0 ? 0 : slot) * 256) * 4u);
        FOR_AI_M { const int lr = ai * 128 + wr * 64 + m * 16 + fr; const int rr = row0 + lr < MT ? row0 + lr : MT - 1; const float rs = (slot >= 0 ? rp[lr] : row_rstd(stats, rr)) * scale; float mx = -3.0e38f;
#pragma unroll
            for (int bj = 0; bj < 2; ++bj)
#pragma unroll
                for (int n = 0; n < 2; ++n) { acc[ai][bj][m][n] = acc[ai][bj][m][n] * rs;
#pragma unroll
                    for (int e = 0; e < 4; ++e) mx = fmaxf(mx, acc[ai][bj][m][n][e]); }
            mx = fmaxf(mx, shx(mx, 16)); mx = fmaxf(mx, shx(mx, 32));
            if (fq == 0) scr[lr * 4 + wc] = mx; }
        asm volatile("s_waitcnt lgkmcnt(0)" ::: "memory"); __builtin_amdgcn_s_barrier(); asm volatile("" ::: "memory");
        FOR_AI_M { const int lr = ai * 128 + wr * 64 + m * 16 + fr; const f32x4 q = *(const LAS f32x4*)(scr + lr * 4); const float mx = fmaxf(fmaxf(q[0], q[1]), fmaxf(q[2], q[3])); float sm = 0.f;
#pragma unroll
            for (int bj = 0; bj < 2; ++bj)
#pragma unroll
                for (int n = 0; n < 2; ++n)
#pragma unroll
                    for (int e = 0; e < 4; ++e) { const float p = __builtin_amdgcn_exp2f(acc[ai][bj][m][n][e] - mx); acc[ai][bj][m][n][e] = p; sm += p; }
            sm += shx(sm, 16); sm += shx(sm, 32);
            if (fq == 0) scr[1024 + lr * 4 + wc] = sm; }
        asm volatile("s_waitcnt lgkmcnt(0)" ::: "memory"); __builtin_amdgcn_s_barrier(); asm volatile("" ::: "memory");
        FOR_AI_M { const int lr = ai * 128 + wr * 64 + m * 16 + fr; const f32x4 q = *(const LAS f32x4*)(scr + 1024 + lr * 4); const float inv = __builtin_amdgcn_rcpf((q[0] + q[1]) + (q[2] + q[3]));
            if (lr < valid) {
#pragma unroll
                for (int bj = 0; bj < 2; ++bj) *(u32x4*)(P + (size_t)(row0 + lr) * 1024 + u.pn * 256 + bj * 128 + wc * 32 + 8 * fq) = pack8(acc[ai][bj][m][0] * inv, acc[ai][bj][m][1] * inv); } }
    }
};
struct EpiResM {
    float* x; bf16_t* xb; float* stats;
    __device__ __forceinline__ void operator()(Acc& acc, const Unit& u, int wr, int wc, int fr, int fq, unsigned rowmask = 0xffu) const {
        const int row0 = ma_row0(u.pm), valid = u.pm < 128 ? 256 : DSEQ; const int c0 = u.pn * 256 + wc * 32 + 8 * fq;
        FOR_AI_M { const int lr = ai * 128 + wr * 64 + m * 16 + fr; const bool ok = lr < valid; const int r = ok ? row0 + lr : row0; float* xr = x + (size_t)r * 1024; float ss = 0.f;
#pragma unroll
            for (int bj = 0; bj < 2; ++bj) { const int c = c0 + bj * 128; const f32x4 a = *(const f32x4*)(xr + c) + acc[ai][bj][m][0], b = *(const f32x4*)(xr + c + 4) + acc[ai][bj][m][1];
                if (ok) { *(f32x4*)(xr + c) = a; *(f32x4*)(xr + c + 4) = b; *(u32x4*)(xb + (size_t)r * 1024 + c) = pack8(a, b); }
                ss += (a[0] * a[0] + a[1] * a[1]) + (a[2] * a[2] + a[3] * a[3]) + (b[0] * b[0] + b[1] * b[1]) + (b[2] * b[2] + b[3] * b[3]); }
            ss += shx(ss, 16); ss += shx(ss, 32);
            if (fq == 0 && ok) stats[(size_t)r * 16 + u.pn * 4 + wc] = ss; }
    }
};
#undef EPI_ROWS
#undef FOR_AI_M
}

namespace attn {
constexpr int NSLOT = 4, NOPE_B = 0, ROPE_B = NSLOT * 8192, V_B = ROPE_B + NSLOT * 4096;
constexpr int QR_OFF = V_B + NSLOT * 8192;
__device__ __forceinline__ void glds16(const void* sbase, unsigned voff, unsigned lds_dst) { unsigned keep;
    asm volatile("s_mov_b32 %0, m0\n\ts_mov_b32 m0, %3\n\ts_nop 0\n\tglobal_load_lds_dwordx4 %1, %2\n\ts_mov_b32 m0, %0" : "=&s"(keep) : "v"(voff), "s"(sbase), "s"(lds_dst) : "memory"); }
__device__ __forceinline__ s16x4 vtr(const LAS unsigned char* p) { return __builtin_bit_cast(s16x4, __builtin_amdgcn_ds_read_tr16_b64_v4i16((LAS s16x4*)p)); }
struct Unit { int qrow0, kvrow0, h, ntiles, lim_base, lim_step, nwq; };

__device__ __forceinline__ float row_max32(const f32x16& p0, const f32x16& p1) {
    float a = fmaxf(fmaxf(p0[0], p0[1]), p1[0]), b = fmaxf(fmaxf(p0[2], p0[3]), p1[1]); a = fmaxf(fmaxf(a, p1[2]), p1[3]);
#pragma unroll
    for (int r = 4; r < 16; r += 4) { a = fmaxf(fmaxf(a, p0[r]), p0[r + 1]); b = fmaxf(fmaxf(b, p0[r + 2]), p0[r + 3]); a = fmaxf(fmaxf(a, p1[r]), p1[r + 1]); b = fmaxf(fmaxf(b, p1[r + 2]), p1[r + 3]); }
    const float m = fmaxf(a, b);
    auto rr = __builtin_amdgcn_permlane32_swap(__float_as_uint(m), __float_as_uint(m), false, false);
    return fmaxf(__uint_as_float(rr[0]), __uint_as_float(rr[1]));
}
__device__ __forceinline__ void kfrag(bf16x8& a0, bf16x8& a1, int d0, const unsigned (&ka)[6], int ko) {
    if (d0 < 4) { a0 = *reinterpret_cast<const LAS bf16x8*>(ka[d0] + ko); a1 = *reinterpret_cast<const LAS bf16x8*>(ka[d0] + ko + 32 * 128); }
    else { a0 = *reinterpret_cast<const LAS bf16x8*>(ka[d0] + (ko >> 1)); a1 = *reinterpret_cast<const LAS bf16x8*>(ka[d0] + (ko >> 1) + 32 * 64); }
}
struct NoDma { __device__ __forceinline__ void operator()() const {} };
template <bool DO_QK, class Dma = NoDma>
__device__ __forceinline__ void step(f32x16& pn0, f32x16& pn1, f32x16& pc0, f32x16& pc1, f32x16& o0, f32x16& o1, float& lrun, const bf16x8 qmf, const bf16x8 kneg,
                                     const unsigned (&ka)[6], int ko, const LAS unsigned char* vb, const bf16x8 (&qf)[4], const LAS unsigned char* qr, const Dma& dma = Dma()) {
    bf16x8 fa[2][2];
    if (DO_QK) kfrag(fa[0][0], fa[0][1], 0, ka, ko);
    __builtin_amdgcn_s_setprio(1);
#pragma unroll
    for (int d0 = 0; d0 < 6; ++d0) {
        if (DO_QK) {
            if (d0 + 1 < 6) kfrag(fa[(d0 + 1) & 1][0], fa[(d0 + 1) & 1][1], d0 + 1, ka, ko);
            const bf16x8 qd = d0 < 4 ? qf[d0 < 4 ? d0 : 0] : *(const LAS bf16x8*)(qr + (d0 - 4) * 16);
            if (d0 == 0) { const f32x16 z = {}; pn0 = __builtin_amdgcn_mfma_f32_32x32x16_bf16(fa[0][0], qd, z, 0, 0, 0); pn1 = __builtin_amdgcn_mfma_f32_32x32x16_bf16(fa[0][1], qd, z, 0, 0, 0); }
            else { pn0 = __builtin_amdgcn_mfma_f32_32x32x16_bf16(fa[d0 & 1][0], qd, pn0, 0, 0, 0); pn1 = __builtin_amdgcn_mfma_f32_32x32x16_bf16(fa[d0 & 1][1], qd, pn1, 0, 0, 0); }
        }
        if (d0 == 1) dma();
#pragma unroll
        for (int r = (16 * d0) / 6; r < (16 * (d0 + 1)) / 6; ++r) { pc0[r] = __builtin_amdgcn_exp2f(pc0[r]); pc1[r] = __builtin_amdgcn_exp2f(pc1[r]); }
        asm volatile("" ::: "memory");
    }
    if (DO_QK) {
        pn0 = __builtin_amdgcn_mfma_f32_32x32x16_bf16(kneg, qmf, pn0, 0, 0, 0); pn1 = __builtin_amdgcn_mfma_f32_32x32x16_bf16(kneg, qmf, pn1, 0, 0, 0); }
    { float one = 1.0f; asm volatile("" : "+s"(one));
      float sa = pc0[0], sb = pc1[0];
#pragma unroll
      for (int r = 1; r < 16; ++r) { sa = sa + pc0[r]; sb = __builtin_fmaf(pc1[r], one, sb); }
      lrun += sa + sb; }
    u32x4 pw[4];
    pw[0] = (u32x4){cvt_pk_bf16(pc0[0], pc0[1]), cvt_pk_bf16(pc0[2], pc0[3]), cvt_pk_bf16(pc0[4], pc0[5]), cvt_pk_bf16(pc0[6], pc0[7])};
    pw[1] = (u32x4){cvt_pk_bf16(pc0[8], pc0[9]), cvt_pk_bf16(pc0[10], pc0[11]), cvt_pk_bf16(pc0[12], pc0[13]), cvt_pk_bf16(pc0[14], pc0[15])};
    pw[2] = (u32x4){cvt_pk_bf16(pc1[0], pc1[1]), cvt_pk_bf16(pc1[2], pc1[3]), cvt_pk_bf16(pc1[4], pc1[5]), cvt_pk_bf16(pc1[6], pc1[7])};
    pw[3] = (u32x4){cvt_pk_bf16(pc1[8], pc1[9]), cvt_pk_bf16(pc1[10], pc1[11]), cvt_pk_bf16(pc1[12], pc1[13]), cvt_pk_bf16(pc1[14], pc1[15])};
    s16x4 vl[2][4];
    vl[0][0] = vtr(vb); vl[0][1] = vtr(vb + 512); vl[0][2] = vtr(vb + 4096); vl[0][3] = vtr(vb + 4096 + 512);
#pragma unroll
    for (int ks = 0; ks < 4; ++ks) {
        if (ks + 1 < 4) { const int n = (ks + 1) & 1; vl[n][0] = vtr(vb + (ks + 1) * 1024); vl[n][1] = vtr(vb + (ks + 1) * 1024 + 512); vl[n][2] = vtr(vb + 4096 + (ks + 1) * 1024); vl[n][3] = vtr(vb + 4096 + (ks + 1) * 1024 + 512); }
        const int c = ks & 1; const bf16x8 pb = __builtin_bit_cast(bf16x8, pw[ks]);
        const bf16x8 v0 = (bf16x8){vl[c][0][0], vl[c][0][1], vl[c][0][2], vl[c][0][3], vl[c][1][0], vl[c][1][1], vl[c][1][2], vl[c][1][3]};
        const bf16x8 v1 = (bf16x8){vl[c][2][0], vl[c][2][1], vl[c][2][2], vl[c][2][3], vl[c][3][0], vl[c][3][1], vl[c][3][2], vl[c][3][3]};
        o0 = __builtin_amdgcn_mfma_f32_32x32x16_bf16(v0, pb, o0, 0, 0, 0);
        o1 = __builtin_amdgcn_mfma_f32_32x32x16_bf16(v1, pb, o1, 0, 0, 0);
        asm volatile("" ::: "memory");
    }
    __builtin_amdgcn_s_setprio(0);
}
__device__ __forceinline__ bf16x8 mfrag(float m, int hi) {
    const unsigned h = cvt_pk_bf16(m, 0.f) & 0xffffu; const float mh = __builtin_bit_cast(float, h << 16); const unsigned l = cvt_pk_bf16(m - mh, 0.f) & 0xffffu;
    const unsigned w = hi ? 0u : (h | (l << 16));
    return __builtin_bit_cast(bf16x8, (u32x4){w, 0u, 0u, 0u});
}
constexpr float ATT_BIG = 1099511627776.0f;
__device__ __forceinline__ void rebase(f32x16& p0, f32x16& p1, f32x16& o0, f32x16& o1, float& lrun, float& mrun, bf16x8& qmf, int hi) {
    if (__builtin_amdgcn_ballot_w64(lrun > ATT_BIG) != 0ull) {
        auto rr = __builtin_amdgcn_permlane32_swap(__float_as_uint(lrun), __float_as_uint(lrun), false, false);
        const float lt = __uint_as_float(rr[0]) + __uint_as_float(rr[1]);
        const int e = __builtin_amdgcn_frexp_expf(lt) - 1;
        const int d = e > 0 ? e : 0; const float delta = (float)d, alpha = __builtin_amdgcn_ldexpf(1.0f, -d); mrun += delta; lrun *= alpha; qmf = mfrag(mrun, hi);
#pragma unroll
        for (int r = 0; r < 16; ++r) { p0[r] -= delta; p1[r] -= delta; o0[r] *= alpha; o1[r] *= alpha; }
    }
}
__device__ __forceinline__ void unit(const Unit& U, const bf16_t* __restrict__ Q, const bf16_t* __restrict__ KV, const bf16_t* __restrict__ KR, bf16_t* __restrict__ O, LAS unsigned char* lds) {
    int tid_ = threadIdx.x; asm volatile("" : "+v"(tid_));
    const int tid = tid_, lane = tid & 63, r32 = lane & 31, hi = lane >> 5; const int wid = __builtin_amdgcn_readfirstlane(tid >> 6);
    const bool active = wid < U.nwq; const int mylim = active ? U.lim_base + (wid >> 1) * U.lim_step : 0;
    const int nr = wid * 8 + (lane >> 3), rr = wid * 8 + ((lane & 31) >> 2), vr = 16 * (wid & 3) + (lane >> 2);
    const unsigned voffN = (unsigned)(((U.kvrow0 + nr) * KVW + U.h * 128 + 8 * ((lane & 7) ^ ((nr >> 1) & 7))) * 2);
    const unsigned voffR = (unsigned)(((U.kvrow0 + rr) * 32 + 8 * ((lane & 3) ^ ((rr >> 2) & 3))) * 2);
    const unsigned voffV = (unsigned)(((U.kvrow0 + vr) * KVW + U.h * 128 + 64 + (wid >> 2) * 32 + 8 * (lane & 3)) * 2);
    const unsigned lds0 = (unsigned)(size_t)lds;
#define ATT_DMAS(t, s) do { if (wid < 4) { const char* kvb_ = (const char*)KV + (size_t)(t) * (64 * KVW * 2); const char* krb_ = (const char*)KR + (size_t)(t) * (64 * 32 * 2); \
          \
          \
        glds16(kvb_, voffN, (unsigned)__builtin_amdgcn_readfirstlane(lds0 + NOPE_B + (s) * 8192 + wid * 1024)); \
        glds16(kvb_ + 32 * KVW * 2, voffN, (unsigned)__builtin_amdgcn_readfirstlane(lds0 + NOPE_B + (s) * 8192 + (wid + 4) * 1024)); \
        glds16(kvb_, voffV, (unsigned)__builtin_amdgcn_readfirstlane(lds0 + V_B + (s) * 8192 + wid * 1024)); \
        glds16(kvb_ + 64, voffV, (unsigned)__builtin_amdgcn_readfirstlane(lds0 + V_B + (s) * 8192 + (wid + 4) * 1024)); \
        if (lane < 32) { glds16(krb_, voffR, (unsigned)__builtin_amdgcn_readfirstlane(lds0 + ROPE_B + (s) * 4096 + wid * 512)); \
                         glds16(krb_ + 32 * 64, voffR, (unsigned)__builtin_amdgcn_readfirstlane(lds0 + ROPE_B + (s) * 4096 + (wid + 4) * 512)); } } } while (0)
#define ATT_DMA(t) ATT_DMAS(t, (t) & 3)
    ATT_DMA(0); ATT_DMA(1); ATT_DMA(2);
    bf16x8 qf[4], qr4 = (bf16x8){0, 0, 0, 0, 0, 0, 0, 0}, qr5 = qr4;
    if (active) {
        const bf16_t* qp = Q + (size_t)(U.qrow0 + wid * 32 + r32) * QW + U.h * 96 + hi * 8;
#pragma unroll
        for (int d0 = 0; d0 < 4; ++d0) qf[d0] = *(const bf16x8*)(qp + d0 * 16);
        qr4 = *(const bf16x8*)(qp + 64); qr5 = *(const bf16x8*)(qp + 80);
    } else {
#pragma unroll
        for (int d0 = 0; d0 < 4; ++d0) qf[d0] = (bf16x8){0, 0, 0, 0, 0, 0, 0, 0};
    }
    const LAS unsigned char* qr = lds + QR_OFF + tid * 32;
    *(LAS bf16x8*)(lds + QR_OFF + tid * 32) = qr4; *(LAS bf16x8*)(lds + QR_OFF + tid * 32 + 16) = qr5;
    float mrun = 0.f, lrun = 0.f; f32x16 o0 = {}, o1 = {}, pA0 = {}, pA1 = {}, pB0 = {}, pB1 = {};
    bf16x8 qmf = (bf16x8){0, 0, 0, 0, 0, 0, 0, 0}; const bf16x8 kneg = __builtin_bit_cast(bf16x8, (u32x4){hi ? 0u : 0xBF80BF80u, 0u, 0u, 0u});
    unsigned ka[6];
    { const int xn = ((r32 >> 1) & 7) << 4, xr = ((r32 >> 2) & 3) << 4, hb = hi << 4;
#pragma unroll
      for (int d0 = 0; d0 < 6; ++d0) { unsigned a_ = d0 < 4 ? lds0 + NOPE_B + r32 * 128 + ((d0 * 32 + hb) ^ xn) : lds0 + ROPE_B + r32 * 64 + (((d0 - 4) * 32 + hb) ^ xr); asm volatile("" : "+v"(a_)); ka[d0] = a_; } }
    const int vfo = V_B + (4 * hi + ((lane & 15) >> 2)) * 64 + ((lane >> 4) & 1) * 32 + (lane & 3) * 8;
#define ATT_HEADX(t) do { asm volatile("s_waitcnt vmcnt(6) lgkmcnt(0)\n\ts_barrier" ::: "memory"); ATT_DMA((t) + 3); } while (0)
#define ATT_HEAD(t) do { if ((t) + 2 < U.ntiles) asm volatile("s_waitcnt vmcnt(6) lgkmcnt(0)\n\ts_barrier" ::: "memory"); else asm volatile("s_waitcnt vmcnt(0) lgkmcnt(0)\n\ts_barrier" ::: "memory"); \
        if ((t) + 3 < U.ntiles) ATT_DMA((t) + 3); } while (0)
#define ATT_FULLS(PC0, PC1, PN0, PN1, s0, s1) do { \
        step<true>(PN0, PN1, PC0, PC1, o0, o1, lrun, qmf, kneg, ka, (s1) * 8192, lds + (s0) * 8192 + vfo, qf, qr); rebase(PN0, PN1, o0, o1, lrun, mrun, qmf, hi); } while (0)
#define ATT_BARX asm volatile("s_waitcnt vmcnt(6) lgkmcnt(0)\n\ts_barrier" ::: "memory")
#define ATT_FULLD(PC0, PC1, PN0, PN1, s0, s1, td, sd) do { auto dma_ = [&]() { ATT_DMAS(td, sd); }; \
        step<true>(PN0, PN1, PC0, PC1, o0, o1, lrun, qmf, kneg, ka, (s1) * 8192, lds + (s0) * 8192 + vfo, qf, qr, dma_); rebase(PN0, PN1, o0, o1, lrun, mrun, qmf, hi); } while (0)
#define ATT_FULL(PC0, PC1, PN0, PN1, j) ATT_FULLS(PC0, PC1, PN0, PN1, (j) & 3, ((j) + 1) & 3)
#define ATT_LAST(PC0, PC1, PN0, PN1, j) do { const int s0_ = (j) & 3; \
        step<false>(PN0, PN1, PC0, PC1, o0, o1, lrun, qmf, kneg, ka, 0, lds + s0_ * 8192 + vfo, qf, qr); } while (0)
#define ATT_HEADS(t, s) do { asm volatile("s_waitcnt vmcnt(6) lgkmcnt(0)\n\ts_barrier" ::: "memory"); ATT_DMAS((t) + 3, s); } while (0)
    ATT_HEAD(0);
    int j = 1;
    if (0 < mylim) {
        {
#pragma unroll
            for (int d0 = 0; d0 < 6; ++d0) { bf16x8 a0_, a1_; kfrag(a0_, a1_, d0, ka, 0); const bf16x8 qd_ = d0 < 4 ? qf[d0 < 4 ? d0 : 0] : (d0 == 4 ? qr4 : qr5);
                pA0 = __builtin_amdgcn_mfma_f32_32x32x16_bf16(a0_, qd_, pA0, 0, 0, 0); pA1 = __builtin_amdgcn_mfma_f32_32x32x16_bf16(a1_, qd_, pA1, 0, 0, 0); }
            mrun = row_max32(pA0, pA1); qmf = mfrag(mrun, hi);
#pragma unroll
            for (int r_ = 0; r_ < 16; ++r_) { pA0[r_] -= mrun; pA1[r_] -= mrun; }
        }
        j = 0;
        while (j + 4 < mylim && j + 7 < U.ntiles) {
            ATT_FULLS(pA0, pA1, pB0, pB1, 0, 1); ATT_BARX; ATT_FULLD(pB0, pB1, pA0, pA1, 1, 2, j + 4, 0); ATT_BARX;
            ATT_FULLD(pA0, pA1, pB0, pB1, 2, 3, j + 5, 1); ATT_BARX; ATT_FULLD(pB0, pB1, pA0, pA1, 3, 0, j + 6, 2); ATT_HEADS(j + 4, 3); j += 4; }
        while (j + 2 < mylim && j + 5 < U.ntiles) { ATT_FULL(pA0, pA1, pB0, pB1, j); ATT_HEADX(j + 1); ATT_FULL(pB0, pB1, pA0, pA1, j + 1); ATT_HEADX(j + 2); j += 2; }
        while (j + 2 < mylim) { ATT_FULL(pA0, pA1, pB0, pB1, j); ATT_HEAD(j + 1); ATT_FULL(pB0, pB1, pA0, pA1, j + 1); ATT_HEAD(j + 2); j += 2; }
        if (j + 1 < mylim) { ATT_FULL(pA0, pA1, pB0, pB1, j); ATT_HEAD(j + 1); ATT_LAST(pB0, pB1, pA0, pA1, j + 1); j += 2; }
        else { ATT_LAST(pA0, pA1, pB0, pB1, j); j += 1; }
    }
    for (; j < U.ntiles; ++j) ATT_HEAD(j);
#undef ATT_HEADX
#undef ATT_HEAD
#undef ATT_FULL
#undef ATT_LAST
#undef ATT_FULLS
#undef ATT_FULLD
#undef ATT_BARX
#undef ATT_HEADS
#undef ATT_DMAS
#undef ATT_DMA
    asm volatile("s_waitcnt vmcnt(0) lgkmcnt(0)\n\ts_barrier" ::: "memory");
    if (active) {
        const float lt = lrun + shx(lrun, 32), inv = __builtin_amdgcn_rcpf(lt);
        bf16_t* op = O + (size_t)(U.qrow0 + wid * 32 + r32) * 1024 + U.h * 64 + 8 * hi;
#pragma unroll
        for (int dh = 0; dh < 2; ++dh) {
            const f32x16& oo = dh ? o1 : o0;
#pragma unroll
            for (int g = 0; g < 4; g += 2) {
                const unsigned a0 = cvt_pk_bf16(oo[4 * g] * inv, oo[4 * g + 1] * inv), a1 = cvt_pk_bf16(oo[4 * g + 2] * inv, oo[4 * g + 3] * inv);
                const unsigned b0 = cvt_pk_bf16(oo[4 * g + 4] * inv, oo[4 * g + 5] * inv), b1 = cvt_pk_bf16(oo[4 * g + 6] * inv, oo[4 * g + 7] * inv);
                auto s0 = __builtin_amdgcn_permlane32_swap(a0, b0, false, false); auto s1 = __builtin_amdgcn_permlane32_swap(a1, b1, false, false);
                *(u32x4*)(op + dh * 32 + 8 * g) = (u32x4){s0[0], s1[0], s0[1], s1[1]};
            }
        }
    }
}
__device__ __forceinline__ void phase(int vcu, int G, const bf16_t* Q, const bf16_t* KV, const bf16_t* KR, bf16_t* O, LAS unsigned char* lds) {
    for (int w = vcu; w < 256; w += G) {
        const int g = w >> 3, s = w & 7;
        for (int rnd = 0; rnd < 4; ++rnd) {
            const int bh = g + 32 * rnd, b = bh >> 4, h = bh & 15;
            int qlong, qshort;
            if (rnd < 2) { if (s < 4) { qlong = 15 - 2 * s; qshort = 2 * s + 1; } else { qlong = 14 - 2 * (s - 4); qshort = 2 * (s - 4); } }
            else { qlong = 15 - s; qshort = s; }
            for (int k = 0; k < 2; ++k) {
                const int qb = k ? qshort : qlong;
                Unit U; U.qrow0 = b * SEQ + qb * 256; U.kvrow0 = b * SEQ; U.h = h; U.ntiles = 4 * qb + 4; U.lim_base = 4 * qb + 1; U.lim_step = 1; U.nwq = 8;
                unit(U, Q, KV, KR, O, lds);
            }
        }
        if (s >= 4) {
            const int su = g * 4 + (s - 4), b = su >> 4, h = su & 15;
            Unit U; U.qrow0 = MP + b * DSEQ; U.kvrow0 = MP + b * KVS; U.h = h; U.ntiles = KVS / 64; U.lim_base = KVS / 64; U.lim_step = 0; U.nwq = 2;
            unit(U, Q, KV, KR, O, lds);
        }
    }
}
}

struct Args { const float* in[28]; float* out; unsigned char* ws; int ph_lo, ph_hi; };

__device__ __forceinline__ unsigned f2bf(float f) { unsigned u = __builtin_bit_cast(unsigned, f); return (u + 0x7fffu + ((u >> 16) & 1u)) >> 16; }
__device__ __forceinline__ unsigned pk2(float lo, float hi) { return f2bf(lo) | (f2bf(hi) << 16); }

__device__ __forceinline__ void transpose_item(const float* W, int N, const float* gain, bf16_t* WT, size_t ldw, int coff, int k0, int n0, int drow0, LAS float* scr, int lane) {
    float wv[32];
#pragma unroll
    for (int i = 0; i < 32; ++i) wv[i] = W[(size_t)(k0 + 2 * i + (lane >> 5)) * N + n0 + (lane & 31)];
    if (gain) {
#pragma unroll
        for (int i = 0; i < 32; ++i) wv[i] *= gain[k0 + 2 * i + (lane >> 5)];
    }
#pragma unroll
    for (int i = 0; i < 32; ++i) scr[(2 * i + (lane >> 5)) * 33 + (lane & 31)] = wv[i];
    asm volatile("s_waitcnt lgkmcnt(0)" ::: "memory");
    const int c = lane & 7;
#pragma unroll
    for (int j = 0; j < 4; ++j) { const int n = (lane >> 3) + 8 * j; const LAS float* s = scr + (8 * c) * 33 + n;
        u32x4 o; o.x = pk2(s[0 * 33], s[1 * 33]); o.y = pk2(s[2 * 33], s[3 * 33]); o.z = pk2(s[4 * 33], s[5 * 33]); o.w = pk2(s[6 * 33], s[7 * 33]);
        *(u32x4*)(WT + (size_t)(drow0 + n) * ldw + coff + k0 + 8 * c) = o; }
    asm volatile("s_waitcnt lgkmcnt(0)" ::: "memory");
}
__device__ __forceinline__ int win_row(int n0) {
    if (n0 < 1024) return (n0 >> 7) * 256 + (n0 & 127);
    if (n0 < 2048) return 2048 + (n0 - 1024);
    if (n0 < 3072) { const int j = n0 - 2048; return (j >> 7) * 256 + 128 + (j & 127); }
    if (n0 < 3840) return n0;
    if (n0 < 3872) return 5888 + (n0 - 3840);
    return n0 - 32;
}

__device__ __forceinline__ void rope_cs(int pos, int i, float& c, float& s) {
    float iv = 1.0f;
    iv = (i == 1) ? 0.5623413324356079f : iv;
    iv = (i == 2) ? 0.3162277638912201f : iv;
    iv = (i == 3) ? 0.17782793939113617f : iv;
    iv = (i == 4) ? 0.10000000149011612f : iv;
    iv = (i == 5) ? 0.05623413249850273f : iv;
    iv = (i == 6) ? 0.03162277489900589f : iv;
    iv = (i == 7) ? 0.017782794311642647f : iv;
    iv = (i == 8) ? 0.009999999776482582f : iv;
    iv = (i == 9) ? 0.005623413249850273f : iv;
    iv = (i == 10) ? 0.003162277629598975f : iv;
    iv = (i == 11) ? 0.0017782794311642647f : iv;
    iv = (i == 12) ? 0.0010000000474974513f : iv;
    iv = (i == 13) ? 0.000562341301701963f : iv;
    iv = (i == 14) ? 0.0003162277571391314f : iv;
    iv = (i == 15) ? 0.00017782794020604342f : iv;
    const float ang = (float)pos * iv;
    const float n = rintf(ang * 0.15915494309189535f);
    float r = fmaf(-n, 6.2831854820251465f, ang); r = fmaf(-n, -1.7484555e-7f, r);
    c = __cosf(r); s = __sinf(r);
}

__global__ void __launch_bounds__(NWAVES * 64, 2) fwd_kernel(Args args) {
    extern __shared__ __attribute__((aligned(16))) unsigned char lds_raw[];
    LAS unsigned char* lds = (LAS unsigned char*)lds_raw;
    volatile LAS unsigned* MISC = (volatile LAS unsigned*)(lds + MISC_OFF);
    const int wave = __builtin_amdgcn_readfirstlane((int)threadIdx.x >> 6);
    const int G = gridDim.x; const int bx = blockIdx.x; const int vcu = (G % 8 == 0) ? (bx % 8) * (G / 8) + bx / 8 : bx;
    unsigned char* ws = args.ws; float* out = args.out;
    unsigned* ctl = (unsigned*)(ws + WS_CTL);
    for (int u = threadIdx.x; u < (LDS_BYTES - LDSCTL_OFF) / 4; u += NWAVES * 64) ((LAS unsigned*)(lds + LDSCTL_OFF))[u] = 0u;
    __syncthreads();
    const int lo = args.ph_lo, hi = args.ph_hi;
    const bool multi = (hi - lo) > 1;
    XcdBarrier bar; bar.bar = ctl; bar.x = 0; bar.st = nullptr;
    if (multi) bar = xcd_barrier_post(ctl, MISC + 8);
#define IN(k) (({ asm volatile("" : "+s"(kp)); }), (lo <= (k) && (k) < hi))
#define TID_LANE int tid = threadIdx.x; asm volatile("" : "+v"(tid)); const int lane = tid & 63;
#define SEAM(k) do { if (IN(k) && IN((k) + 1)) xcd_barrier(bar); } while (0)
    const int gw = vcu * NWAVES + wave, NGW = G * NWAVES;

    const __attribute__((address_space(4))) unsigned char* kp = (const __attribute__((address_space(4))) unsigned char*)__builtin_amdgcn_kernarg_segment_ptr();
#define KIN(k) (((const float* const __attribute__((address_space(4)))*)kp)[k])
#define x_prompt KIN(0)
#define x_sample KIN(1)
#define cache_conv KIN(2)
#define cache_ckv KIN(3)
#define cache_krope KIN(4)
#define cache_mem_k KIN(5)
#define cache_mem_v KIN(6)
#define mem_prompt KIN(7)
#define g_mix KIN(8)
#define w_in KIN(9)
#define w_conv KIN(10)
#define w_conv_out KIN(11)
#define g_q KIN(12)
#define w_uq KIN(13)
#define g_kv KIN(14)
#define w_ukv KIN(15)
#define w_mla_out KIN(16)
#define w_mix_out KIN(17)
#define g_mem_q KIN(18)
#define g_mem_kv KIN(19)
#define w_qm KIN(20)
#define w_km KIN(21)
#define w_vm KIN(22)
#define w_om KIN(23)
#define g_mlp KIN(24)
#define w_up KIN(25)
#define w_down KIN(26)
#define g_final KIN(27)
    f32x2* tab = (f32x2*)(ws + WS_TAB);
    float* rstd0 = (float*)(ws + WS_RSTD0); float* rq = (float*)(ws + WS_RQ); float* rstdm = (float*)(ws + WS_RSTDM);
    float* st1 = (float*)(ws + WS_ST1); float* st2 = (float*)(ws + WS_ST2); float* st3 = (float*)(ws + WS_ST3);
    bf16_t* Win_t = (bf16_t*)(ws + WS_WIN); bf16_t* Wco_t = (bf16_t*)(ws + WS_WCO); bf16_t* Wuq_t = (bf16_t*)(ws + WS_WUQ); bf16_t* Wukv_t = (bf16_t*)(ws + WS_WUKV);
    bf16_t* Wmo_t = (bf16_t*)(ws + WS_WMO); bf16_t* Wmx_t = (bf16_t*)(ws + WS_WMX); bf16_t* Wqm_g = (bf16_t*)(ws + WS_WQM); bf16_t* Wkv_t = (bf16_t*)(ws + WS_WKV);
    bf16_t* Wom_t = (bf16_t*)(ws + WS_WOM); bf16_t* Wup_t = (bf16_t*)(ws + WS_WUP); bf16_t* Wdn_t = (bf16_t*)(ws + WS_WDN);
    bf16_t* mb = (bf16_t*)(ws + WS_MB); bf16_t* memk = (bf16_t*)(ws + WS_MEMK); bf16_t* memv = (bf16_t*)(ws + WS_MEMV); bf16_t* Wp = (bf16_t*)(ws + WS_WP); bf16_t* Vp = (bf16_t*)(ws + WS_VP);
    bf16_t* ckvb = (bf16_t*)(ws + WS_CKVB); bf16_t* krb = (bf16_t*)(ws + WS_KRB);
    bf16_t* R1 = (bf16_t*)(ws + WS_R1); bf16_t* R2 = (bf16_t*)(ws + WS_R2); bf16_t* R3 = (bf16_t*)(ws + WS_R3); bf16_t* R4 = (bf16_t*)(ws + WS_R4);
    bf16_t* R5 = (bf16_t*)(ws + WS_R5); bf16_t* R6 = (bf16_t*)(ws + WS_R6); bf16_t* R7 = (bf16_t*)(ws + WS_R7); bf16_t* R8 = (bf16_t*)(ws + WS_R8);
    float* slabs = (float*)(ws + WS_SLAB);
    bf16_t* cqb = (bf16_t*)out + (size_t)MT * QW;
    bf16_t* qbuf = (bf16_t*)out;

    if (IN(0)) { TID_LANE
        { constexpr int WKP = 1032; LAS unsigned short* wk = (LAS unsigned short*)(lds + RING_OFF);
          for (int k = tid; k < 1024; k += NWAVES * 64) { const float gk = g_mix[k]; const float* src = w_in + (size_t)k * NIN + 3840;
#pragma unroll
              for (int j4 = 0; j4 < 8; ++j4) { const f32x4 v = *(const f32x4*)(src + 4 * j4) * gk;
#pragma unroll
                  for (int e = 0; e < 4; ++e) wk[(4 * j4 + e) * WKP + k] = (unsigned short)(cvt_pk_bf16(v[e], 0.f) & 0xffffu); } }
          __syncthreads();
          const int rr = lane & 15, q = lane >> 4;
          const LAS unsigned char* wkb = lds + RING_OFF + (rr * WKP + 8 * q) * 2;
          f32x4 acc0, acc1; float ss;
#define P0_LOAD4(A, src, kc) do { _Pragma("unroll") for (int u = 0; u < 4; ++u) { A[u][0] = *(const f32x4*)((src) + 32 * ((kc) + u)); A[u][1] = *(const f32x4*)((src) + 32 * ((kc) + u) + 4); } } while (0)
#define P0_PROC4(A, dst, kc) do { _Pragma("unroll") for (int u = 0; u < 4; ++u) { \
              ss += (A[u][0][0] * A[u][0][0] + A[u][0][1] * A[u][0][1]) + (A[u][0][2] * A[u][0][2] + A[u][0][3] * A[u][0][3]) + (A[u][1][0] * A[u][1][0] + A[u][1][1] * A[u][1][1]) + (A[u][1][2] * A[u][1][2] + A[u][1][3] * A[u][1][3]); \
              const u32x4 pk = pack8(A[u][0], A[u][1]); *(u32x4*)((dst) + 32 * ((kc) + u)) = pk; const bf16x8 af = __builtin_bit_cast(bf16x8, pk); \
              const bf16x8 b0 = *(const LAS bf16x8*)(wkb + ((kc) + u) * 64), b1 = *(const LAS bf16x8*)(wkb + 16 * WKP * 2 + ((kc) + u) * 64); \
              acc0 = __builtin_amdgcn_mfma_f32_16x16x32_bf16(af, b0, acc0, 0, 0, 0); acc1 = __builtin_amdgcn_mfma_f32_16x16x32_bf16(af, b1, acc1, 0, 0, 0); } } while (0)
#define P0_FINISH(R0) do { ss += shx(ss, 16); ss += shx(ss, 32); const float rs = 1.0f / sqrtf(ss * (1.0f / 1024.0f) + EPS); if (q == 0) rstd0[(R0) + rr] = rs; \
              _Pragma("unroll") for (int e = 0; e < 4; ++e) { const float rse = __builtin_bit_cast(float, __builtin_amdgcn_ds_bpermute((4 * q + e) << 2, __builtin_bit_cast(int, rs))); \
                  unsigned short* kp = (unsigned short*)R8 + (size_t)((R0) + 4 * q + e) * 32 + rr; \
                  kp[0] = (unsigned short)(cvt_pk_bf16(acc0[e] * rse, 0.f) & 0xffffu); kp[16] = (unsigned short)(cvt_pk_bf16(acc1[e] * rse, 0.f) & 0xffffu); } } while (0)
          for (int bi = gw; bi < MP / 16; bi += NGW) {
              const int R0 = bi * 16; const float* src = x_prompt + (size_t)(R0 + rr) * 1024 + 8 * q; bf16_t* dst = R1 + (size_t)(R0 + rr) * 1024 + 8 * q;
              acc0 = (f32x4){0.f, 0.f, 0.f, 0.f}; acc1 = acc0; ss = 0.f;
              f32x4 a[2][4][2]; P0_LOAD4(a[0], src, 0);
#pragma unroll
              for (int it = 0; it < 8; ++it) { if (it + 1 < 8) P0_LOAD4(a[(it + 1) & 1], src, 4 * (it + 1)); P0_PROC4(a[it & 1], dst, 4 * it); }
              P0_FINISH(R0);
          }
          { LAS float* part = (LAS float*)(lds + RING_OFF + 73728);
            for (int sb = vcu; sb < MS / 16; sb += G) {
              const int R0 = MP + sb * 16; const float* src = x_sample + (size_t)(sb * 16 + rr) * 1024 + 8 * q; bf16_t* dst = R1 + (size_t)(R0 + rr) * 1024 + 8 * q;
              acc0 = (f32x4){0.f, 0.f, 0.f, 0.f}; acc1 = acc0; ss = 0.f;
              f32x4 a[4][2]; P0_LOAD4(a, src, 4 * wave); P0_PROC4(a, dst, 4 * wave);
              LAS float* mine = part + (wave * 9) * 64 + lane;
              mine[0] = ss;
#pragma unroll
              for (int e = 0; e < 4; ++e) { mine[(1 + e) * 64] = acc0[e]; mine[(5 + e) * 64] = acc1[e]; }
              __syncthreads();
              if (wave == 0) {
                  ss = 0.f; acc0 = (f32x4){0.f, 0.f, 0.f, 0.f}; acc1 = acc0;
                  for (int w = 0; w < NWAVES; ++w) { const LAS float* o = part + (w * 9) * 64 + lane; ss += o[0];
#pragma unroll
                      for (int e = 0; e < 4; ++e) { acc0[e] += o[(1 + e) * 64]; acc1[e] += o[(5 + e) * 64]; } }
                  P0_FINISH(R0);
              }
              __syncthreads();
            } }
#undef P0_LOAD4
#undef P0_PROC4
#undef P0_FINISH
          __syncthreads();
        }
        LAS float* scr = (LAS float*)(lds + RING_OFF + wave * 16384);
        int it = gw;
#define WJ(W, K, N, gain, dst, ldw, coff, mode) do { const int nblk = (N) / 32, nitems = ((K) / 64) * nblk; \
            for (; it < nitems; it += NGW) { const int kb = it / nblk, nb = it % nblk, n0 = nb * 32; transpose_item(W, N, gain, dst, (size_t)(ldw), coff, kb * 64, n0, (mode) ? win_row(n0) : n0, scr, lane); } \
            it -= nitems; } while (0)
        WJ(w_in, 1024, NIN, g_mix, Win_t, 1024, 0, 1);
        WJ(w_conv_out, 1024, 1024, (const float*)nullptr, Wco_t, 1024, 0, 0);
        WJ(w_uq, 512, QW, g_q, Wuq_t, 512, 0, 0);
        WJ(w_ukv, 256, KVW, (const float*)nullptr, Wukv_t, 256, 0, 0);
        WJ(w_mla_out, 1024, 1024, (const float*)nullptr, Wmo_t, 1024, 0, 0);
        WJ(w_mix_out, 1024, 1024, (const float*)nullptr, Wmx_t, 1024, 0, 0);
        WJ(w_km, 1024, 1024, g_mem_kv, Wkv_t, 1024, 0, 0);
        WJ(w_vm, 1024, 1024, g_mem_kv, Wkv_t + (size_t)1024 * 1024, 1024, 0, 0);
        WJ(w_om, 1024, 1024, (const float*)nullptr, Wom_t, 1024, 0, 0);
        WJ(w_up, 1024, DFF, g_mlp, Wup_t, 1024, 0, 0);
        WJ(w_down, DFF, 1024, (const float*)nullptr, Wdn_t, DFF, 0, 0);
#undef WJ
        for (int r = MT + gw; r < MT + 2048; r += NGW) {
            const float* src = r < MP ? x_prompt + (size_t)r * 1024 : (r < MT ? x_sample + (size_t)(r - MP) * 1024 : mem_prompt + (size_t)(r - MT) * 1024);
            bf16_t* dst = r < MT ? R1 + (size_t)r * 1024 : mb + (size_t)(r - MT) * 1024;
            f32x4 v[4]; float s = 0.f;
#pragma unroll
            for (int j = 0; j < 4; ++j) { v[j] = *(const f32x4*)(src + 256 * j + 4 * lane); s += (v[j][0] * v[j][0] + v[j][1] * v[j][1]) + (v[j][2] * v[j][2] + v[j][3] * v[j][3]); }
            s = wave_sum(s); const float rs = 1.0f / sqrtf(s * (1.0f / 1024.0f) + EPS);
            if (lane == 0) { if (r < MT) rstd0[r] = rs; else rstdm[r - MT] = rs; }
#pragma unroll
            for (int j = 0; j < 4; ++j) *(u32x2*)(dst + 256 * j + 4 * lane) = (u32x2){cvt_pk_bf16(v[j][0], v[j][1]), cvt_pk_bf16(v[j][2], v[j][3])};
        }
        for (int i = gw * 64 + lane; i < NB * PAST * 256 / 8; i += NGW * 64) { const int e = i * 8, row = e >> 8, c = e & 255, b = row >> 10, t = row & 1023;
            const f32x4 a = *(const f32x4*)(cache_ckv + e), bb = *(const f32x4*)(cache_ckv + e + 4); *(u32x4*)(ckvb + (size_t)(MP + b * KVS + t) * 256 + c) = pack8(a, bb); }
        for (int i = gw * 64 + lane; i < NB * PAST * 32 / 8; i += NGW * 64) { const int e = i * 8, row = e >> 5, c = e & 31, b = row >> 10, t = row & 1023;
            const f32x4 a = *(const f32x4*)(cache_krope + e), bb = *(const f32x4*)(cache_krope + e + 4); *(u32x4*)(krb + (size_t)(MP + b * KVS + t) * 32 + c) = pack8(a, bb); }
        for (int i = gw * 64 + lane; i < 2048 * 1024 / 8; i += NGW * 64) { const size_t e = (size_t)i * 8;
            const f32x4 a = *(const f32x4*)(cache_mem_k + e), bb = *(const f32x4*)(cache_mem_k + e + 4); *(u32x4*)(memk + (size_t)2048 * 1024 + e) = pack8(a, bb); }
        for (int i = gw * 64 + lane; i < 2048 * 1024 / 8; i += NGW * 64) { const size_t e = (size_t)i * 8;
            const f32x4 a = *(const f32x4*)(cache_mem_v + e), bb = *(const f32x4*)(cache_mem_v + e + 4); *(u32x4*)(memv + (size_t)2048 * 1024 + e) = pack8(a, bb); }
        for (int i = gw * 64 + lane; i < 1024 * 1024 / 8; i += NGW * 64) { const size_t e = (size_t)i * 8; const float gk = g_mem_q[e >> 10];
            const f32x4 a = *(const f32x4*)(w_qm + e) * gk, bb = *(const f32x4*)(w_qm + e + 4) * gk; *(u32x4*)(Wqm_g + e) = pack8(a, bb); }
        for (int i = gw * 64 + lane; i < SEQ * 16; i += NGW * 64) { float c, s; rope_cs(i >> 4, i & 15, c, s); tab[i] = (f32x2){c, s}; }
    }
    SEAM(0);

    if (IN(1)) {
        { pg8::Dense P{R1, Win_t, 1024, 1024, 1024}; pg8::StaticOrder S; S.init(MP, NIN1, G, bx);
          pg8::EpiIn E{rstd0, R2, R3, cqb, R5, R6, R7}; pg8::gemm_phase(lds + RING_OFF, P, S, E);
          { pg8::Piece pc; if (pg8::piece_of(NIN1, 1024, G, bx, 2, 128, pc)) pg8::gemm_piece(lds + RING_OFF, P, E, pc, pg8::SplitCtx{out + OUT_Y, ctl + 4096, MISC + 16}); } }
        if (G != 256) { pg8::Dense P{mb, Wkv_t, 1024, 1024, 1024}; pg8::StaticOrder S; S.init(2048, 2048, G, (bx + G - 96) % G);
          pg8::EpiMemKV E{rstdm, out + OUT_MEMK, out + OUT_MEMV, memk, memv}; pg8::gemm_phase(lds + RING_OFF, P, S, E); }
    }
    SEAM(1);

    if (IN(2)) {
        const bool kvcu = G == 256 && (vcu & 31) < 8;
        if (kvcu) { pg8::Dense P{mb, Wkv_t, 1024, 1024, 1024}; pg8::StaticOrder S; S.init(2048, 2048, 64, (vcu >> 5) * 8 + (vcu & 31));
            pg8::EpiMemKV E{rstdm, out + OUT_MEMK, out + OUT_MEMV, memk, memv}; pg8::gemm_phase(lds + RING_OFF, P, S, E); }
        TID_LANE
        int h0, h1, nh;
        if (G == 256) { nh = 3584; if (kvcu) { h0 = 3072 + ((vcu >> 5) * 8 + (vcu & 31)) * NWAVES + wave; h1 = h0 + 1; } else { h0 = 2 * (((vcu >> 5) * 24 + (vcu & 31) - 8) * NWAVES + wave); h1 = h0 + 2; } }
        else { nh = G * NWAVES; h0 = vcu * NWAVES + wave; h1 = h0 + 1; }
        const int rbeg = (int)(((long)h0 * MT) / nh), rend = (int)(((long)h1 * MT) / nh);
        f32x4 wc_[2][6];
#pragma unroll
        for (int hh = 0; hh < 2; ++hh) { const int c = hh * 512 + lane * 8;
#pragma unroll
            for (int k = 0; k < 3; ++k) { wc_[hh][2 * k] = *(const f32x4*)(w_conv + k * 1024 + c); wc_[hh][2 * k + 1] = *(const f32x4*)(w_conv + k * 1024 + c + 4); } }
        const f32x4 gkv = *(const f32x4*)(g_kv + lane * 4);
        f32x4 p1[2][2] = {}, p2[2][2] = {};
        u32x4 cv[2], cb[2], ccq; u32x2 cck; unsigned short ckr;
#define P2_LOAD(r_, V, B, CQ, CK, KR) do { _Pragma("unroll") for (int hh = 0; hh < 2; ++hh) { V[hh] = *(const u32x4*)(R2 + (size_t)(r_) * 1024 + hh * 512 + lane * 8); B[hh] = *(const u32x4*)(R3 + (size_t)(r_) * 1024 + hh * 512 + lane * 8); } \
            CQ = *(const u32x4*)(cqb + (size_t)(r_) * 512 + lane * 8); CK = *(const u32x2*)(R5 + (size_t)(r_) * 256 + lane * 4); KR = R8[(size_t)(r_) * 32 + (lane & 31)]; } while (0)
        if (rbeg < rend) {
            P2_LOAD(rbeg, cv, cb, ccq, cck, ckr);
            { const bool isP = rbeg < MP; const int rr = isP ? rbeg : rbeg - MP; const int b = isP ? rr >> 12 : rr >> 6, t = isP ? rr & (SEQ - 1) : rr & (DSEQ - 1);
#pragma unroll
              for (int hh = 0; hh < 2; ++hh) { const int c = hh * 512 + lane * 8;
                  if (t >= 1) unpack8(*(const u32x4*)(R2 + (size_t)(rbeg - 1) * 1024 + c), p1[hh][0], p1[hh][1]);
                  else if (!isP) { p1[hh][0] = *(const f32x4*)(cache_conv + (size_t)(b * 2 + 1) * 1024 + c); p1[hh][1] = *(const f32x4*)(cache_conv + (size_t)(b * 2 + 1) * 1024 + c + 4); }
                  if (t >= 2) unpack8(*(const u32x4*)(R2 + (size_t)(rbeg - 2) * 1024 + c), p2[hh][0], p2[hh][1]);
                  else if (!isP) { p2[hh][0] = *(const f32x4*)(cache_conv + (size_t)(b * 2 + t) * 1024 + c); p2[hh][1] = *(const f32x4*)(cache_conv + (size_t)(b * 2 + t) * 1024 + c + 4); } } }
        }
        for (int r = rbeg; r < rend; ++r) {
            u32x4 nv[2], nb[2], ncq; u32x2 nck; unsigned short nkr;
            const int rn = r + 1 < rend ? r + 1 : r;
            P2_LOAD(rn, nv, nb, ncq, nck, nkr);
            const bool isP = r < MP; const int rr = isP ? r : r - MP; const int b = isP ? rr >> 12 : rr >> 6, t = isP ? rr & (SEQ - 1) : rr & (DSEQ - 1), T = isP ? SEQ : DSEQ;
            const int kvrow = isP ? r : MP + b * KVS + PAST + t, pos = isP ? t : PAST + t;
            float* oconv = out + (isP ? OUT_CONVP : OUT_CONVS); float* ockv = out + (isP ? OUT_CKVP : OUT_CKVS); float* okr = out + (isP ? OUT_KRP : OUT_KRS);
            if (t == 0) {
#pragma unroll
                for (int hh = 0; hh < 2; ++hh) { const int c = hh * 512 + lane * 8;
                    if (isP) { p1[hh][0] = p1[hh][1] = p2[hh][0] = p2[hh][1] = (f32x4){0.f, 0.f, 0.f, 0.f}; }
                    else { p1[hh][0] = *(const f32x4*)(cache_conv + (size_t)(b * 2 + 1) * 1024 + c); p1[hh][1] = *(const f32x4*)(cache_conv + (size_t)(b * 2 + 1) * 1024 + c + 4);
                           p2[hh][0] = *(const f32x4*)(cache_conv + (size_t)(b * 2) * 1024 + c); p2[hh][1] = *(const f32x4*)(cache_conv + (size_t)(b * 2) * 1024 + c + 4); } }
            }
#pragma unroll
            for (int hh = 0; hh < 2; ++hh) {
                const int c = hh * 512 + lane * 8;
                f32x4 v0a, v0b, ba, bb; unpack8(cv[hh], v0a, v0b); unpack8(cb[hh], ba, bb);
                const f32x4 ga = ba * (wc_[hh][0] * p2[hh][0] + wc_[hh][2] * p1[hh][0] + wc_[hh][4] * v0a), gb = bb * (wc_[hh][1] * p2[hh][1] + wc_[hh][3] * p1[hh][1] + wc_[hh][5] * v0b);
                *(u32x4*)(R1 + (size_t)r * 1024 + c) = pack8(ga, gb);
                if (t >= T - 2) { float* o = oconv + (size_t)(b * 2 + (t - (T - 2))) * 1024 + c; *(f32x4*)o = v0a; *(f32x4*)(o + 4) = v0b; }
                p2[hh][0] = p1[hh][0]; p2[hh][1] = p1[hh][1]; p1[hh][0] = v0a; p1[hh][1] = v0b;
            }
            f32x4 qa, qb; unpack8(ccq, qa, qb);
            float s1 = (qa[0] * qa[0] + qa[1] * qa[1]) + (qa[2] * qa[2] + qa[3] * qa[3]) + (qb[0] * qb[0] + qb[1] * qb[1]) + (qb[2] * qb[2] + qb[3] * qb[3]);
            f32x4 ka = (f32x4){bf_lo(cck.x), bf_hi(cck.x), bf_lo(cck.y), bf_hi(cck.y)};
            float s2 = (ka[0] * ka[0] + ka[1] * ka[1]) + (ka[2] * ka[2] + ka[3] * ka[3]);
#pragma unroll
            for (int o = 1; o < 64; o <<= 1) { s1 += shx(s1, o); s2 += shx(s2, o); }
            if (lane == 0) rq[r] = 1.0f / sqrtf(s1 * (1.0f / 512.0f) + EPS);
            { const float rs = 1.0f / sqrtf(s2 * (1.0f / 256.0f) + EPS); ka = ka * rs * gkv;
              *(f32x4*)(ockv + (size_t)rr * 256 + lane * 4) = ka; *(u32x2*)(ckvb + (size_t)kvrow * 256 + lane * 4) = (u32x2){cvt_pk_bf16(ka[0], ka[1]), cvt_pk_bf16(ka[2], ka[3])}; }
            { const int i = lane & 31; const float xv = __builtin_bit_cast(float, (unsigned)ckr << 16);
              const float pv = shx(xv, 16); const f32x2 cs = tab[pos * 16 + (i & 15)];
              const float o = (i < 16) ? xv * cs.x - pv * cs.y : xv * cs.x + pv * cs.y;
              if (lane < 32) { okr[(size_t)rr * 32 + i] = o; krb[(size_t)kvrow * 32 + i] = (bf16_t)f2bf(o); } }
#pragma unroll
            for (int hh = 0; hh < 2; ++hh) { cv[hh] = nv[hh]; cb[hh] = nb[hh]; }
            ccq = ncq; cck = nck; ckr = nkr;
        }
#undef P2_LOAD
    }
    SEAM(2);

    if (IN(3)) {
        { pg8::Dense P{R1, Wco_t, 1024, 1024, 1024}; pg8::StaticOrder S; S.init(MP, 1024, G, bx);
          pg8::EpiGate E{R6}; pg8::gemm_phase(lds + RING_OFF, P, S, E);
          { pg8::Piece pc; if (pg8::piece_of(1024, 1024, G, bx, 4, 0, pc)) pg8::gemm_piece(lds + RING_OFF, P, E, pc, pg8::SplitCtx{slabs, ctl + 4096 + 64, MISC + 16}); } }
        { pg8::Dense P{cqb, Wuq_t, 512, 512, 512}; pg8::StaticOrder S; S.init(MP, QW, G, bx);
          pg8::EpiQ E{rq, tab, qbuf}; pg8::gemm_phase(lds + RING_OFF, P, S, E);
          { pg8::Piece pc; if (pg8::piece_of(QW, 512, G, bx, 2, 128, pc)) pg8::gemm_piece(lds + RING_OFF, P, E, pc, pg8::SplitCtx{slabs + (size_t)32 * 65536, ctl + 4096 + 128, MISC + 16}); } }
        { pg8::Dense P{ckvb, Wukv_t, 256, 256, 256}; pg8::StaticOrder S; S.init(KVROWS, KVW, G, (bx + 64) % G);
          pg8::EpiPlain E{R2, KVW}; pg8::gemm_phase(lds + RING_OFF, P, S, E); }
    }
    SEAM(3);

    if (IN(5)) attn::phase(vcu, G, qbuf, R2, krb, R1, lds + RING_OFF);
    SEAM(5);

    if (IN(6)) {
        pg8::Dense P{R1, Wmo_t, 1024, 1024, 1024}; pg8::StaticOrder S; S.init(MP, 1024, G, bx);
        pg8::EpiMix E{R6, R7}; pg8::gemm_phase(lds + RING_OFF, P, S, E);
          { pg8::Piece pc; if (pg8::piece_of(1024, 1024, G, bx, 4, 0, pc)) pg8::gemm_piece(lds + RING_OFF, P, E, pc, pg8::SplitCtx{slabs, ctl + 4096 + 192, MISC + 16}); }
        { pg8::ProbWp Pw{memk, Wqm_g, 256, 1024, 1024}; pg8::PreOrder So{G - 32, (int)bx - 32}; pg8::EpiPlain Ew{Wp, 1024}; pg8::gemm_phase(lds + RING_OFF, Pw, So, Ew); }
    }
    SEAM(6);

    if (IN(7)) {
        pg8::Dense P{R7, Wmx_t, 1024, 1024, 1024}; pg8::StaticOrder S; S.init(MP, 1024, G, bx);
        pg8::EpiRes E{x_prompt, x_sample, out + OUT_Y, R1, st1}; pg8::gemm_phase(lds + RING_OFF, P, S, E);
          { pg8::Piece pc; if (pg8::piece_of(1024, 1024, G, bx, 4, 0, pc)) pg8::gemm_piece(lds + RING_OFF, P, E, pc, pg8::SplitCtx{slabs, ctl + 4096 + 256, MISC + 16}); }
        { pg8::ProbVp Pv{Wom_t, memv, 256, 1024, 1024}; pg8::PreOrder So{G - 32, (int)bx - 32}; pg8::EpiPlain Ev{Vp, 1024}; pg8::gemm_phase(lds + RING_OFF, Pv, So, Ev); }
    }
    SEAM(7);

    if (IN(8)) {
        pg8::ProbMA P{R1, Wp, 1024, 1024, 1024}; pg8::StaticOrder S; S.init(MP, 1024, G, bx);
        LAS float* rt8 = (LAS float*)(lds + MISC_OFF + 512); LAS int* pmt8 = (LAS int*)(lds + MISC_OFF + 256);
        { TID_LANE (void)lane;
          if (tid == 0) { int n = 0;
              for (int i = 0; ; ++i) { const int pmi = S.pm_of(i); if (pmi < 0) break; bool seen = false; for (int k = 0; k < n; ++k) seen = seen || (pmt8[k] == pmi); if (!seen && n < 7) pmt8[n++] = pmi; }
              pmt8[8] = n; for (int k = n; k < 8; ++k) pmt8[k] = -1; }
          __syncthreads();
          const int n_ = pmt8[8];
          for (int idx = tid; idx < n_ * 256; idx += NWAVES * 64) rt8[idx] = pg8::row_rstd(st1, pmt8[idx >> 8] * 256 + (idx & 255));
          __syncthreads(); }
        pg8::EpiSoftmaxS E{st1, MSCALE, R3, (LAS float*)(lds + SCR_OFF), (unsigned)(size_t)rt8, (unsigned)(size_t)pmt8}; pg8::gemm_phase(lds + RING_OFF, P, S, E);
          { pg8::Piece pc; if (pg8::piece_of_mem(G, bx, 4, 0, pc)) pg8::gemm_piece(lds + RING_OFF, P, E, pc, pg8::SplitCtx{slabs, ctl + 4096 + 320, MISC + 16}); }
    }
    SEAM(8);

    if (IN(9)) {
        pg8::ProbMA P{R3, Vp, 1024, 1024, 1024}; pg8::StaticOrder S; S.init(MP, 1024, G, bx);
        pg8::EpiResM E{out + OUT_Y, R1, st2}; pg8::gemm_phase(lds + RING_OFF, P, S, E);
          { pg8::Piece pc; if (pg8::piece_of_mem(G, bx, 4, 0, pc)) pg8::gemm_piece(lds + RING_OFF, P, E, pc, pg8::SplitCtx{slabs, ctl + 4096 + 384, MISC + 16}); }
    }
    SEAM(9);

    if (IN(12)) {
        pg8::Dense P{R1, Wup_t, 1024, 1024, 1024}; pg8::StaticOrder S; S.init(MP, DFF, G, bx);
        LAS float* rt = (LAS float*)(lds + SCR_OFF); LAS int* pmt = (LAS int*)(lds + MISC_OFF + 128);
        { TID_LANE
          if (tid == 0) { int n = 0;
              for (int i = 0; ; ++i) { const int pmi = S.pm_of(i); if (pmi < 0) break; bool seen = false; for (int k = 0; k < n; ++k) seen = seen || (pmt[k] == pmi); if (!seen && n < 8) pmt[n++] = pmi; }
              pmt[8] = n; for (int k = n; k < 8; ++k) pmt[k] = -1; }
          __syncthreads();
          const int n = pmt[8];
          for (int idx = tid; idx < n * 256; idx += NWAVES * 64) rt[idx] = pg8::row_rstd(st2, pmt[idx >> 8] * 256 + (idx & 255));
          __syncthreads(); (void)lane; }
        pg8::EpiNormAct<1> E{st2, R2, DFF, 1.0f, (unsigned)(size_t)rt, (unsigned)(size_t)pmt}; pg8::gemm_phase(lds + RING_OFF, P, S, E);
          { pg8::Piece pc; if (pg8::piece_of(DFF, 1024, G, bx, 4, 0, pc)) pg8::gemm_piece(lds + RING_OFF, P, E, pc, pg8::SplitCtx{slabs, ctl + 4096 + 448, MISC + 16}); }
    }
    SEAM(12);

    if (IN(13)) {
        pg8::Dense P{R2, Wdn_t, DFF, DFF, DFF}; pg8::StaticOrder S; S.init(MP, 1024, G, bx);
        if (G == 256) {
            pg8::EpiResFinal E{out + OUT_Y, out + OUT_Y + (size_t)MP * 1024, out + OUT_Y, st3, ctl + 8192, g_final}; pg8::gemm_phase(lds + RING_OFF, P, S, E);
            { pg8::Piece pc; if (pg8::piece_of(1024, DFF, G, bx, 8, 0, pc)) pg8::gemm_piece(lds + RING_OFF, P, E, pc, pg8::SplitCtx{slabs, ctl + 4096 + 512, MISC + 16}); }
        } else {
            pg8::EpiRes E{out + OUT_Y, out + OUT_Y + (size_t)MP * 1024, out + OUT_Y, nullptr, st3}; pg8::gemm_phase(lds + RING_OFF, P, S, E);
            { pg8::Piece pc; if (pg8::piece_of(1024, DFF, G, bx, 8, 0, pc)) pg8::gemm_piece(lds + RING_OFF, P, E, pc, pg8::SplitCtx{slabs, ctl + 4096 + 512, MISC + 16}); }
        }
    }
    if (G != 256) SEAM(13);

    if (IN(14) && G != 256) { TID_LANE
        for (int r = gw; r < MT; r += NGW) {
            const float rs = pg8::row_rstd(st3, r); float* p = out + OUT_Y + (size_t)r * 1024;
#pragma unroll
            for (int j = 0; j < 4; ++j) { const int c = 256 * j + 4 * lane; *(f32x4*)(p + c) = *(const f32x4*)(p + c) * rs * *(const f32x4*)(g_final + c); }
        }
    }
#undef IN
#undef SEAM
#undef x_prompt
#undef x_sample
#undef cache_conv
#undef cache_ckv
#undef cache_krope
#undef cache_mem_k
#undef cache_mem_v
#undef mem_prompt
#undef g_mix
#undef w_in
#undef w_conv
#undef w_conv_out
#undef g_q
#undef w_uq
#undef g_kv
#undef w_ukv
#undef w_mla_out
#undef w_mix_out
#undef g_mem_q
#undef g_mem_kv
#undef w_qm
#undef w_km
#undef w_vm
#undef w_om
#undef g_mlp
#undef w_up
#undef w_down
#undef g_final
#undef KIN
}

#ifndef MK_PER_PHASE
#define MK_PER_PHASE 0
#endif
constexpr int NPHASE = 15;
extern "C" void kernel_launch(void* const* d_in, const int* in_sizes, int n_in, void* d_out, int out_size, void* d_ws, size_t ws_size, hipStream_t stream) {
    static int grid = 0;
    if (grid == 0) {
        if (n_in != 28 || (size_t)out_size != OUT_TOTAL || ws_size < WS_END) { fprintf(stderr, "kernel_launch: unexpected problem (n_in %d, out %d, ws %zu)\n", n_in, out_size, ws_size); grid = -1; return; }
        int dev = 0, cus = 0, per_cu = 0;
        if (hipGetDevice(&dev) != hipSuccess || hipDeviceGetAttribute(&cus, hipDeviceAttributeMultiprocessorCount, dev) != hipSuccess) { grid = -1; return; }
        if (hipFuncSetAttribute((const void*)fwd_kernel, hipFuncAttributeMaxDynamicSharedMemorySize, LDS_BYTES) != hipSuccess) { fprintf(stderr, "kernel_launch: hipFuncSetAttribute failed\n"); grid = -1; return; }
        if (hipOccupancyMaxActiveBlocksPerMultiprocessor(&per_cu, (const void*)fwd_kernel, NWAVES * 64, LDS_BYTES) != hipSuccess || per_cu < 1) { fprintf(stderr, "kernel_launch: occupancy query says %d\n", per_cu); per_cu = 1; }
        (void)hipGetLastError();
        grid = cus;
    }
    if (grid < 0) return;
    (void)hipMemsetAsync((char*)d_ws + WS_CTL, 0, CTL_ZERO_BYTES, stream);
    Args a{};
    for (int i = 0; i < 28; ++i) a.in[i] = (const float*)d_in[i];
    a.out = (float*)d_out; a.ws = (unsigned char*)d_ws;
#if MK_PER_PHASE
    for (int p = 0; p < NPHASE; ++p) { a.ph_lo = p; a.ph_hi = p + 1; hipLaunchKernelGGL(fwd_kernel, dim3(grid), dim3(NWAVES * 64), LDS_BYTES, stream, a); }
#else
    a.ph_lo = 0; a.ph_hi = NPHASE;
    hipLaunchKernelGGL(fwd_kernel, dim3(grid), dim3(NWAVES * 64), LDS_BYTES, stream, a);
#endif
}
```

```cpp
#include <hip/hip_runtime.h>
#include <cstdio>
#include <cstdint>

#define LAS __attribute__((address_space(3)))
#define GAS __attribute__((address_space(1)))
typedef unsigned short bf16_t;
typedef short bf16x8 __attribute__((ext_vector_type(8)));
typedef short s16x4 __attribute__((ext_vector_type(4)));
typedef float f32x4 __attribute__((ext_vector_type(4)));
typedef float f32x2 __attribute__((ext_vector_type(2)));
typedef float f32x16 __attribute__((ext_vector_type(16)));
typedef unsigned u32x4 __attribute__((ext_vector_type(4)));
typedef unsigned u32x2 __attribute__((ext_vector_type(2)));

constexpr int DM = 1024, NB = 8, SEQ = 4096, DSEQ = 64, PAST = 1024;
constexpr int MP = NB * SEQ;
constexpr int MS = NB * DSEQ;
constexpr int MT = MP + MS;
constexpr int KVS = PAST + DSEQ;
constexpr int KVROWS = MP + NB * KVS;
constexpr int NIN = 5920, NINP = 6144, NIN1 = 5888;
constexpr int QW = 1536, KVW = 2048, DFF = 4096, NMEM = 256;
constexpr float EPS = 1e-6f;
constexpr float LOG2E = 1.4426950408889634f;
constexpr float QSCALE = 0.10206207261596577f * LOG2E;
constexpr float MSCALE = 0.0625f * LOG2E;

typedef __bf16 bf16x2_t __attribute__((ext_vector_type(2)));
__device__ __forceinline__ unsigned cvt_pk_bf16(float lo, float hi) { f32x2 v = {lo, hi}; bf16x2_t b = __builtin_convertvector(v, bf16x2_t); return __builtin_bit_cast(unsigned, b); }
__device__ __forceinline__ float bf_lo(unsigned w) { return __builtin_bit_cast(float, w << 16); }
__device__ __forceinline__ float bf_hi(unsigned w) { return __builtin_bit_cast(float, w & 0xffff0000u); }
__device__ __forceinline__ u32x4 pack8(f32x4 a, f32x4 b) { u32x4 w; w.x = cvt_pk_bf16(a[0], a[1]); w.y = cvt_pk_bf16(a[2], a[3]); w.z = cvt_pk_bf16(b[0], b[1]); w.w = cvt_pk_bf16(b[2], b[3]); return w; }
__device__ __forceinline__ void unpack8(u32x4 w, f32x4& a, f32x4& b) { a = (f32x4){bf_lo(w.x), bf_hi(w.x), bf_lo(w.y), bf_hi(w.y)}; b = (f32x4){bf_lo(w.z), bf_hi(w.z), bf_lo(w.w), bf_hi(w.w)}; }
__device__ __forceinline__ float fast_sigmoid(float x) { return __builtin_amdgcn_rcpf(1.0f + __builtin_amdgcn_exp2f(-x * LOG2E)); }
__device__ __forceinline__ float shx(float v, int m) { int z = 0; asm volatile("" : "+v"(z)); const int l = __builtin_amdgcn_mbcnt_hi(~0u, __builtin_amdgcn_mbcnt_lo(~0u, z));
    return __builtin_bit_cast(float, __builtin_amdgcn_ds_bpermute((l ^ m) << 2, __builtin_bit_cast(int, v))); }
__device__ __forceinline__ float wave_sum(float v) {
#pragma unroll
    for (int o = 1; o < 64; o <<= 1) v += shx(v, o);
    return v;
}

namespace pg8 {
constexpr int BM = 256, BK = 64, HALF = 128, HTB = HALF * BK * 2  , STAGE_BYTES = 8 * HTB, NXCD = 8, WGM = 4;
static_assert(WGM * 4 <= 32, "EpiResFinal: a row panel's four owners must share a round");
__host__ __device__ __forceinline__ int lds_byte(int r, int c) { const int st = (r >> 4) * 2 + (c >> 5), rr = r & 15, cc = c & 31, ob = rr * 64 + cc * 2; return st * 1024 + (ob ^ (((ob >> 9) & 1) << 5)); }
__host__ __device__ __forceinline__ void stage_rc(int b, int& R, int& C) { const int st = b / 1024, sb = b % 1024, swz = sb ^ (((sb >> 9) & 1) << 5); R = (st >> 1) * 16 + swz / 64; C = (st & 1) * 32 + (swz % 64) / 2; }
__host__ __device__ __forceinline__ int perm32(int rho) { const int n = rho >> 4, i = rho & 15; return 8 * (i >> 2) + 4 * n + (i & 3); }

struct Unit { int pm, pn; };
struct Dense {
    const bf16_t* A; const bf16_t* Bt; int K, lda, ldb;
    __device__ __forceinline__ const char* aptr(const Unit& u) const { return (const char*)(A + (size_t)u.pm * 256 * lda); }
    __device__ __forceinline__ const char* bptr(const Unit& u) const { return (const char*)(Bt + (size_t)u.pn * 256 * ldb); }
};
struct StaticOrder {
    int nM, nN, nwg, G, c;
    __host__ __device__ void init(int M, int N, int G_, int c_) { nM = M / BM; nN = N / BM; nwg = nM * nN; G = G_; c = c_; }
    __host__ __device__ bool next(int i, Unit& u) const {
        const long L = (long)i * G + c; if (L >= nwg) return false;
        int wgid = (int)L; { const int q = nwg / NXCD, r = nwg % NXCD, xcd = wgid % NXCD, off = wgid / NXCD; wgid = (xcd < r ? xcd * (q + 1) : r * (q + 1) + (xcd - r) * q) + off; }
        const int nig = WGM * nN, gid = wgid / nig, fm = gid * WGM, gsz = (nM - fm) < WGM ? (nM - fm) : WGM;
        u.pm = fm + ((wgid % nig) % gsz); u.pn = (wgid % nig) / gsz; return true;
    }
    __host__ __device__ __forceinline__ int pm_of(int i) const {
        const long L = (long)i * G + c; if (L >= nwg) return -1;
        int wgid = (int)L; { const int q = nwg / NXCD, r = nwg % NXCD, xcd = wgid % NXCD, off = wgid / NXCD; wgid = (xcd < r ? xcd * (q + 1) : r * (q + 1) + (xcd - r) * q) + off; }
        const int nig = WGM * nN, gid = wgid / nig, fm = gid * WGM, gsz = (nM - fm) < WGM ? (nM - fm) : WGM;
        return fm + ((wgid % nig) % gsz);
    }
};

typedef f32x4 Acc[2][2][4][2];

template <class Prob, class Epi, class Sched>
__device__ __forceinline__ void gemm_phase(LAS unsigned char* lds, const Prob& P, const Sched& S, const Epi& E) {
    const int tid = threadIdx.x, wid = __builtin_amdgcn_readfirstlane(tid >> 6), lane = tid & 63, wr = wid >> 2, wc = wid & 3, fr = lane & 15, fq = lane >> 4;
    const int nt = P.K / BK;
    unsigned voffA[2], voffB[2];
#pragma unroll
    for (int i = 0; i < 2; ++i) { int R, C; stage_rc(tid * 16 + i * 8192, R, C); const int Rb = (R & ~31) + perm32(R & 31);
        voffA[i] = (unsigned)(R * P.lda + C) * 2u; voffB[i] = (unsigned)(Rb * P.ldb + C) * 2u; }
    const size_t kstep = (size_t)(BK * 2);
    const size_t hstepA = (size_t)HALF * P.lda * 2, hstepB = (size_t)HALF * P.ldb * 2;
    const unsigned ldsw = (unsigned)wid * 1024u;
    const int aoff = lds_byte(wr * 64 + fr, fq * 8), boff = lds_byte(wc * 32 + fr, fq * 8);
#define PG8_SA(b, h) (((b) * 2 + (h)) * HTB)
#define PG8_SB(b, h) ((4 + (b) * 2 + (h)) * HTB)
#define PG8_STAGE(bufoff, gbase, voff) do { _Pragma("unroll") for (int _i = 0; _i < 2; ++_i) \
        __builtin_amdgcn_global_load_lds((const unsigned*)((const char*)(gbase) + (voff)[_i]), (LAS unsigned*)(lds + (bufoff) + ldsw + _i * 8192), 16, 0, 0); } while (0)
#define PG8_LDA(dst, b, h) do { _Pragma("unroll") for (int m = 0; m < 4; ++m) _Pragma("unroll") for (int k = 0; k < 2; ++k) dst[m][k] = *(const LAS bf16x8*)(lds + PG8_SA(b, h) + aoff + m * 2048 + k * 1024); } while (0)
#define PG8_LDB(dst, b, h) do { _Pragma("unroll") for (int n = 0; n < 2; ++n) _Pragma("unroll") for (int k = 0; k < 2; ++k) dst[n][k] = *(const LAS bf16x8*)(lds + PG8_SB(b, h) + boff + n * 2048 + k * 1024); } while (0)
#define PG8_MMA(ai, bj, At, Bt) do { __builtin_amdgcn_s_setprio(1); _Pragma("unroll") for (int m = 0; m < 4; ++m) _Pragma("unroll") for (int n = 0; n < 2; ++n) _Pragma("unroll") for (int k = 0; k < 2; ++k) \
        acc[ai][bj][m][n] = __builtin_amdgcn_mfma_f32_16x16x32_bf16(Bt[n][k], At[m][k], acc[ai][bj][m][n], 0, 0, 0); __builtin_amdgcn_s_setprio(0); } while (0)
#define PG8_WAIT_V(n) asm volatile("s_waitcnt vmcnt(" #n ")" ::: "memory")
#define PG8_WAIT_VR(rel) do { int r_ = __builtin_amdgcn_readfirstlane(rel); asm volatile("" : "+s"(r_)); asm volatile("s_cmp_lg_u32 %0, 0\n\ts_cbranch_scc1 .Lrxa%=\n\ts_waitcnt vmcnt(8)\n\ts_branch .Lrxb%=\n.Lrxa%=:\n\ts_waitcnt vmcnt(24)\n.Lrxb%=:" :: "s"(r_) : "scc", "memory"); } while (0)
#define PG8_WAIT_L(n) asm volatile("s_waitcnt lgkmcnt(" #n ")" ::: "memory")
#define PG8_BAR __builtin_amdgcn_s_barrier()
#define PG8_SCHED __builtin_amdgcn_sched_barrier(0)
    Unit cur, nxt; int ui = 0;
    if (!S.next(0, cur)) return;
    Acc acc;
#pragma unroll
    for (int a = 0; a < 2; ++a)
#pragma unroll
        for (int b = 0; b < 2; ++b)
#pragma unroll
            for (int m = 0; m < 4; ++m)
#pragma unroll
                for (int n = 0; n < 2; ++n) acc[a][b][m][n] = (f32x4){0.f, 0.f, 0.f, 0.f};
    bf16x8 At[4][2], B0[2][2], B1[2][2];
    const char* cA = P.aptr(cur); const char* cB = P.bptr(cur);
    PG8_STAGE(PG8_SB(0, 0), cB, voffB); PG8_STAGE(PG8_SB(0, 1), cB + hstepB, voffB); PG8_STAGE(PG8_SA(0, 0), cA, voffA); PG8_STAGE(PG8_SA(0, 1), cA + hstepA, voffA);
    if (wr == 1) PG8_BAR;
    PG8_WAIT_V(2); PG8_BAR;
    PG8_STAGE(PG8_SB(1, 0), cB + kstep, voffB); PG8_STAGE(PG8_SA(1, 0), cA + kstep, voffA); PG8_STAGE(PG8_SB(1, 1), cB + hstepB + kstep, voffB);
    PG8_WAIT_V(6); PG8_BAR;
    for (;;) {
        const bool has_next = S.next(ui + 1, nxt);
        const char* nA = has_next ? P.aptr(nxt) : cA; const char* nB = has_next ? P.bptr(nxt) : cB;
        for (int t = 0; t < nt; t += 2) {
            const bool last = (t == nt - 2);
            const char* a1 = cA + (size_t)(t + 1) * kstep;
            const char* a2 = last ? nA : cA + (size_t)(t + 2) * kstep; const char* b2 = last ? nB : cB + (size_t)(t + 2) * kstep;
            const char* a3 = a2 + kstep; const char* b3 = b2 + kstep;
            PG8_LDB(B0, 0, 0); PG8_LDB(B1, 0, 1); PG8_SCHED; PG8_LDA(At, 0, 0); PG8_STAGE(PG8_SA(1, 1), a1 + hstepA, voffA);
            PG8_WAIT_VR((Epi::RELAX && t == 0 && ui > 0) ? 1 : 0); PG8_WAIT_L(0); PG8_BAR; PG8_MMA(0, 0, At, B0); PG8_MMA(0, 1, At, B1); PG8_BAR; PG8_SCHED;
            PG8_LDA(At, 0, 1); PG8_STAGE(PG8_SB(0, 0), b2, voffB); PG8_STAGE(PG8_SB(0, 1), b2 + hstepB, voffB); PG8_STAGE(PG8_SA(0, 0), a2, voffA);
            PG8_WAIT_VR((Epi::RELAX && t == 0 && ui > 0) ? 1 : 0); PG8_WAIT_L(0); PG8_BAR; PG8_MMA(1, 0, At, B0); PG8_MMA(1, 1, At, B1); PG8_BAR; PG8_SCHED;
            PG8_LDB(B0, 1, 0); PG8_LDB(B1, 1, 1); PG8_SCHED; PG8_LDA(At, 1, 0); PG8_STAGE(PG8_SA(0, 1), a2 + hstepA, voffA);
            PG8_WAIT_V(8); PG8_WAIT_L(0); PG8_BAR; PG8_MMA(0, 0, At, B0); PG8_MMA(0, 1, At, B1); PG8_BAR; PG8_SCHED;
            PG8_LDA(At, 1, 1); PG8_STAGE(PG8_SB(1, 0), b3, voffB); PG8_STAGE(PG8_SB(1, 1), b3 + hstepB, voffB); PG8_STAGE(PG8_SA(1, 0), a3, voffA);
            PG8_WAIT_V(8); PG8_WAIT_L(0); PG8_BAR; PG8_MMA(1, 0, At, B0); PG8_MMA(1, 1, At, B1); PG8_BAR; PG8_SCHED;
        }
        if (wr == 0) PG8_BAR;
        E(acc, cur, wr, wc, fr, fq);
        if (!has_next) break;
#pragma unroll
        for (int a = 0; a < 2; ++a)
#pragma unroll
            for (int b = 0; b < 2; ++b)
#pragma unroll
                for (int m = 0; m < 4; ++m)
#pragma unroll
                    for (int n = 0; n < 2; ++n) acc[a][b][m][n] = (f32x4){0.f, 0.f, 0.f, 0.f};
        cur = nxt; cA = nA; cB = nB; ++ui;
        if (wr == 1) PG8_BAR;
    }
    PG8_WAIT_V(0);
    PG8_BAR;
#undef PG8_SA
#undef PG8_SB
#undef PG8_STAGE
#undef PG8_LDA
#undef PG8_LDB
#undef PG8_MMA
#undef PG8_WAIT_V
#undef PG8_WAIT_VR
#undef PG8_WAIT_L
#undef PG8_BAR
#undef PG8_SCHED
}

struct SplitCtx { float* slabs; unsigned* cnt; volatile LAS unsigned* flag; };
struct Piece { int pm, pn, k0, nk, split, slot, uid, rm; };
__device__ __forceinline__ bool piece_of(int N, int K, int G, int c, int split, int coff, Piece& p) {
    const int nN = N / BM, j = (c + coff) % G, un = j / split; p.slot = j % split; p.uid = un; p.pm = 128 + un / nN; p.pn = un % nN; p.nk = K / BK / split; p.k0 = p.slot * p.nk; p.split = split; p.rm = 0;
    return j < 2 * nN * split;
}
__device__ __forceinline__ bool piece_of_mem(int G, int c, int split, int coff, Piece& p) {
    const int j = (c + coff) % G, un = j / split; p.slot = j % split; p.uid = un; p.pm = 128 + (un >> 2); p.pn = un & 3; p.nk = 16 / split; p.k0 = p.slot * p.nk; p.split = split;
    p.rm = split == 4 ? (1 << p.slot) : 0;
    return j < 32 * split;
}
template <class Prob, class Epi>
__device__ __forceinline__ void gemm_piece(LAS unsigned char* lds, const Prob& P, const Epi& E, const Piece pc, const SplitCtx X) {
    int tid_ = threadIdx.x; asm volatile("" : "+v"(tid_));
    const int tid = tid_, wid = __builtin_amdgcn_readfirstlane(tid >> 6), lane = tid & 63, wr = wid >> 2, wc = wid & 3, fr = lane & 15, fq = lane >> 4;
    unsigned voffA[2], voffB[2];
#pragma unroll
    for (int i = 0; i < 2; ++i) { int R, C; stage_rc(tid * 16 + i * 8192, R, C); const int Rb = (R & ~31) + perm32(R & 31);
        voffA[i] = (unsigned)(R * P.lda + C) * 2u; voffB[i] = (unsigned)(Rb * P.ldb + C) * 2u; }
    const size_t kstep = (size_t)(BK * 2);
    const size_t hstepA = (size_t)HALF * P.lda * 2, hstepB = (size_t)HALF * P.ldb * 2;
    const unsigned ldsw = (unsigned)wid * 1024u;
    const int aoff = lds_byte(wr * 64 + fr, fq * 8), boff = lds_byte(wc * 32 + fr, fq * 8);
#define PG8_SA(b, h) (((b) * 2 + (h)) * HTB)
#define PG8_SB(b, h) ((4 + (b) * 2 + (h)) * HTB)
#define PG8_STAGE(bufoff, gbase, voff) do { _Pragma("unroll") for (int _i = 0; _i < 2; ++_i) \
        __builtin_amdgcn_global_load_lds((const unsigned*)((const char*)(gbase) + (voff)[_i]), (LAS unsigned*)(lds + (bufoff) + ldsw + _i * 8192), 16, 0, 0); } while (0)
#define PG8_LDA(dst, b, h) do { _Pragma("unroll") for (int m = 0; m < 4; ++m) _Pragma("unroll") for (int k = 0; k < 2; ++k) dst[m][k] = *(const LAS bf16x8*)(lds + PG8_SA(b, h) + aoff + m * 2048 + k * 1024); } while (0)
#define PG8_LDB(dst, b, h) do { _Pragma("unroll") for (int n = 0; n < 2; ++n) _Pragma("unroll") for (int k = 0; k < 2; ++k) dst[n][k] = *(const LAS bf16x8*)(lds + PG8_SB(b, h) + boff + n * 2048 + k * 1024); } while (0)
#define PG8_MMA(ai, bj, At, Bt) do { __builtin_amdgcn_s_setprio(1); _Pragma("unroll") for (int m = 0; m < 4; ++m) _Pragma("unroll") for (int n = 0; n < 2; ++n) _Pragma("unroll") for (int k = 0; k < 2; ++k) \
        acc[ai][bj][m][n] = __builtin_amdgcn_mfma_f32_16x16x32_bf16(Bt[n][k], At[m][k], acc[ai][bj][m][n], 0, 0, 0); __builtin_amdgcn_s_setprio(0); } while (0)
#define PG8_WAIT_V(n) asm volatile("s_waitcnt vmcnt(" #n ")" ::: "memory")
#define PG8_WAIT_L(n) asm volatile("s_waitcnt lgkmcnt(" #n ")" ::: "memory")
#define PG8_BAR __builtin_amdgcn_s_barrier()
#define PG8_SCHED __builtin_amdgcn_sched_barrier(0)
    Unit cur; cur.pm = pc.pm; cur.pn = pc.pn;
    Acc acc;
#pragma unroll
    for (int a = 0; a < 2; ++a)
#pragma unroll
        for (int b = 0; b < 2; ++b)
#pragma unroll
            for (int m = 0; m < 4; ++m)
#pragma unroll
                for (int n = 0; n < 2; ++n) acc[a][b][m][n] = (f32x4){0.f, 0.f, 0.f, 0.f};
    {
    bf16x8 At[4][2], B0[2][2], B1[2][2];
    const char* cA = P.aptr(cur) + (size_t)pc.k0 * kstep; const char* cB = P.bptr(cur) + (size_t)pc.k0 * kstep;
    PG8_STAGE(PG8_SB(0, 0), cB, voffB); PG8_STAGE(PG8_SB(0, 1), cB + hstepB, voffB); PG8_STAGE(PG8_SA(0, 0), cA, voffA); PG8_STAGE(PG8_SA(0, 1), cA + hstepA, voffA);
    if (wr == 1) PG8_BAR;
    PG8_WAIT_V(2); PG8_BAR;
    PG8_STAGE(PG8_SB(1, 0), cB + kstep, voffB); PG8_STAGE(PG8_SA(1, 0), cA + kstep, voffA); PG8_STAGE(PG8_SB(1, 1), cB + hstepB + kstep, voffB);
    PG8_WAIT_V(6); PG8_BAR;
    const int nt = pc.nk;
    for (int t = 0; t < nt; t += 2) {
        const bool last = (t == nt - 2);
        const char* a1 = cA + (size_t)(t + 1) * kstep;
        const char* a2 = last ? cA : cA + (size_t)(t + 2) * kstep; const char* b2 = last ? cB : cB + (size_t)(t + 2) * kstep;
        const char* a3 = a2 + kstep; const char* b3 = b2 + kstep;
        PG8_LDB(B0, 0, 0); PG8_LDB(B1, 0, 1); PG8_SCHED; PG8_LDA(At, 0, 0); PG8_STAGE(PG8_SA(1, 1), a1 + hstepA, voffA);
        PG8_WAIT_V(8); PG8_WAIT_L(0); PG8_BAR; PG8_MMA(0, 0, At, B0); PG8_MMA(0, 1, At, B1); PG8_BAR; PG8_SCHED;
        PG8_LDA(At, 0, 1); PG8_STAGE(PG8_SB(0, 0), b2, voffB); PG8_STAGE(PG8_SB(0, 1), b2 + hstepB, voffB); PG8_STAGE(PG8_SA(0, 0), a2, voffA);
        PG8_WAIT_V(8); PG8_WAIT_L(0); PG8_BAR; PG8_MMA(1, 0, At, B0); PG8_MMA(1, 1, At, B1); PG8_BAR; PG8_SCHED;
        PG8_LDB(B0, 1, 0); PG8_LDB(B1, 1, 1); PG8_SCHED; PG8_LDA(At, 1, 0); PG8_STAGE(PG8_SA(0, 1), a2 + hstepA, voffA);
        PG8_WAIT_V(8); PG8_WAIT_L(0); PG8_BAR; PG8_MMA(0, 0, At, B0); PG8_MMA(0, 1, At, B1); PG8_BAR; PG8_SCHED;
        PG8_LDA(At, 1, 1); PG8_STAGE(PG8_SB(1, 0), b3, voffB); PG8_STAGE(PG8_SB(1, 1), b3 + hstepB, voffB); PG8_STAGE(PG8_SA(1, 0), a3, voffA);
        PG8_WAIT_V(8); PG8_WAIT_L(0); PG8_BAR; PG8_MMA(1, 0, At, B0); PG8_MMA(1, 1, At, B1); PG8_BAR; PG8_SCHED;
    }
    if (wr == 0) PG8_BAR;
    }
    float* ubase = X.slabs + (size_t)pc.uid * pc.split * 65536;
    const __amdgpu_buffer_rsrc_t rs = __builtin_amdgcn_make_buffer_rsrc((void*)ubase, (short)0, pc.split * 262144, 0x00020000);
    { const int so = pc.slot * 262144;
#pragma unroll
      for (int a = 0; a < 2; ++a)
#pragma unroll
          for (int b = 0; b < 2; ++b)
#pragma unroll
              for (int m = 0; m < 4; ++m)
#pragma unroll
                  for (int n = 0; n < 2; ++n) __builtin_amdgcn_raw_buffer_store_b128(__builtin_bit_cast(u32x4, acc[a][b][m][n]), rs, tid * 16, so + ((((a * 2 + b) * 4 + m) * 2 + n) * 8192), 16); }
    asm volatile("s_waitcnt vmcnt(0)" ::: "memory"); __syncthreads();
    if (tid == 0) { (void)__hip_atomic_fetch_add(X.cnt + pc.uid, 1u, __ATOMIC_RELAXED, __HIP_MEMORY_SCOPE_AGENT);
        unsigned sp = 0u; while (__hip_atomic_load(X.cnt + pc.uid, __ATOMIC_RELAXED, __HIP_MEMORY_SCOPE_AGENT) < (unsigned)pc.split) { __builtin_amdgcn_s_sleep(2); if (++sp > (1u << 22)) break; } }
    __syncthreads();
    const int gsz = 8 / pc.split, g0 = pc.slot * gsz;
    const unsigned rowmask = pc.rm ? (unsigned)pc.rm : ((1u << gsz) - 1u) << g0;
#pragma unroll
    for (int a = 0; a < 2; ++a)
#pragma unroll
        for (int b = 0; b < 2; ++b)
#pragma unroll
            for (int m = 0; m < 4; ++m)
#pragma unroll
                for (int n = 0; n < 2; ++n) acc[a][b][m][n] = (f32x4){0.f, 0.f, 0.f, 0.f};
    int nsp = pc.split; asm volatile("" : "+s"(nsp));
    for (int s = 0; s < nsp; ++s) {
#pragma unroll
        for (int a = 0; a < 2; ++a)
#pragma unroll
            for (int m = 0; m < 4; ++m)
                if ((rowmask >> (a * 4 + m)) & 1u) {
#pragma unroll
                    for (int b = 0; b < 2; ++b)
#pragma unroll
                        for (int n = 0; n < 2; ++n) acc[a][b][m][n] += __builtin_bit_cast(f32x4, __builtin_amdgcn_raw_buffer_load_b128(rs, tid * 16, s * 262144 + ((((a * 2 + b) * 4 + m) * 2 + n) * 8192), 16));
                }
    }
    E(acc, cur, wr, wc, fr, fq, rowmask);
    return;
    E(acc, cur, wr, wc, fr, fq);
#undef PG8_SA
#undef PG8_SB
#undef PG8_STAGE
#undef PG8_LDA
#undef PG8_LDB
#undef PG8_MMA
#undef PG8_WAIT_V
#undef PG8_WAIT_L
#undef PG8_BAR
#undef PG8_SCHED
}
}

constexpr size_t MiB = 1u << 20;
constexpr size_t UB = (size_t)MT * 1024 * 2;
constexpr size_t WS_CTL = 0, CTL_ZERO_BYTES = 64 * 1024;
constexpr size_t WS_TAB = 1 * MiB;
constexpr size_t WS_RSTD0 = 2 * MiB;
constexpr size_t WS_RQ = WS_RSTD0 + 256 * 1024;
constexpr size_t WS_RSTDM = WS_RQ + 256 * 1024;
constexpr size_t WS_ST1 = 3 * MiB;
constexpr size_t WS_ST2 = WS_ST1 + 2304 * 1024;
constexpr size_t WS_ST3 = WS_ST2 + 2304 * 1024;
constexpr size_t WS_W = 12 * MiB;
constexpr size_t WS_WIN = WS_W;
constexpr size_t WS_WCO = WS_WIN + (size_t)NINP * 1024 * 2;
constexpr size_t WS_WUQ = WS_WCO + 2 * MiB;
constexpr size_t WS_WUKV = WS_WUQ + (size_t)QW * 512 * 2;
constexpr size_t WS_WMO = WS_WUKV + (size_t)KVW * 256 * 2;
constexpr size_t WS_WMX = WS_WMO + 2 * MiB;
constexpr size_t WS_WQM = WS_WMX + 2 * MiB;
constexpr size_t WS_WKV = WS_WQM + 2 * MiB;
constexpr size_t WS_WOM = WS_WKV + 4 * MiB;
constexpr size_t WS_WUP = WS_WOM + 2 * MiB;
constexpr size_t WS_WDN = WS_WUP + 8 * MiB;
constexpr size_t WS_WEND = WS_WDN + 8 * MiB;
constexpr size_t WS_MB = 57 * MiB;
constexpr size_t WS_MEMK = 61 * MiB;
constexpr size_t WS_MEMV = 69 * MiB;
constexpr size_t WS_CKVB = 77 * MiB;
constexpr size_t WS_KRB = 98 * MiB;
constexpr size_t WS_R1 = 101 * MiB;
constexpr size_t WS_R2 = WS_R1 + UB;
constexpr size_t WS_R3 = WS_R2 + UB;
constexpr size_t WS_R4 = WS_R3 + UB;
constexpr size_t WS_R5 = WS_R4 + UB / 2;
constexpr size_t WS_R6 = WS_R5 + UB / 4;
constexpr size_t WS_R7 = WS_R6 + UB;
constexpr size_t WS_R8 = WS_R7 + UB;
constexpr size_t WS_END = WS_R8 + (size_t)MT * 32 * 2;
constexpr size_t WS_WP = WS_R2, WS_VP = WS_R2 + 32 * MiB;
static_assert(64 * MiB <= UB, "Wp | Vp fit R2");
constexpr size_t WS_SLAB = 477 * MiB;
static_assert(WS_WEND <= WS_MB && WS_END <= WS_SLAB && WS_SLAB + 32 * MiB <= 512 * MiB, "d_ws map");
static_assert(WS_R2 + (size_t)KVROWS * KVW * 2 <= WS_R5, "kv overlays v | g | cq");
static_assert(WS_R2 + 4 * UB <= 512 * MiB, "hmid");

constexpr size_t OUT_Y = 0;
constexpr size_t OUT_CONVP = (size_t)MT * 1024;
constexpr size_t OUT_CKVP = OUT_CONVP + 16384;
constexpr size_t OUT_KRP = OUT_CKVP + (size_t)MP * 256;
constexpr size_t OUT_MEMK = OUT_KRP + (size_t)MP * 32;
constexpr size_t OUT_MEMV = OUT_MEMK + 2097152;
constexpr size_t OUT_CONVS = OUT_MEMV + 2097152;
constexpr size_t OUT_CKVS = OUT_CONVS + 16384;
constexpr size_t OUT_KRS = OUT_CKVS + (size_t)MS * 256;
constexpr size_t OUT_TOTAL = OUT_KRS + (size_t)MS * 32;

constexpr int RING_OFF = 0, RING_BYTES = 131072;
constexpr int SCR_OFF = RING_BYTES;
constexpr int LDSCTL_OFF = SCR_OFF + 8192, MISC_OFF = LDSCTL_OFF + 320;
constexpr int LDS_BYTES = 147456;
constexpr int NWAVES = 8;

#define XB_TMO      128
#define XB_XCNT(j)  (256  + 64 * (j))
#define XB_XSUB(j)  (1280 + 64 * (j))
#define XB_XGEN(j)  (2304 + 64 * (j))
#define XB_TOP      3328
#define XB_TOPGEN   3392
#define XCD_BAR_WORDS 3456
#define XB_SPIN_CAP (1u << 20)
__device__ __forceinline__ unsigned xb_ld(unsigned* p)              { return __hip_atomic_load(p, __ATOMIC_RELAXED, __HIP_MEMORY_SCOPE_AGENT); }
__device__ __forceinline__ unsigned xb_add(unsigned* p, unsigned v) { return __hip_atomic_fetch_add(p, v, __ATOMIC_RELAXED, __HIP_MEMORY_SCOPE_AGENT); }
__device__ __forceinline__ unsigned xb_xcc_id() { return (unsigned)__builtin_amdgcn_s_getreg((3 << 11) | 20) & 0xFu; }
#define XB_SPIN(cond, bar) do { unsigned _sp = 0; while (cond) { __builtin_amdgcn_s_sleep(1); \
    if ((++_sp & 255u) == 0u) { if (xb_ld(&(bar)[XB_TMO])) break; if (_sp > XB_SPIN_CAP) { atomicAdd(&(bar)[XB_TMO], 1u); break; } } } } while (0)
struct XcdBarrier { unsigned* bar; unsigned x; volatile LAS unsigned* st; };
__device__ __forceinline__ XcdBarrier xcd_barrier_post(unsigned* bar, volatile LAS unsigned* st) {
    XcdBarrier b; b.bar = bar; b.x = xb_xcc_id(); b.st = st;
    if (threadIdx.x == 0) (void)xb_add(&bar[XB_XCNT(b.x)], 1u);
    return b;
}
__device__ __forceinline__ void xcd_barrier_complete(unsigned* bar, unsigned x, unsigned& nloc, unsigned& nx) {
    const unsigned G = gridDim.x * gridDim.y * gridDim.z;
    unsigned sum, cnt, mine, sp = 0u;
    for (;;) {
        sum = 0u; cnt = 0u; mine = 0u;
#pragma unroll
        for (unsigned j = 0; j < 16; ++j) { const unsigned c = xb_ld(&bar[XB_XCNT(j)]); sum += c; cnt += (c > 0u) ? 1u : 0u; mine = (j == x) ? c : mine; }
        if (sum == G) break;
        __builtin_amdgcn_s_sleep(1);
        if ((++sp & 255u) == 0u) { if (xb_ld(&bar[XB_TMO])) break; if (sp > XB_SPIN_CAP) { atomicAdd(&bar[XB_TMO], 1u); break; } }
    }
    nloc = mine > 0u ? mine : 1u; nx = cnt > 0u ? cnt : 1u;
}
__device__ __forceinline__ void xcd_barrier(const XcdBarrier& b) {
    asm volatile("s_waitcnt vmcnt(0)" ::: "memory");
    __syncthreads();
    if (threadIdx.x == 0) {
        unsigned* bar = b.bar;
        __builtin_amdgcn_s_waitcnt(0);
        unsigned nloc = b.st[0], nx = b.st[1];
        if (nloc == 0u) { xcd_barrier_complete(bar, b.x, nloc, nx); b.st[0] = nloc; b.st[1] = nx; }
        const unsigned old = xb_add(&bar[XB_XSUB(b.x)], 1u);
        const unsigned gen = old / nloc;
        if (old + 1u == (gen + 1u) * nloc) {
            __builtin_amdgcn_fence(__ATOMIC_RELEASE, "agent");
            asm volatile("s_waitcnt vmcnt(0)" ::: "memory");
            const unsigned og = xb_add(&bar[XB_TOP], 1u);
            const unsigned tg = og / nx;
            if (og + 1u == (tg + 1u) * nx) xb_add(&bar[XB_TOPGEN], 1u);
            else XB_SPIN(xb_ld(&bar[XB_TOPGEN]) == tg, bar);
            __builtin_amdgcn_fence(__ATOMIC_ACQUIRE, "agent");
            xb_add(&bar[XB_XGEN(b.x)], 1u);
            asm volatile("s_waitcnt vmcnt(0)" ::: "memory");
        } else {
            XB_SPIN(xb_ld(&bar[XB_XGEN(b.x)]) == gen, bar);
            __builtin_amdgcn_fence(__ATOMIC_ACQUIRE, "agent");
            asm volatile("s_waitcnt vmcnt(0)" ::: "memory");
        }
    }
    __syncthreads();
}

namespace pg8 {
#define EPI_ROWS(ai, m) (u.pm * 256 + (ai) * 128 + wr * 64 + (m) * 16 + fr)
#define FOR_AI_M _Pragma("unroll") for (int ai = 0; ai < 2; ++ai) _Pragma("unroll") for (int m = 0; m < 4; ++m) if ((rowmask >> (ai * 4 + m)) & 1u)

struct EpiIn {
    const float* rstd0; bf16_t *v, *Bg, *cq, *ckvraw, *sigc, *siga;
    static constexpr bool RELAX = false;
    static __device__ __forceinline__ void plain(const Acc& acc, bf16_t* dst, int ld, int ai, int m, float rs) {
#pragma unroll
        for (int bj = 0; bj < 2; ++bj) *(u32x4*)(dst + bj * 128) = pack8(acc[ai][bj][m][0] * rs, acc[ai][bj][m][1] * rs);
    }
    static __device__ __forceinline__ void sigm(const Acc& acc, bf16_t* dst, int ai, int m, float rs) {
#pragma unroll
        for (int bj = 0; bj < 2; ++bj) { f32x4 a = acc[ai][bj][m][0] * rs, b = acc[ai][bj][m][1] * rs;
#pragma unroll
            for (int e = 0; e < 4; ++e) { a[e] = fast_sigmoid(a[e]); b[e] = fast_sigmoid(b[e]); }
            *(u32x4*)(dst + bj * 128) = pack8(a, b); }
    }
    __device__ __forceinline__ void operator()(Acc& acc, const Unit& u, int wr, int wc, int fr, int fq, unsigned rowmask = 0xffu) const {
        const int pn = u.pn, cw = wc * 32 + 8 * fq;
        FOR_AI_M {
            const int r = EPI_ROWS(ai, m); const float rs = rstd0[r];
            if (pn < 8) {
                const float rs2 = rs * rs;
                *(u32x4*)(v + (size_t)r * 1024 + pn * 128 + cw) = pack8(acc[ai][0][m][0] * acc[ai][1][m][0] * rs2, acc[ai][0][m][1] * acc[ai][1][m][1] * rs2);
            } else if (pn < 12) { plain(acc, Bg + (size_t)r * 1024 + (pn - 8) * 256 + cw, 1024, ai, m, rs);
            } else if (pn < 14) { plain(acc, cq + (size_t)r * 512 + (pn - 12) * 256 + cw, 512, ai, m, rs);
            } else if (pn < 15) { plain(acc, ckvraw + (size_t)r * 256 + cw, 256, ai, m, rs);
            } else if (pn < 19) { sigm(acc, sigc + (size_t)r * 1024 + (pn - 15) * 256 + cw, ai, m, rs);
            } else { sigm(acc, siga + (size_t)r * 1024 + (pn - 19) * 256 + cw, ai, m, rs); }
        }
    }
};
struct EpiMemKV {
    const float* rstdm; float *outk, *outv; bf16_t *memk, *memv;
    static constexpr bool RELAX = true;
    __device__ __forceinline__ void operator()(Acc& acc, const Unit& u, int wr, int wc, int fr, int fq, unsigned rowmask = 0xffu) const {
        const bool isk = u.pn < 4; const int c0 = (u.pn & 3) * 256 + wc * 32 + 8 * fq; float* out = isk ? outk : outv; bf16_t* cp = isk ? memk : memv;
        FOR_AI_M {
            const int r = EPI_ROWS(ai, m); const float rs = rstdm[r];
#pragma unroll
            for (int bj = 0; bj < 2; ++bj) { const f32x4 a = acc[ai][bj][m][0] * rs, b = acc[ai][bj][m][1] * rs; const size_t off = (size_t)r * 1024 + c0 + bj * 128;
                *(f32x4*)(out + off) = a; *(f32x4*)(out + off + 4) = b; *(u32x4*)(cp + off) = pack8(a, b); }
        }
    }
};
struct EpiGate {
    bf16_t* buf;
    static constexpr bool RELAX = true;
    __device__ __forceinline__ void operator()(Acc& acc, const Unit& u, int wr, int wc, int fr, int fq, unsigned rowmask = 0xffu) const {
        const int c0 = u.pn * 256 + wc * 32 + 8 * fq;
        FOR_AI_M { const int r = EPI_ROWS(ai, m);
#pragma unroll
            for (int bj = 0; bj < 2; ++bj) { bf16_t* p = buf + (size_t)r * 1024 + c0 + bj * 128; f32x4 a, b; unpack8(*(const u32x4*)p, a, b);
                *(u32x4*)p = pack8(a * acc[ai][bj][m][0], b * acc[ai][bj][m][1]); } }
    }
};
struct EpiMix {
    const bf16_t* ya; bf16_t* buf;
    static constexpr bool RELAX = true;
    __device__ __forceinline__ void operator()(Acc& acc, const Unit& u, int wr, int wc, int fr, int fq, unsigned rowmask = 0xffu) const {
        const int c0 = u.pn * 256 + wc * 32 + 8 * fq;
        FOR_AI_M { const int r = EPI_ROWS(ai, m);
#pragma unroll
            for (int bj = 0; bj < 2; ++bj) { const size_t off = (size_t)r * 1024 + c0 + bj * 128; f32x4 a, b, ya0, ya1; unpack8(*(const u32x4*)(buf + off), a, b); unpack8(*(const u32x4*)(ya + off), ya0, ya1);
                *(u32x4*)(buf + off) = pack8(ya0 + a * acc[ai][bj][m][0], ya1 + b * acc[ai][bj][m][1]); } }
    }
};
struct EpiQ {
    const float* rq; const f32x2* tab; bf16_t* q;
    static constexpr bool RELAX = true;
    __device__ __forceinline__ void operator()(Acc& acc, const Unit& u, int wr, int wc, int fr, int fq, unsigned rowmask = 0xffu) const {
        FOR_AI_M {
            const int r = EPI_ROWS(ai, m); const float rs = rq[r];
            const int pos = r < MP ? (r & (SEQ - 1)) : PAST + ((r - MP) & (DSEQ - 1));
#pragma unroll
            for (int bj = 0; bj < 2; ++bj) {
                const int g = u.pn * 8 + bj * 4 + wc;
                f32x4 a = acc[ai][bj][m][0] * rs, b = acc[ai][bj][m][1] * rs;
                if (g % 3 == 2) {
                    const f32x2* t = tab + pos * 16 + 8 * (fq & 1);
                    const float sgn = fq < 2 ? -1.f : 1.f;
#pragma unroll
                    for (int e = 0; e < 4; ++e) { const f32x2 cs0 = t[e], cs1 = t[4 + e];
                        const float pa = shx(a[e], 32), pb = shx(b[e], 32);
                        a[e] = a[e] * cs0.x + sgn * pa * cs0.y; b[e] = b[e] * cs1.x + sgn * pb * cs1.y; }
                }
                *(u32x4*)(q + (size_t)r * QW + g * 32 + 8 * fq) = pack8(a * QSCALE, b * QSCALE);
            }
        }
    }
};
struct EpiPlain {
    bf16_t* out; int ld;
    static constexpr bool RELAX = true;
    __device__ __forceinline__ void operator()(Acc& acc, const Unit& u, int wr, int wc, int fr, int fq, unsigned rowmask = 0xffu) const {
        const int c0 = u.pn * 256 + wc * 32 + 8 * fq;
        FOR_AI_M { const int r = EPI_ROWS(ai, m);
#pragma unroll
            for (int bj = 0; bj < 2; ++bj) *(u32x4*)(out + (size_t)r * ld + c0 + bj * 128) = pack8(acc[ai][bj][m][0], acc[ai][bj][m][1]); }
    }
};
struct EpiRes {
    const float* xold_p; const float* xold_s; float* xout; bf16_t* xb; float* stats;
    static constexpr bool RELAX = true;
    __device__ __forceinline__ void operator()(Acc& acc, const Unit& u, int wr, int wc, int fr, int fq, unsigned rowmask = 0xffu) const {
        const int c0 = u.pn * 256 + wc * 32 + 8 * fq;
        FOR_AI_M { const int r = EPI_ROWS(ai, m); const float* xo = r < MP ? xold_p + (size_t)r * 1024 : xold_s + (size_t)(r - MP) * 1024; float ss = 0.f;
#pragma unroll
            for (int bj = 0; bj < 2; ++bj) { const int c = c0 + bj * 128; const f32x4 a = *(const f32x4*)(xo + c) + acc[ai][bj][m][0], b = *(const f32x4*)(xo + c + 4) + acc[ai][bj][m][1];
                *(f32x4*)(xout + (size_t)r * 1024 + c) = a; *(f32x4*)(xout + (size_t)r * 1024 + c + 4) = b;
                if (xb) *(u32x4*)(xb + (size_t)r * 1024 + c) = pack8(a, b);
                ss += (a[0] * a[0] + a[1] * a[1]) + (a[2] * a[2] + a[3] * a[3]) + (b[0] * b[0] + b[1] * b[1]) + (b[2] * b[2] + b[3] * b[3]); }
            ss += shx(ss, 16); ss += shx(ss, 32);
            if (fq == 0) stats[(size_t)r * 16 + u.pn * 4 + wc] = ss; }
    }
};
struct EpiResFinal {
    const float* xold_p; const float* xold_s; float* out; float* stats; unsigned* cnt; const float* gfin;
    static constexpr bool RELAX = false;
    __device__ __forceinline__ void operator()(Acc& acc, const Unit& u, int wr, int wc, int fr, int fq, unsigned rowmask = 0xffu) const {
        const int c0 = u.pn * 256 + wc * 32 + 8 * fq;
        FOR_AI_M { const int r = EPI_ROWS(ai, m); const float* xo = r < MP ? xold_p + (size_t)r * 1024 : xold_s + (size_t)(r - MP) * 1024; float ss = 0.f;
#pragma unroll
            for (int bj = 0; bj < 2; ++bj) { const int c = c0 + bj * 128; const f32x4 a = *(const f32x4*)(xo + c) + acc[ai][bj][m][0], b = *(const f32x4*)(xo + c + 4) + acc[ai][bj][m][1];
                acc[ai][bj][m][0] = a; acc[ai][bj][m][1] = b;
                ss += (a[0] * a[0] + a[1] * a[1]) + (a[2] * a[2] + a[3] * a[3]) + (b[0] * b[0] + b[1] * b[1]) + (b[2] * b[2] + b[3] * b[3]); }
            ss += shx(ss, 16); ss += shx(ss, 32);
            if (fq == 0) __hip_atomic_store(stats + (size_t)r * 16 + u.pn * 4 + wc, ss, __ATOMIC_RELAXED, __HIP_MEMORY_SCOPE_AGENT); }
        asm volatile("s_waitcnt vmcnt(0)" ::: "memory"); __builtin_amdgcn_s_barrier(); asm volatile("" ::: "memory");
        if (threadIdx.x == 0) { unsigned* cw = cnt + u.pm * 8 + __builtin_ctz(rowmask);
            (void)__hip_atomic_fetch_add(cw, 1u, __ATOMIC_RELAXED, __HIP_MEMORY_SCOPE_AGENT);
            unsigned sp = 0u; while (__hip_atomic_load(cw, __ATOMIC_RELAXED, __HIP_MEMORY_SCOPE_AGENT) < 4u) { __builtin_amdgcn_s_sleep(2); if (++sp > (1u << 22)) break; } }
        asm volatile("s_waitcnt vmcnt(0)" ::: "memory"); __builtin_amdgcn_s_barrier(); asm volatile("" ::: "memory");
        const __amdgpu_buffer_rsrc_t rs = __builtin_amdgcn_make_buffer_rsrc((void*)stats, (short)0, MT * 64, 0x00020000);
        FOR_AI_M { const int r = EPI_ROWS(ai, m);
            const f32x4 s0 = __builtin_bit_cast(f32x4, __builtin_amdgcn_raw_buffer_load_b128(rs, r * 64, 0, 16)), s1 = __builtin_bit_cast(f32x4, __builtin_amdgcn_raw_buffer_load_b128(rs, r * 64 + 16, 0, 16)),
                        s2 = __builtin_bit_cast(f32x4, __builtin_amdgcn_raw_buffer_load_b128(rs, r * 64 + 32, 0, 16)), s3 = __builtin_bit_cast(f32x4, __builtin_amdgcn_raw_buffer_load_b128(rs, r * 64 + 48, 0, 16));
            const float t = ((s0[0] + s0[1]) + (s0[2] + s0[3])) + ((s1[0] + s1[1]) + (s1[2] + s1[3])) + ((s2[0] + s2[1]) + (s2[2] + s2[3])) + ((s3[0] + s3[1]) + (s3[2] + s3[3]));
            const float rsd = __builtin_amdgcn_rsqf(t * (1.0f / 1024.0f) + EPS);
#pragma unroll
            for (int bj = 0; bj < 2; ++bj) { const int c = c0 + bj * 128; const f32x4 g0 = *(const f32x4*)(gfin + c), g1 = *(const f32x4*)(gfin + c + 4);
                *(f32x4*)(out + (size_t)r * 1024 + c) = acc[ai][bj][m][0] * rsd * g0; *(f32x4*)(out + (size_t)r * 1024 + c + 4) = acc[ai][bj][m][1] * rsd * g1; } }
    }
};
__device__ __forceinline__ float row_rstd(const float* stats, int r) {
    const f32x4* s = (const f32x4*)(stats + (size_t)r * 16); const f32x4 a = s[0], b = s[1], c = s[2], d = s[3];
    const float t = ((a[0] + a[1]) + (a[2] + a[3])) + ((b[0] + b[1]) + (b[2] + b[3])) + ((c[0] + c[1]) + (c[2] + c[3])) + ((d[0] + d[1]) + (d[2] + d[3]));
    return __builtin_amdgcn_rsqf(t * (1.0f / 1024.0f) + EPS);
}
template <int ACT> struct EpiNormAct {
    const float* stats; bf16_t* out; int ld; float scale; unsigned rt, pmt;
    static constexpr bool RELAX = true;
    __device__ __forceinline__ void operator()(Acc& acc, const Unit& u, int wr, int wc, int fr, int fq, unsigned rowmask = 0xffu) const {
        const int c0 = u.pn * 256 + wc * 32 + 8 * fq;
        int slot = -1;
#pragma unroll
        for (int k = 0; k < 8; ++k) slot = (*reinterpret_cast<const LAS int*>(pmt + 4 * k) == u.pm) ? k : slot;
        slot = __builtin_amdgcn_readfirstlane(slot);
        if (slot >= 0) {
            const LAS float* rp = reinterpret_cast<const LAS float*>(rt + (unsigned)(slot * 256 + wr * 64 + fr) * 4u);
            FOR_AI_M { const int r = EPI_ROWS(ai, m); const float rs = rp[ai * 128 + m * 16] * scale;
#pragma unroll
                for (int bj = 0; bj < 2; ++bj) { f32x4 a = acc[ai][bj][m][0] * rs, b = acc[ai][bj][m][1] * rs;
                    if (ACT == 1) {
#pragma unroll
                        for (int e = 0; e < 4; ++e) { const float x = fmaxf(a[e], 0.f), y = fmaxf(b[e], 0.f); a[e] = x * x; b[e] = y * y; } }
                    *(u32x4*)(out + (size_t)r * ld + c0 + bj * 128) = pack8(a, b); } }
        } else {
            FOR_AI_M { const int r = EPI_ROWS(ai, m); const float rs = row_rstd(stats, r) * scale;
#pragma unroll
                for (int bj = 0; bj < 2; ++bj) { f32x4 a = acc[ai][bj][m][0] * rs, b = acc[ai][bj][m][1] * rs;
                    if (ACT == 1) {
#pragma unroll
                        for (int e = 0; e < 4; ++e) { const float x = fmaxf(a[e], 0.f), y = fmaxf(b[e], 0.f); a[e] = x * x; b[e] = y * y; } }
                    *(u32x4*)(out + (size_t)r * ld + c0 + bj * 128) = pack8(a, b); } }
        }
    }
};

__device__ __forceinline__ int ma_row0(int pm) { return pm < 128 ? pm * 256 : MP + (pm - 128) * DSEQ; }
__device__ __forceinline__ int ma_batch(int pm) { return pm < 128 ? pm >> 4 : 8 + (pm - 128); }
struct ProbMA {
    const bf16_t* A; const bf16_t* W; int K, lda, ldb;
    __device__ __forceinline__ const char* aptr(const Unit& u) const { return (const char*)(A + (size_t)ma_row0(u.pm) * 1024); }
    __device__ __forceinline__ const char* bptr(const Unit& u) const { return (const char*)(W + ((size_t)ma_batch(u.pm) * 1024 + u.pn * 256) * 1024); }
};
struct PreOrder {
    int G, c;
    __device__ __forceinline__ bool next(int i, Unit& u) const { const int L = i * G + c; u.pm = L >> 2; u.pn = L & 3; return c >= 0 && L < 256; }
};
struct ProbWp {
    const bf16_t* memk; const bf16_t* wqg; int K, lda, ldb;
    __device__ __forceinline__ const char* aptr(const Unit& u) const { return (const char*)(memk + (size_t)((u.pm >> 2) * 256) * 1024 + (u.pm & 3) * 256); }
    __device__ __forceinline__ const char* bptr(const Unit& u) const { return (const char*)(wqg + (size_t)(u.pn * 256) * 1024 + (u.pm & 3) * 256); }
};
struct ProbVp {
    const bf16_t* womt; const bf16_t* memv; int K, lda, ldb;
    __device__ __forceinline__ const char* aptr(const Unit& u) const { return (const char*)(womt + (size_t)((u.pm & 3) * 256) * 1024 + u.pn * 256); }
    __device__ __forceinline__ const char* bptr(const Unit& u) const { return (const char*)(memv + (size_t)((u.pm >> 2) * 256) * 1024 + u.pn * 256); }
};
struct EpiSoftmaxS {
    const float* stats; float scale; bf16_t* P; LAS float* scr; unsigned rt, pmt;
    static constexpr bool RELAX = false;
    __device__ __forceinline__ void operator()(Acc& acc, const Unit& u, int wr, int wc, int fr, int fq, unsigned rowmask = 0xffu) const {
        const int row0 = ma_row0(u.pm), valid = u.pm < 128 ? 256 : DSEQ;
        int slot = -1;
#pragma unroll
        for (int k = 0; k < 8; ++k) slot = (*reinterpret_cast<const LAS int*>(pmt + 4 * k) == u.pm) ? k : slot;
        slot = __builtin_amdgcn_readfirstlane(slot);
        const LAS float* rp = reinterpret_cast<const LAS float*>(rt + (unsigned)((slot < 0 ? 0 : slot) * 256) * 4u);
        FOR_AI_M { const int lr = ai * 128 + wr * 64 + m * 16 + fr; const int rr = row0 + lr < MT ? row0 + lr : MT - 1; const float rs = (slot >= 0 ? rp[lr] : row_rstd(stats, rr)) * scale; float mx = -3.0e38f;
#pragma unroll
            for (int bj = 0; bj < 2; ++bj)
#pragma unroll
                for (int n = 0; n < 2; ++n) { acc[ai][bj][m][n] = acc[ai][bj][m][n] * rs;
#pragma unroll
                    for (int e = 0; e < 4; ++e) mx = fmaxf(mx, acc[ai][bj][m][n][e]); }
            mx = fmaxf(mx, shx(mx, 16)); mx = fmaxf(mx, shx(mx, 32));
            if (fq == 0) scr[lr * 4 + wc] = mx; }
        asm volatile("s_waitcnt lgkmcnt(0)" ::: "memory"); __builtin_amdgcn_s_barrier(); asm volatile("" ::: "memory");
        FOR_AI_M { const int lr = ai * 128 + wr * 64 + m * 16 + fr; const f32x4 q = *(const LAS f32x4*)(scr + lr * 4); const float mx = fmaxf(fmaxf(q[0], q[1]), fmaxf(q[2], q[3])); float sm = 0.f;
#pragma unroll
            for (int bj = 0; bj < 2; ++bj)
#pragma unroll
                for (int n = 0; n < 2; ++n)
#pragma unroll
                    for (int e = 0; e < 4; ++e) { const float p = __builtin_amdgcn_exp2f(acc[ai][bj][m][n][e] - mx); acc[ai][bj][m][n][e] = p; sm += p; }
            sm += shx(sm, 16); sm += shx(sm, 32);
            if (fq == 0) scr[1024 + lr * 4 + wc] = sm; }
        asm volatile("s_waitcnt lgkmcnt(0)" ::: "memory"); __builtin_amdgcn_s_barrier(); asm volatile("" ::: "memory");
        FOR_AI_M { const int lr = ai * 128 + wr * 64 + m * 16 + fr; const f32x4 q = *(const LAS f32x4*)(scr + 1024 + lr * 4); const float inv = __builtin_amdgcn_rcpf((q[0] + q[1]) + (q[2] + q[3]));
            if (lr < valid) {
#pragma unroll
                for (int bj = 0; bj < 2; ++bj) *(u32x4*)(P + (size_t)(row0 + lr) * 1024 + u.pn * 256 + bj * 128 + wc * 32 + 8 * fq) = pack8(acc[ai][bj][m][0] * inv, acc[ai][bj][m][1] * inv); } }
    }
};
struct EpiResM {
    float* x; bf16_t* xb; float* stats;
    static constexpr bool RELAX = false;
    __device__ __forceinline__ void operator()(Acc& acc, const Unit& u, int wr, int wc, int fr, int fq, unsigned rowmask = 0xffu) const {
        const int row0 = ma_row0(u.pm), valid = u.pm < 128 ? 256 : DSEQ; const int c0 = u.pn * 256 + wc * 32 + 8 * fq;
        FOR_AI_M { const int lr = ai * 128 + wr * 64 + m * 16 + fr; const bool ok = lr < valid; const int r = ok ? row0 + lr : row0; float* xr = x + (size_t)r * 1024; float ss = 0.f;
#pragma unroll
            for (int bj = 0; bj < 2; ++bj) { const int c = c0 + bj * 128; const f32x4 a = *(const f32x4*)(xr + c) + acc[ai][bj][m][0], b = *(const f32x4*)(xr + c + 4) + acc[ai][bj][m][1];
                if (ok) { *(f32x4*)(xr + c) = a; *(f32x4*)(xr + c + 4) = b; *(u32x4*)(xb + (size_t)r * 1024 + c) = pack8(a, b); }
                ss += (a[0] * a[0] + a[1] * a[1]) + (a[2] * a[2] + a[3] * a[3]) + (b[0] * b[0] + b[1] * b[1]) + (b[2] * b[2] + b[3] * b[3]); }
            ss += shx(ss, 16); ss += shx(ss, 32);
            if (fq == 0 && ok) stats[(size_t)r * 16 + u.pn * 4 + wc] = ss; }
    }
};
#undef EPI_ROWS
#undef FOR_AI_M
}

namespace attn {
constexpr int NSLOT = 4, NOPE_B = 0, ROPE_B = NSLOT * 8192, V_B = ROPE_B + NSLOT * 4096;
constexpr int QR_OFF = V_B + NSLOT * 8192;
__device__ __forceinline__ void glds16(const void* sbase, unsigned voff, unsigned lds_dst) { unsigned keep;
    asm volatile("s_mov_b32 %0, m0\n\ts_mov_b32 m0, %3\n\ts_nop 0\n\tglobal_load_lds_dwordx4 %1, %2\n\ts_mov_b32 m0, %0" : "=&s"(keep) : "v"(voff), "s"(sbase), "s"(lds_dst) : "memory"); }
__device__ __forceinline__ s16x4 vtr(const LAS unsigned char* p) { return __builtin_bit_cast(s16x4, __builtin_amdgcn_ds_read_tr16_b64_v4i16((LAS s16x4*)p)); }
struct Unit { int qrow0, kvrow0, h, ntiles, lim_base, lim_step, nwq; };

__device__ __forceinline__ float row_max32(const f32x16& p0, const f32x16& p1) {
    float a = fmaxf(fmaxf(p0[0], p0[1]), p1[0]), b = fmaxf(fmaxf(p0[2], p0[3]), p1[1]); a = fmaxf(fmaxf(a, p1[2]), p1[3]);
#pragma unroll
    for (int r = 4; r < 16; r += 4) { a = fmaxf(fmaxf(a, p0[r]), p0[r + 1]); b = fmaxf(fmaxf(b, p0[r + 2]), p0[r + 3]); a = fmaxf(fmaxf(a, p1[r]), p1[r + 1]); b = fmaxf(fmaxf(b, p1[r + 2]), p1[r + 3]); }
    const float m = fmaxf(a, b);
    auto rr = __builtin_amdgcn_permlane32_swap(__float_as_uint(m), __float_as_uint(m), false, false);
    return fmaxf(__uint_as_float(rr[0]), __uint_as_float(rr[1]));
}
__device__ __forceinline__ void kfrag(bf16x8& a0, bf16x8& a1, int d0, const unsigned (&ka)[6], int ko) {
    if (d0 < 4) { a0 = *reinterpret_cast<const LAS bf16x8*>(ka[d0] + ko); a1 = *reinterpret_cast<const LAS bf16x8*>(ka[d0] + ko + 32 * 128); }
    else { a0 = *reinterpret_cast<const LAS bf16x8*>(ka[d0] + (ko >> 1)); a1 = *reinterpret_cast<const LAS bf16x8*>(ka[d0] + (ko >> 1) + 32 * 64); }
}
struct NoDma { __device__ __forceinline__ void operator()() const {} };
template <bool DO_QK, class Dma = NoDma>
__device__ __forceinline__ void step(f32x16& pn0, f32x16& pn1, f32x16& pc0, f32x16& pc1, f32x16& o0, f32x16& o1, float& lrun, const bf16x8 qmf, const bf16x8 kneg,
                                     const unsigned (&ka)[6], int ko, const LAS unsigned char* vb, const bf16x8 (&qf)[4], const LAS unsigned char* qr, const Dma& dma = Dma()) {
    bf16x8 fa[2][2];
    if (DO_QK) kfrag(fa[0][0], fa[0][1], 0, ka, ko);
    __builtin_amdgcn_s_setprio(1);
#pragma unroll
    for (int d0 = 0; d0 < 6; ++d0) {
        if (DO_QK) {
            if (d0 + 1 < 6) kfrag(fa[(d0 + 1) & 1][0], fa[(d0 + 1) & 1][1], d0 + 1, ka, ko);
            const bf16x8 qd = d0 < 4 ? qf[d0 < 4 ? d0 : 0] : *(const LAS bf16x8*)(qr + (d0 - 4) * 16);
            if (d0 == 0) { const f32x16 z = {}; pn0 = __builtin_amdgcn_mfma_f32_32x32x16_bf16(fa[0][0], qd, z, 0, 0, 0); pn1 = __builtin_amdgcn_mfma_f32_32x32x16_bf16(fa[0][1], qd, z, 0, 0, 0); }
            else { pn0 = __builtin_amdgcn_mfma_f32_32x32x16_bf16(fa[d0 & 1][0], qd, pn0, 0, 0, 0); pn1 = __builtin_amdgcn_mfma_f32_32x32x16_bf16(fa[d0 & 1][1], qd, pn1, 0, 0, 0); }
        }
        if (d0 == 1) dma();
#pragma unroll
        for (int r = (16 * d0) / 6; r < (16 * (d0 + 1)) / 6; ++r) { pc0[r] = __builtin_amdgcn_exp2f(pc0[r]); pc1[r] = __builtin_amdgcn_exp2f(pc1[r]); }
        asm volatile("" ::: "memory");
    }
    if (DO_QK) {
        pn0 = __builtin_amdgcn_mfma_f32_32x32x16_bf16(kneg, qmf, pn0, 0, 0, 0); pn1 = __builtin_amdgcn_mfma_f32_32x32x16_bf16(kneg, qmf, pn1, 0, 0, 0); }
    { float one = 1.0f; asm volatile("" : "+s"(one));
      float sa = pc0[0], sb = pc1[0];
#pragma unroll
      for (int r = 1; r < 16; ++r) { sa = sa + pc0[r]; sb = __builtin_fmaf(pc1[r], one, sb); }
      lrun += sa + sb; }
    u32x4 pw[4];
    pw[0] = (u32x4){cvt_pk_bf16(pc0[0], pc0[1]), cvt_pk_bf16(pc0[2], pc0[3]), cvt_pk_bf16(pc0[4], pc0[5]), cvt_pk_bf16(pc0[6], pc0[7])};
    pw[1] = (u32x4){cvt_pk_bf16(pc0[8], pc0[9]), cvt_pk_bf16(pc0[10], pc0[11]), cvt_pk_bf16(pc0[12], pc0[13]), cvt_pk_bf16(pc0[14], pc0[15])};
    pw[2] = (u32x4){cvt_pk_bf16(pc1[0], pc1[1]), cvt_pk_bf16(pc1[2], pc1[3]), cvt_pk_bf16(pc1[4], pc1[5]), cvt_pk_bf16(pc1[6], pc1[7])};
    pw[3] = (u32x4){cvt_pk_bf16(pc1[8], pc1[9]), cvt_pk_bf16(pc1[10], pc1[11]), cvt_pk_bf16(pc1[12], pc1[13]), cvt_pk_bf16(pc1[14], pc1[15])};
    s16x4 vl[2][4];
    vl[0][0] = vtr(vb); vl[0][1] = vtr(vb + 512); vl[0][2] = vtr(vb + 4096); vl[0][3] = vtr(vb + 4096 + 512);
#pragma unroll
    for (int ks = 0; ks < 4; ++ks) {
        if (ks + 1 < 4) { const int n = (ks + 1) & 1; vl[n][0] = vtr(vb + (ks + 1) * 1024); vl[n][1] = vtr(vb + (ks + 1) * 1024 + 512); vl[n][2] = vtr(vb + 4096 + (ks + 1) * 1024); vl[n][3] = vtr(vb + 4096 + (ks + 1) * 1024 + 512); }
        const int c = ks & 1; const bf16x8 pb = __builtin_bit_cast(bf16x8, pw[ks]);
        const bf16x8 v0 = (bf16x8){vl[c][0][0], vl[c][0][1], vl[c][0][2], vl[c][0][3], vl[c][1][0], vl[c][1][1], vl[c][1][2], vl[c][1][3]};
        const bf16x8 v1 = (bf16x8){vl[c][2][0], vl[c][2][1], vl[c][2][2], vl[c][2][3], vl[c][3][0], vl[c][3][1], vl[c][3][2], vl[c][3][3]};
        o0 = __builtin_amdgcn_mfma_f32_32x32x16_bf16(v0, pb, o0, 0, 0, 0);
        o1 = __builtin_amdgcn_mfma_f32_32x32x16_bf16(v1, pb, o1, 0, 0, 0);
        asm volatile("" ::: "memory");
    }
    __builtin_amdgcn_s_setprio(0);
}
__device__ __forceinline__ bf16x8 mfrag(float m, int hi) {
    const unsigned h = cvt_pk_bf16(m, 0.f) & 0xffffu; const float mh = __builtin_bit_cast(float, h << 16); const unsigned l = cvt_pk_bf16(m - mh, 0.f) & 0xffffu;
    const unsigned w = hi ? 0u : (h | (l << 16));
    return __builtin_bit_cast(bf16x8, (u32x4){w, 0u, 0u, 0u});
}
constexpr float ATT_BIG = 1099511627776.0f;
__device__ __forceinline__ void rebase(f32x16& p0, f32x16& p1, f32x16& o0, f32x16& o1, float& lrun, float& mrun, bf16x8& qmf, int hi) {
    if (__builtin_amdgcn_ballot_w64(lrun > ATT_BIG) != 0ull) {
        auto rr = __builtin_amdgcn_permlane32_swap(__float_as_uint(lrun), __float_as_uint(lrun), false, false);
        const float lt = __uint_as_float(rr[0]) + __uint_as_float(rr[1]);
        const int e = __builtin_amdgcn_frexp_expf(lt) - 1;
        const int d = e > 0 ? e : 0; const float delta = (float)d, alpha = __builtin_amdgcn_ldexpf(1.0f, -d); mrun += delta; lrun *= alpha; qmf = mfrag(mrun, hi);
#pragma unroll
        for (int r = 0; r < 16; ++r) { p0[r] -= delta; p1[r] -= delta; o0[r] *= alpha; o1[r] *= alpha; }
    }
}
__device__ __forceinline__ void unit(const Unit& U, const bf16_t* __restrict__ Q, const bf16_t* __restrict__ KV, const bf16_t* __restrict__ KR, bf16_t* __restrict__ O, LAS unsigned char* lds) {
    int tid_ = threadIdx.x; asm volatile("" : "+v"(tid_));
    const int tid = tid_, lane = tid & 63, r32 = lane & 31, hi = lane >> 5; const int wid = __builtin_amdgcn_readfirstlane(tid >> 6);
    const bool active = wid < U.nwq; const int mylim = active ? U.lim_base + (wid >> 1) * U.lim_step : 0;
    const int nr = wid * 8 + (lane >> 3), rr = wid * 8 + ((lane & 31) >> 2), vr = 16 * (wid & 3) + (lane >> 2);
    const unsigned voffN = (unsigned)(((U.kvrow0 + nr) * KVW + U.h * 128 + 8 * ((lane & 7) ^ ((nr >> 1) & 7))) * 2);
    const unsigned voffR = (unsigned)(((U.kvrow0 + rr) * 32 + 8 * ((lane & 3) ^ ((rr >> 2) & 3))) * 2);
    const unsigned voffV = (unsigned)(((U.kvrow0 + vr) * KVW + U.h * 128 + 64 + (wid >> 2) * 32 + 8 * (lane & 3)) * 2);
    const unsigned lds0 = (unsigned)(size_t)lds;
#define ATT_DMAS(t, s) do { if (wid < 4) { const char* kvb_ = (const char*)KV + (size_t)(t) * (64 * KVW * 2); const char* krb_ = (const char*)KR + (size_t)(t) * (64 * 32 * 2); \
          \
          \
        glds16(kvb_, voffN, (unsigned)__builtin_amdgcn_readfirstlane(lds0 + NOPE_B + (s) * 8192 + wid * 1024)); \
        glds16(kvb_ + 32 * KVW * 2, voffN, (unsigned)__builtin_amdgcn_readfirstlane(lds0 + NOPE_B + (s) * 8192 + (wid + 4) * 1024)); \
        glds16(kvb_, voffV, (unsigned)__builtin_amdgcn_readfirstlane(lds0 + V_B + (s) * 8192 + wid * 1024)); \
        glds16(kvb_ + 64, voffV, (unsigned)__builtin_amdgcn_readfirstlane(lds0 + V_B + (s) * 8192 + (wid + 4) * 1024)); \
        if (lane < 32) { glds16(krb_, voffR, (unsigned)__builtin_amdgcn_readfirstlane(lds0 + ROPE_B + (s) * 4096 + wid * 512)); \
                         glds16(krb_ + 32 * 64, voffR, (unsigned)__builtin_amdgcn_readfirstlane(lds0 + ROPE_B + (s) * 4096 + (wid + 4) * 512)); } } } while (0)
#define ATT_DMA(t) ATT_DMAS(t, (t) & 3)
    ATT_DMA(0); ATT_DMA(1); ATT_DMA(2);
    bf16x8 qf[4], qr4 = (bf16x8){0, 0, 0, 0, 0, 0, 0, 0}, qr5 = qr4;
    if (active) {
        const bf16_t* qp = Q + (size_t)(U.qrow0 + wid * 32 + r32) * QW + U.h * 96 + hi * 8;
#pragma unroll
        for (int d0 = 0; d0 < 4; ++d0) qf[d0] = *(const bf16x8*)(qp + d0 * 16);
        qr4 = *(const bf16x8*)(qp + 64); qr5 = *(const bf16x8*)(qp + 80);
    } else {
#pragma unroll
        for (int d0 = 0; d0 < 4; ++d0) qf[d0] = (bf16x8){0, 0, 0, 0, 0, 0, 0, 0};
    }
    const LAS unsigned char* qr = lds + QR_OFF + tid * 32;
    *(LAS bf16x8*)(lds + QR_OFF + tid * 32) = qr4; *(LAS bf16x8*)(lds + QR_OFF + tid * 32 + 16) = qr5;
    float mrun = 0.f, lrun = 0.f; f32x16 o0 = {}, o1 = {}, pA0 = {}, pA1 = {}, pB0 = {}, pB1 = {};
    bf16x8 qmf = (bf16x8){0, 0, 0, 0, 0, 0, 0, 0}; const bf16x8 kneg = __builtin_bit_cast(bf16x8, (u32x4){hi ? 0u : 0xBF80BF80u, 0u, 0u, 0u});
    unsigned ka[6];
    { const int xn = ((r32 >> 1) & 7) << 4, xr = ((r32 >> 2) & 3) << 4, hb = hi << 4;
#pragma unroll
      for (int d0 = 0; d0 < 6; ++d0) { unsigned a_ = d0 < 4 ? lds0 + NOPE_B + r32 * 128 + ((d0 * 32 + hb) ^ xn) : lds0 + ROPE_B + r32 * 64 + (((d0 - 4) * 32 + hb) ^ xr); asm volatile("" : "+v"(a_)); ka[d0] = a_; } }
    const int vfo = V_B + (4 * hi + ((lane & 15) >> 2)) * 64 + ((lane >> 4) & 1) * 32 + (lane & 3) * 8;
#define ATT_HEADX(t) do { asm volatile("s_waitcnt vmcnt(6) lgkmcnt(0)\n\ts_barrier" ::: "memory"); ATT_DMA((t) + 3); } while (0)
#define ATT_HEAD(t) do { if ((t) + 2 < U.ntiles) asm volatile("s_waitcnt vmcnt(6) lgkmcnt(0)\n\ts_barrier" ::: "memory"); else asm volatile("s_waitcnt vmcnt(0) lgkmcnt(0)\n\ts_barrier" ::: "memory"); \
        if ((t) + 3 < U.ntiles) ATT_DMA((t) + 3); } while (0)
#define ATT_FULLS(PC0, PC1, PN0, PN1, s0, s1) do { \
        step<true>(PN0, PN1, PC0, PC1, o0, o1, lrun, qmf, kneg, ka, (s1) * 8192, lds + (s0) * 8192 + vfo, qf, qr); rebase(PN0, PN1, o0, o1, lrun, mrun, qmf, hi); } while (0)
#define ATT_BARX asm volatile("s_waitcnt vmcnt(6) lgkmcnt(0)\n\ts_barrier" ::: "memory")
#define ATT_FULLD(PC0, PC1, PN0, PN1, s0, s1, td, sd) do { auto dma_ = [&]() { ATT_DMAS(td, sd); }; \
        step<true>(PN0, PN1, PC0, PC1, o0, o1, lrun, qmf, kneg, ka, (s1) * 8192, lds + (s0) * 8192 + vfo, qf, qr, dma_); rebase(PN0, PN1, o0, o1, lrun, mrun, qmf, hi); } while (0)
#define ATT_FULL(PC0, PC1, PN0, PN1, j) ATT_FULLS(PC0, PC1, PN0, PN1, (j) & 3, ((j) + 1) & 3)
#define ATT_LAST(PC0, PC1, PN0, PN1, j) do { const int s0_ = (j) & 3; \
        step<false>(PN0, PN1, PC0, PC1, o0, o1, lrun, qmf, kneg, ka, 0, lds + s0_ * 8192 + vfo, qf, qr); } while (0)
#define ATT_HEADS(t, s) do { asm volatile("s_waitcnt vmcnt(6) lgkmcnt(0)\n\ts_barrier" ::: "memory"); ATT_DMAS((t) + 3, s); } while (0)
    ATT_HEAD(0);
    int j = 1;
    if (0 < mylim) {
        {
#pragma unroll
            for (int d0 = 0; d0 < 6; ++d0) { bf16x8 a0_, a1_; kfrag(a0_, a1_, d0, ka, 0); const bf16x8 qd_ = d0 < 4 ? qf[d0 < 4 ? d0 : 0] : (d0 == 4 ? qr4 : qr5);
                pA0 = __builtin_amdgcn_mfma_f32_32x32x16_bf16(a0_, qd_, pA0, 0, 0, 0); pA1 = __builtin_amdgcn_mfma_f32_32x32x16_bf16(a1_, qd_, pA1, 0, 0, 0); }
            mrun = row_max32(pA0, pA1); qmf = mfrag(mrun, hi);
#pragma unroll
            for (int r_ = 0; r_ < 16; ++r_) { pA0[r_] -= mrun; pA1[r_] -= mrun; }
        }
        j = 0;
        while (j + 4 < mylim && j + 7 < U.ntiles) {
            ATT_FULLS(pA0, pA1, pB0, pB1, 0, 1); ATT_BARX; ATT_FULLD(pB0, pB1, pA0, pA1, 1, 2, j + 4, 0); ATT_BARX;
            ATT_FULLD(pA0, pA1, pB0, pB1, 2, 3, j + 5, 1); ATT_BARX; ATT_FULLD(pB0, pB1, pA0, pA1, 3, 0, j + 6, 2); ATT_HEADS(j + 4, 3); j += 4; }
        while (j + 2 < mylim && j + 5 < U.ntiles) { ATT_FULL(pA0, pA1, pB0, pB1, j); ATT_HEADX(j + 1); ATT_FULL(pB0, pB1, pA0, pA1, j + 1); ATT_HEADX(j + 2); j += 2; }
        while (j + 2 < mylim) { ATT_FULL(pA0, pA1, pB0, pB1, j); ATT_HEAD(j + 1); ATT_FULL(pB0, pB1, pA0, pA1, j + 1); ATT_HEAD(j + 2); j += 2; }
        if (j + 1 < mylim) { ATT_FULL(pA0, pA1, pB0, pB1, j); ATT_HEAD(j + 1); ATT_LAST(pB0, pB1, pA0, pA1, j + 1); j += 2; }
        else { ATT_LAST(pA0, pA1, pB0, pB1, j); j += 1; }
    }
    for (; j < U.ntiles; ++j) ATT_HEAD(j);
#undef ATT_HEADX
#undef ATT_HEAD
#undef ATT_FULL
#undef ATT_LAST
#undef ATT_FULLS
#undef ATT_FULLD
#undef ATT_BARX
#undef ATT_HEADS
#undef ATT_DMAS
#undef ATT_DMA
    asm volatile("s_waitcnt vmcnt(0) lgkmcnt(0)\n\ts_barrier" ::: "memory");
    if (active) {
        const float lt = lrun + shx(lrun, 32), inv = __builtin_amdgcn_rcpf(lt);
        bf16_t* op = O + (size_t)(U.qrow0 + wid * 32 + r32) * 1024 + U.h * 64 + 8 * hi;
#pragma unroll
        for (int dh = 0; dh < 2; ++dh) {
            const f32x16& oo = dh ? o1 : o0;
#pragma unroll
            for (int g = 0; g < 4; g += 2) {
                const unsigned a0 = cvt_pk_bf16(oo[4 * g] * inv, oo[4 * g + 1] * inv), a1 = cvt_pk_bf16(oo[4 * g + 2] * inv, oo[4 * g + 3] * inv);
                const unsigned b0 = cvt_pk_bf16(oo[4 * g + 4] * inv, oo[4 * g + 5] * inv), b1 = cvt_pk_bf16(oo[4 * g + 6] * inv, oo[4 * g + 7] * inv);
                auto s0 = __builtin_amdgcn_permlane32_swap(a0, b0, false, false); auto s1 = __builtin_amdgcn_permlane32_swap(a1, b1, false, false);
                *(u32x4*)(op + dh * 32 + 8 * g) = (u32x4){s0[0], s1[0], s0[1], s1[1]};
            }
        }
    }
}
__device__ __forceinline__ void phase(int vcu, int G, const bf16_t* Q, const bf16_t* KV, const bf16_t* KR, bf16_t* O, LAS unsigned char* lds) {
    for (int w = vcu; w < 256; w += G) {
        const int g = w >> 3, s = w & 7;
        for (int rnd = 0; rnd < 4; ++rnd) {
            const int bh = g + 32 * rnd, b = bh >> 4, h = bh & 15;
            int qlong, qshort;
            if (rnd < 2) { if (s < 4) { qlong = 15 - 2 * s; qshort = 2 * s + 1; } else { qlong = 14 - 2 * (s - 4); qshort = 2 * (s - 4); } }
            else { qlong = 15 - s; qshort = s; }
            for (int k = 0; k < 2; ++k) {
                const int qb = k ? qshort : qlong;
                Unit U; U.qrow0 = b * SEQ + qb * 256; U.kvrow0 = b * SEQ; U.h = h; U.ntiles = 4 * qb + 4; U.lim_base = 4 * qb + 1; U.lim_step = 1; U.nwq = 8;
                unit(U, Q, KV, KR, O, lds);
            }
        }
        if (s >= 4) {
            const int su = g * 4 + (s - 4), b = su >> 4, h = su & 15;
            Unit U; U.qrow0 = MP + b * DSEQ; U.kvrow0 = MP + b * KVS; U.h = h; U.ntiles = KVS / 64; U.lim_base = KVS / 64; U.lim_step = 0; U.nwq = 2;
            unit(U, Q, KV, KR, O, lds);
        }
    }
}
}

struct Args { const float* in[28]; float* out; unsigned char* ws; int ph_lo, ph_hi; };

__device__ __forceinline__ unsigned f2bf(float f) { unsigned u = __builtin_bit_cast(unsigned, f); return (u + 0x7fffu + ((u >> 16) & 1u)) >> 16; }
__device__ __forceinline__ unsigned pk2(float lo, float hi) { return f2bf(lo) | (f2bf(hi) << 16); }

__device__ __forceinline__ void transpose_item(const float* W, int N, const float* gain, bf16_t* WT, size_t ldw, int coff, int k0, int n0, int drow0, LAS float* scr, int lane) {
    float wv[32];
#pragma unroll
    for (int i = 0; i < 32; ++i) wv[i] = W[(size_t)(k0 + 2 * i + (lane >> 5)) * N + n0 + (lane & 31)];
    if (gain) {
#pragma unroll
        for (int i = 0; i < 32; ++i) wv[i] *= gain[k0 + 2 * i + (lane >> 5)];
    }
#pragma unroll
    for (int i = 0; i < 32; ++i) scr[(2 * i + (lane >> 5)) * 33 + (lane & 31)] = wv[i];
    asm volatile("s_waitcnt lgkmcnt(0)" ::: "memory");
    const int c = lane & 7;
#pragma unroll
    for (int j = 0; j < 4; ++j) { const int n = (lane >> 3) + 8 * j; const LAS float* s = scr + (8 * c) * 33 + n;
        u32x4 o; o.x = pk2(s[0 * 33], s[1 * 33]); o.y = pk2(s[2 * 33], s[3 * 33]); o.z = pk2(s[4 * 33], s[5 * 33]); o.w = pk2(s[6 * 33], s[7 * 33]);
        *(u32x4*)(WT + (size_t)(drow0 + n) * ldw + coff + k0 + 8 * c) = o; }
    asm volatile("s_waitcnt lgkmcnt(0)" ::: "memory");
}
__device__ __forceinline__ int win_row(int n0) {
    if (n0 < 1024) return (n0 >> 7) * 256 + (n0 & 127);
    if (n0 < 2048) return 2048 + (n0 - 1024);
    if (n0 < 3072) { const int j = n0 - 2048; return (j >> 7) * 256 + 128 + (j & 127); }
    if (n0 < 3840) return n0;
    if (n0 < 3872) return 5888 + (n0 - 3840);
    return n0 - 32;
}

__device__ __forceinline__ void rope_cs(int pos, int i, float& c, float& s) {
    float iv = 1.0f;
    iv = (i == 1) ? 0.5623413324356079f : iv;
    iv = (i == 2) ? 0.3162277638912201f : iv;
    iv = (i == 3) ? 0.17782793939113617f : iv;
    iv = (i == 4) ? 0.10000000149011612f : iv;
    iv = (i == 5) ? 0.05623413249850273f : iv;
    iv = (i == 6) ? 0.03162277489900589f : iv;
    iv = (i == 7) ? 0.017782794311642647f : iv;
    iv = (i == 8) ? 0.009999999776482582f : iv;
    iv = (i == 9) ? 0.005623413249850273f : iv;
    iv = (i == 10) ? 0.003162277629598975f : iv;
    iv = (i == 11) ? 0.0017782794311642647f : iv;
    iv = (i == 12) ? 0.0010000000474974513f : iv;
    iv = (i == 13) ? 0.000562341301701963f : iv;
    iv = (i == 14) ? 0.0003162277571391314f : iv;
    iv = (i == 15) ? 0.00017782794020604342f : iv;
    const float ang = (float)pos * iv;
    const float n = rintf(ang * 0.15915494309189535f);
    float r = fmaf(-n, 6.2831854820251465f, ang); r = fmaf(-n, -1.7484555e-7f, r);
    c = __cosf(r); s = __sinf(r);
}

__global__ void __launch_bounds__(NWAVES * 64, 2) fwd_kernel(Args args) {
    extern __shared__ __attribute__((aligned(16))) unsigned char lds_raw[];
    LAS unsigned char* lds = (LAS unsigned char*)lds_raw;
    volatile LAS unsigned* MISC = (volatile LAS unsigned*)(lds + MISC_OFF);
    const int wave = __builtin_amdgcn_readfirstlane((int)threadIdx.x >> 6);
    const int G = gridDim.x; const int bx = blockIdx.x; const int vcu = (G % 8 == 0) ? (bx % 8) * (G / 8) + bx / 8 : bx;
    unsigned char* ws = args.ws; float* out = args.out;
    unsigned* ctl = (unsigned*)(ws + WS_CTL);
    for (int u = threadIdx.x; u < (LDS_BYTES - LDSCTL_OFF) / 4; u += NWAVES * 64) ((LAS unsigned*)(lds + LDSCTL_OFF))[u] = 0u;
    __syncthreads();
    const int lo = args.ph_lo, hi = args.ph_hi;
    const bool multi = (hi - lo) > 1;
    XcdBarrier bar; bar.bar = ctl; bar.x = 0; bar.st = nullptr;
    if (multi) bar = xcd_barrier_post(ctl, MISC + 8);
#define IN(k) (({ asm volatile("" : "+s"(kp)); }), (lo <= (k) && (k) < hi))
#define TID_LANE int tid = threadIdx.x; asm volatile("" : "+v"(tid)); const int lane = tid & 63;
#define SEAM(k) do { if (IN(k) && IN((k) + 1)) xcd_barrier(bar); } while (0)
    const int gw = vcu * NWAVES + wave, NGW = G * NWAVES;

    const __attribute__((address_space(4))) unsigned char* kp = (const __attribute__((address_space(4))) unsigned char*)__builtin_amdgcn_kernarg_segment_ptr();
#define KIN(k) (((const float* const __attribute__((address_space(4)))*)kp)[k])
#define x_prompt KIN(0)
#define x_sample KIN(1)
#define cache_conv KIN(2)
#define cache_ckv KIN(3)
#define cache_krope KIN(4)
#define cache_mem_k KIN(5)
#define cache_mem_v KIN(6)
#define mem_prompt KIN(7)
#define g_mix KIN(8)
#define w_in KIN(9)
#define w_conv KIN(10)
#define w_conv_out KIN(11)
#define g_q KIN(12)
#define w_uq KIN(13)
#define g_kv KIN(14)
#define w_ukv KIN(15)
#define w_mla_out KIN(16)
#define w_mix_out KIN(17)
#define g_mem_q KIN(18)
#define g_mem_kv KIN(19)
#define w_qm KIN(20)
#define w_km KIN(21)
#define w_vm KIN(22)
#define w_om KIN(23)
#define g_mlp KIN(24)
#define w_up KIN(25)
#define w_down KIN(26)
#define g_final KIN(27)
    f32x2* tab = (f32x2*)(ws + WS_TAB);
    float* rstd0 = (float*)(ws + WS_RSTD0); float* rq = (float*)(ws + WS_RQ); float* rstdm = (float*)(ws + WS_RSTDM);
    float* st1 = (float*)(ws + WS_ST1); float* st2 = (float*)(ws + WS_ST2); float* st3 = (float*)(ws + WS_ST3);
    bf16_t* Win_t = (bf16_t*)(ws + WS_WIN); bf16_t* Wco_t = (bf16_t*)(ws + WS_WCO); bf16_t* Wuq_t = (bf16_t*)(ws + WS_WUQ); bf16_t* Wukv_t = (bf16_t*)(ws + WS_WUKV);
    bf16_t* Wmo_t = (bf16_t*)(ws + WS_WMO); bf16_t* Wmx_t = (bf16_t*)(ws + WS_WMX); bf16_t* Wqm_g = (bf16_t*)(ws + WS_WQM); bf16_t* Wkv_t = (bf16_t*)(ws + WS_WKV);
    bf16_t* Wom_t = (bf16_t*)(ws + WS_WOM); bf16_t* Wup_t = (bf16_t*)(ws + WS_WUP); bf16_t* Wdn_t = (bf16_t*)(ws + WS_WDN);
    bf16_t* mb = (bf16_t*)(ws + WS_MB); bf16_t* memk = (bf16_t*)(ws + WS_MEMK); bf16_t* memv = (bf16_t*)(ws + WS_MEMV); bf16_t* Wp = (bf16_t*)(ws + WS_WP); bf16_t* Vp = (bf16_t*)(ws + WS_VP);
    bf16_t* ckvb = (bf16_t*)(ws + WS_CKVB); bf16_t* krb = (bf16_t*)(ws + WS_KRB);
    bf16_t* R1 = (bf16_t*)(ws + WS_R1); bf16_t* R2 = (bf16_t*)(ws + WS_R2); bf16_t* R3 = (bf16_t*)(ws + WS_R3); bf16_t* R4 = (bf16_t*)(ws + WS_R4);
    bf16_t* R5 = (bf16_t*)(ws + WS_R5); bf16_t* R6 = (bf16_t*)(ws + WS_R6); bf16_t* R7 = (bf16_t*)(ws + WS_R7); bf16_t* R8 = (bf16_t*)(ws + WS_R8);
    float* slabs = (float*)(ws + WS_SLAB);
    bf16_t* cqb = (bf16_t*)out + (size_t)MT * QW;
    bf16_t* qbuf = (bf16_t*)out;

    if (IN(0)) { TID_LANE
        { constexpr int WKP = 1032; LAS unsigned short* wk = (LAS unsigned short*)(lds + RING_OFF);
          for (int k = tid; k < 1024; k += NWAVES * 64) { const float gk = g_mix[k]; const float* src = w_in + (size_t)k * NIN + 3840;
#pragma unroll
              for (int j4 = 0; j4 < 8; ++j4) { const f32x4 v = *(const f32x4*)(src + 4 * j4) * gk;
#pragma unroll
                  for (int e = 0; e < 4; ++e) wk[(4 * j4 + e) * WKP + k] = (unsigned short)(cvt_pk_bf16(v[e], 0.f) & 0xffffu); } }
          __syncthreads();
          const int rr = lane & 15, q = lane >> 4;
          const LAS unsigned char* wkb = lds + RING_OFF + (rr * WKP + 8 * q) * 2;
          f32x4 acc0, acc1; float ss;
#define P0_LOAD4(A, src, kc) do { _Pragma("unroll") for (int u = 0; u < 4; ++u) { A[u][0] = *(const f32x4*)((src) + 32 * ((kc) + u)); A[u][1] = *(const f32x4*)((src) + 32 * ((kc) + u) + 4); } } while (0)
#define P0_PROC4(A, dst, kc) do { _Pragma("unroll") for (int u = 0; u < 4; ++u) { \
              ss += (A[u][0][0] * A[u][0][0] + A[u][0][1] * A[u][0][1]) + (A[u][0][2] * A[u][0][2] + A[u][0][3] * A[u][0][3]) + (A[u][1][0] * A[u][1][0] + A[u][1][1] * A[u][1][1]) + (A[u][1][2] * A[u][1][2] + A[u][1][3] * A[u][1][3]); \
              const u32x4 pk = pack8(A[u][0], A[u][1]); *(u32x4*)((dst) + 32 * ((kc) + u)) = pk; const bf16x8 af = __builtin_bit_cast(bf16x8, pk); \
              const bf16x8 b0 = *(const LAS bf16x8*)(wkb + ((kc) + u) * 64), b1 = *(const LAS bf16x8*)(wkb + 16 * WKP * 2 + ((kc) + u) * 64); \
              acc0 = __builtin_amdgcn_mfma_f32_16x16x32_bf16(af, b0, acc0, 0, 0, 0); acc1 = __builtin_amdgcn_mfma_f32_16x16x32_bf16(af, b1, acc1, 0, 0, 0); } } while (0)
#define P0_FINISH(R0) do { ss += shx(ss, 16); ss += shx(ss, 32); const float rs = 1.0f / sqrtf(ss * (1.0f / 1024.0f) + EPS); if (q == 0) rstd0[(R0) + rr] = rs; \
              _Pragma("unroll") for (int e = 0; e < 4; ++e) { const float rse = __builtin_bit_cast(float, __builtin_amdgcn_ds_bpermute((4 * q + e) << 2, __builtin_bit_cast(int, rs))); \
                  unsigned short* kp = (unsigned short*)R8 + (size_t)((R0) + 4 * q + e) * 32 + rr; \
                  kp[0] = (unsigned short)(cvt_pk_bf16(acc0[e] * rse, 0.f) & 0xffffu); kp[16] = (unsigned short)(cvt_pk_bf16(acc1[e] * rse, 0.f) & 0xffffu); } } while (0)
          for (int bi = gw; bi < MP / 16; bi += NGW) {
              const int R0 = bi * 16; const float* src = x_prompt + (size_t)(R0 + rr) * 1024 + 8 * q; bf16_t* dst = R1 + (size_t)(R0 + rr) * 1024 + 8 * q;
              acc0 = (f32x4){0.f, 0.f, 0.f, 0.f}; acc1 = acc0; ss = 0.f;
              f32x4 a[2][4][2]; P0_LOAD4(a[0], src, 0);
#pragma unroll
              for (int it = 0; it < 8; ++it) { if (it + 1 < 8) P0_LOAD4(a[(it + 1) & 1], src, 4 * (it + 1)); P0_PROC4(a[it & 1], dst, 4 * it); }
              P0_FINISH(R0);
          }
          { LAS float* part = (LAS float*)(lds + RING_OFF + 73728);
            for (int sb = vcu; sb < MS / 16; sb += G) {
              const int R0 = MP + sb * 16; const float* src = x_sample + (size_t)(sb * 16 + rr) * 1024 + 8 * q; bf16_t* dst = R1 + (size_t)(R0 + rr) * 1024 + 8 * q;
              acc0 = (f32x4){0.f, 0.f, 0.f, 0.f}; acc1 = acc0; ss = 0.f;
              f32x4 a[4][2]; P0_LOAD4(a, src, 4 * wave); P0_PROC4(a, dst, 4 * wave);
              LAS float* mine = part + (wave * 9) * 64 + lane;
              mine[0] = ss;
#pragma unroll
              for (int e = 0; e < 4; ++e) { mine[(1 + e) * 64] = acc0[e]; mine[(5 + e) * 64] = acc1[e]; }
              __syncthreads();
              if (wave == 0) {
                  ss = 0.f; acc0 = (f32x4){0.f, 0.f, 0.f, 0.f}; acc1 = acc0;
                  for (int w = 0; w < NWAVES; ++w) { const LAS float* o = part + (w * 9) * 64 + lane; ss += o[0];
#pragma unroll
                      for (int e = 0; e < 4; ++e) { acc0[e] += o[(1 + e) * 64]; acc1[e] += o[(5 + e) * 64]; } }
                  P0_FINISH(R0);
              }
              __syncthreads();
            } }
#undef P0_LOAD4
#undef P0_PROC4
#undef P0_FINISH
          __syncthreads();
        }
        LAS float* scr = (LAS float*)(lds + RING_OFF + wave * 16384);
        int it = gw;
#define WJ(W, K, N, gain, dst, ldw, coff, mode) do { const int nblk = (N) / 32, nitems = ((K) / 64) * nblk; \
            for (; it < nitems; it += NGW) { const int kb = it / nblk, nb = it % nblk, n0 = nb * 32; transpose_item(W, N, gain, dst, (size_t)(ldw), coff, kb * 64, n0, (mode) ? win_row(n0) : n0, scr, lane); } \
            it -= nitems; } while (0)
        WJ(w_in, 1024, NIN, g_mix, Win_t, 1024, 0, 1);
        WJ(w_conv_out, 1024, 1024, (const float*)nullptr, Wco_t, 1024, 0, 0);
        WJ(w_uq, 512, QW, g_q, Wuq_t, 512, 0, 0);
        WJ(w_ukv, 256, KVW, (const float*)nullptr, Wukv_t, 256, 0, 0);
        WJ(w_mla_out, 1024, 1024, (const float*)nullptr, Wmo_t, 1024, 0, 0);
        WJ(w_mix_out, 1024, 1024, (const float*)nullptr, Wmx_t, 1024, 0, 0);
        WJ(w_km, 1024, 1024, g_mem_kv, Wkv_t, 1024, 0, 0);
        WJ(w_vm, 1024, 1024, g_mem_kv, Wkv_t + (size_t)1024 * 1024, 1024, 0, 0);
        WJ(w_om, 1024, 1024, (const float*)nullptr, Wom_t, 1024, 0, 0);
        WJ(w_up, 1024, DFF, g_mlp, Wup_t, 1024, 0, 0);
        WJ(w_down, DFF, 1024, (const float*)nullptr, Wdn_t, DFF, 0, 0);
#undef WJ
        for (int r = MT + gw; r < MT + 2048; r += NGW) {
            const float* src = r < MP ? x_prompt + (size_t)r * 1024 : (r < MT ? x_sample + (size_t)(r - MP) * 1024 : mem_prompt + (size_t)(r - MT) * 1024);
            bf16_t* dst = r < MT ? R1 + (size_t)r * 1024 : mb + (size_t)(r - MT) * 1024;
            f32x4 v[4]; float s = 0.f;
#pragma unroll
            for (int j = 0; j < 4; ++j) { v[j] = *(const f32x4*)(src + 256 * j + 4 * lane); s += (v[j][0] * v[j][0] + v[j][1] * v[j][1]) + (v[j][2] * v[j][2] + v[j][3] * v[j][3]); }
            s = wave_sum(s); const float rs = 1.0f / sqrtf(s * (1.0f / 1024.0f) + EPS);
            if (lane == 0) { if (r < MT) rstd0[r] = rs; else rstdm[r - MT] = rs; }
#pragma unroll
            for (int j = 0; j < 4; ++j) *(u32x2*)(dst + 256 * j + 4 * lane) = (u32x2){cvt_pk_bf16(v[j][0], v[j][1]), cvt_pk_bf16(v[j][2], v[j][3])};
        }
        for (int i = gw * 64 + lane; i < NB * PAST * 256 / 8; i += NGW * 64) { const int e = i * 8, row = e >> 8, c = e & 255, b = row >> 10, t = row & 1023;
            const f32x4 a = *(const f32x4*)(cache_ckv + e), bb = *(const f32x4*)(cache_ckv + e + 4); *(u32x4*)(ckvb + (size_t)(MP + b * KVS + t) * 256 + c) = pack8(a, bb); }
        for (int i = gw * 64 + lane; i < NB * PAST * 32 / 8; i += NGW * 64) { const int e = i * 8, row = e >> 5, c = e & 31, b = row >> 10, t = row & 1023;
            const f32x4 a = *(const f32x4*)(cache_krope + e), bb = *(const f32x4*)(cache_krope + e + 4); *(u32x4*)(krb + (size_t)(MP + b * KVS + t) * 32 + c) = pack8(a, bb); }
        for (int i = gw * 64 + lane; i < 2048 * 1024 / 8; i += NGW * 64) { const size_t e = (size_t)i * 8;
            const f32x4 a = *(const f32x4*)(cache_mem_k + e), bb = *(const f32x4*)(cache_mem_k + e + 4); *(u32x4*)(memk + (size_t)2048 * 1024 + e) = pack8(a, bb); }
        for (int i = gw * 64 + lane; i < 2048 * 1024 / 8; i += NGW * 64) { const size_t e = (size_t)i * 8;
            const f32x4 a = *(const f32x4*)(cache_mem_v + e), bb = *(const f32x4*)(cache_mem_v + e + 4); *(u32x4*)(memv + (size_t)2048 * 1024 + e) = pack8(a, bb); }
        for (int i = gw * 64 + lane; i < 1024 * 1024 / 8; i += NGW * 64) { const size_t e = (size_t)i * 8; const float gk = g_mem_q[e >> 10];
            const f32x4 a = *(const f32x4*)(w_qm + e) * gk, bb = *(const f32x4*)(w_qm + e + 4) * gk; *(u32x4*)(Wqm_g + e) = pack8(a, bb); }
        for (int i = gw * 64 + lane; i < SEQ * 16; i += NGW * 64) { float c, s; rope_cs(i >> 4, i & 15, c, s); tab[i] = (f32x2){c, s}; }
    }
    SEAM(0);

    if (IN(1)) {
        { pg8::Dense P{R1, Win_t, 1024, 1024, 1024}; pg8::StaticOrder S; S.init(MP, NIN1, G, bx);
          pg8::EpiIn E{rstd0, R2, R3, cqb, R5, R6, R7}; pg8::gemm_phase(lds + RING_OFF, P, S, E);
          { pg8::Piece pc; if (pg8::piece_of(NIN1, 1024, G, bx, 2, 128, pc)) pg8::gemm_piece(lds + RING_OFF, P, E, pc, pg8::SplitCtx{out + OUT_Y, ctl + 4096, MISC + 16}); } }
        if (G != 256) { pg8::Dense P{mb, Wkv_t, 1024, 1024, 1024}; pg8::StaticOrder S; S.init(2048, 2048, G, (bx + G - 96) % G);
          pg8::EpiMemKV E{rstdm, out + OUT_MEMK, out + OUT_MEMV, memk, memv}; pg8::gemm_phase(lds + RING_OFF, P, S, E); }
    }
    SEAM(1);

    if (IN(2)) {
        const bool kvcu = G == 256 && (vcu & 31) < 8;
        if (kvcu) { pg8::Dense P{mb, Wkv_t, 1024, 1024, 1024}; pg8::StaticOrder S; S.init(2048, 2048, 64, (vcu >> 5) * 8 + (vcu & 31));
            pg8::EpiMemKV E{rstdm, out + OUT_MEMK, out + OUT_MEMV, memk, memv}; pg8::gemm_phase(lds + RING_OFF, P, S, E); }
        TID_LANE
        int h0, h1, nh;
        if (G == 256) { nh = 3584; if (kvcu) { h0 = 3072 + ((vcu >> 5) * 8 + (vcu & 31)) * NWAVES + wave; h1 = h0 + 1; } else { h0 = 2 * (((vcu >> 5) * 24 + (vcu & 31) - 8) * NWAVES + wave); h1 = h0 + 2; } }
        else { nh = G * NWAVES; h0 = vcu * NWAVES + wave; h1 = h0 + 1; }
        const int rbeg = (int)(((long)h0 * MT) / nh), rend = (int)(((long)h1 * MT) / nh);
        f32x4 wc_[2][6];
#pragma unroll
        for (int hh = 0; hh < 2; ++hh) { const int c = hh * 512 + lane * 8;
#pragma unroll
            for (int k = 0; k < 3; ++k) { wc_[hh][2 * k] = *(const f32x4*)(w_conv + k * 1024 + c); wc_[hh][2 * k + 1] = *(const f32x4*)(w_conv + k * 1024 + c + 4); } }
        const f32x4 gkv = *(const f32x4*)(g_kv + lane * 4);
        f32x4 p1[2][2] = {}, p2[2][2] = {};
        u32x4 cv[2], cb[2], ccq; u32x2 cck; unsigned short ckr;
#define P2_LOAD(r_, V, B, CQ, CK, KR) do { _Pragma("unroll") for (int hh = 0; hh < 2; ++hh) { V[hh] = *(const u32x4*)(R2 + (size_t)(r_) * 1024 + hh * 512 + lane * 8); B[hh] = *(const u32x4*)(R3 + (size_t)(r_) * 1024 + hh * 512 + lane * 8); } \
            CQ = *(const u32x4*)(cqb + (size_t)(r_) * 512 + lane * 8); CK = *(const u32x2*)(R5 + (size_t)(r_) * 256 + lane * 4); KR = R8[(size_t)(r_) * 32 + (lane & 31)]; } while (0)
        if (rbeg < rend) {
            P2_LOAD(rbeg, cv, cb, ccq, cck, ckr);
            { const bool isP = rbeg < MP; const int rr = isP ? rbeg : rbeg - MP; const int b = isP ? rr >> 12 : rr >> 6, t = isP ? rr & (SEQ - 1) : rr & (DSEQ - 1);
#pragma unroll
              for (int hh = 0; hh < 2; ++hh) { const int c = hh * 512 + lane * 8;
                  if (t >= 1) unpack8(*(const u32x4*)(R2 + (size_t)(rbeg - 1) * 1024 + c), p1[hh][0], p1[hh][1]);
                  else if (!isP) { p1[hh][0] = *(const f32x4*)(cache_conv + (size_t)(b * 2 + 1) * 1024 + c); p1[hh][1] = *(const f32x4*)(cache_conv + (size_t)(b * 2 + 1) * 1024 + c + 4); }
                  if (t >= 2) unpack8(*(const u32x4*)(R2 + (size_t)(rbeg - 2) * 1024 + c), p2[hh][0], p2[hh][1]);
                  else if (!isP) { p2[hh][0] = *(const f32x4*)(cache_conv + (size_t)(b * 2 + t) * 1024 + c); p2[hh][1] = *(const f32x4*)(cache_conv + (size_t)(b * 2 + t) * 1024 + c + 4); } } }
        }
        for (int r = rbeg; r < rend; ++r) {
            u32x4 nv[2], nb[2], ncq; u32x2 nck; unsigned short nkr;
            const int rn = r + 1 < rend ? r + 1 : r;
            P2_LOAD(rn, nv, nb, ncq, nck, nkr);
            const bool isP = r < MP; const int rr = isP ? r : r - MP; const int b = isP ? rr >> 12 : rr >> 6, t = isP ? rr & (SEQ - 1) : rr & (DSEQ - 1), T = isP ? SEQ : DSEQ;
            const int kvrow = isP ? r : MP + b * KVS + PAST + t, pos = isP ? t : PAST + t;
            float* oconv = out + (isP ? OUT_CONVP : OUT_CONVS); float* ockv = out + (isP ? OUT_CKVP : OUT_CKVS); float* okr = out + (isP ? OUT_KRP : OUT_KRS);
            if (t == 0) {
#pragma unroll
                for (int hh = 0; hh < 2; ++hh) { const int c = hh * 512 + lane * 8;
                    if (isP) { p1[hh][0] = p1[hh][1] = p2[hh][0] = p2[hh][1] = (f32x4){0.f, 0.f, 0.f, 0.f}; }
                    else { p1[hh][0] = *(const f32x4*)(cache_conv + (size_t)(b * 2 + 1) * 1024 + c); p1[hh][1] = *(const f32x4*)(cache_conv + (size_t)(b * 2 + 1) * 1024 + c + 4);
                           p2[hh][0] = *(const f32x4*)(cache_conv + (size_t)(b * 2) * 1024 + c); p2[hh][1] = *(const f32x4*)(cache_conv + (size_t)(b * 2) * 1024 + c + 4); } }
            }
#pragma unroll
            for (int hh = 0; hh < 2; ++hh) {
                const int c = hh * 512 + lane * 8;
                f32x4 v0a, v0b, ba, bb; unpack8(cv[hh], v0a, v0b); unpack8(cb[hh], ba, bb);
                const f32x4 ga = ba * (wc_[hh][0] * p2[hh][0] + wc_[hh][2] * p1[hh][0] + wc_[hh][4] * v0a), gb = bb * (wc_[hh][1] * p2[hh][1] + wc_[hh][3] * p1[hh][1] + wc_[hh][5] * v0b);
                *(u32x4*)(R1 + (size_t)r * 1024 + c) = pack8(ga, gb);
                if (t >= T - 2) { float* o = oconv + (size_t)(b * 2 + (t - (T - 2))) * 1024 + c; *(f32x4*)o = v0a; *(f32x4*)(o + 4) = v0b; }
                p2[hh][0] = p1[hh][0]; p2[hh][1] = p1[hh][1]; p1[hh][0] = v0a; p1[hh][1] = v0b;
            }
            f32x4 qa, qb; unpack8(ccq, qa, qb);
            float s1 = (qa[0] * qa[0] + qa[1] * qa[1]) + (qa[2] * qa[2] + qa[3] * qa[3]) + (qb[0] * qb[0] + qb[1] * qb[1]) + (qb[2] * qb[2] + qb[3] * qb[3]);
            f32x4 ka = (f32x4){bf_lo(cck.x), bf_hi(cck.x), bf_lo(cck.y), bf_hi(cck.y)};
            float s2 = (ka[0] * ka[0] + ka[1] * ka[1]) + (ka[2] * ka[2] + ka[3] * ka[3]);
#pragma unroll
            for (int o = 1; o < 64; o <<= 1) { s1 += shx(s1, o); s2 += shx(s2, o); }
            if (lane == 0) rq[r] = 1.0f / sqrtf(s1 * (1.0f / 512.0f) + EPS);
            { const float rs = 1.0f / sqrtf(s2 * (1.0f / 256.0f) + EPS); ka = ka * rs * gkv;
              *(f32x4*)(ockv + (size_t)rr * 256 + lane * 4) = ka; *(u32x2*)(ckvb + (size_t)kvrow * 256 + lane * 4) = (u32x2){cvt_pk_bf16(ka[0], ka[1]), cvt_pk_bf16(ka[2], ka[3])}; }
            { const int i = lane & 31; const float xv = __builtin_bit_cast(float, (unsigned)ckr << 16);
              const float pv = shx(xv, 16); const f32x2 cs = tab[pos * 16 + (i & 15)];
              const float o = (i < 16) ? xv * cs.x - pv * cs.y : xv * cs.x + pv * cs.y;
              if (lane < 32) { okr[(size_t)rr * 32 + i] = o; krb[(size_t)kvrow * 32 + i] = (bf16_t)f2bf(o); } }
#pragma unroll
            for (int hh = 0; hh < 2; ++hh) { cv[hh] = nv[hh]; cb[hh] = nb[hh]; }
            ccq = ncq; cck = nck; ckr = nkr;
        }
#undef P2_LOAD
    }
    SEAM(2);

    if (IN(3)) {
        { pg8::Dense P{R1, Wco_t, 1024, 1024, 1024}; pg8::StaticOrder S; S.init(MP, 1024, G, bx);
          pg8::EpiGate E{R6}; pg8::gemm_phase(lds + RING_OFF, P, S, E);
          { pg8::Piece pc; if (pg8::piece_of(1024, 1024, G, bx, 4, 0, pc)) pg8::gemm_piece(lds + RING_OFF, P, E, pc, pg8::SplitCtx{slabs, ctl + 4096 + 64, MISC + 16}); } }
        { pg8::Dense P{cqb, Wuq_t, 512, 512, 512}; pg8::StaticOrder S; S.init(MP, QW, G, bx);
          pg8::EpiQ E{rq, tab, qbuf}; pg8::gemm_phase(lds + RING_OFF, P, S, E);
          { pg8::Piece pc; if (pg8::piece_of(QW, 512, G, bx, 2, 128, pc)) pg8::gemm_piece(lds + RING_OFF, P, E, pc, pg8::SplitCtx{slabs + (size_t)32 * 65536, ctl + 4096 + 128, MISC + 16}); } }
        { pg8::Dense P{ckvb, Wukv_t, 256, 256, 256}; pg8::StaticOrder S; S.init(KVROWS, KVW, G, (bx + 64) % G);
          pg8::EpiPlain E{R2, KVW}; pg8::gemm_phase(lds + RING_OFF, P, S, E); }
    }
    SEAM(3);

    if (IN(5)) attn::phase(vcu, G, qbuf, R2, krb, R1, lds + RING_OFF);
    SEAM(5);

    if (IN(6)) {
        pg8::Dense P{R1, Wmo_t, 1024, 1024, 1024}; pg8::StaticOrder S; S.init(MP, 1024, G, bx);
        pg8::EpiMix E{R6, R7}; pg8::gemm_phase(lds + RING_OFF, P, S, E);
          { pg8::Piece pc; if (pg8::piece_of(1024, 1024, G, bx, 4, 0, pc)) pg8::gemm_piece(lds + RING_OFF, P, E, pc, pg8::SplitCtx{slabs, ctl + 4096 + 192, MISC + 16}); }
        { pg8::ProbWp Pw{memk, Wqm_g, 256, 1024, 1024}; pg8::PreOrder So{G - 32, (int)bx - 32}; pg8::EpiPlain Ew{Wp, 1024}; pg8::gemm_phase(lds + RING_OFF, Pw, So, Ew); }
    }
    SEAM(6);

    if (IN(7)) {
        pg8::Dense P{R7, Wmx_t, 1024, 1024, 1024}; pg8::StaticOrder S; S.init(MP, 1024, G, bx);
        pg8::EpiRes E{x_prompt, x_sample, out + OUT_Y, R1, st1}; pg8::gemm_phase(lds + RING_OFF, P, S, E);
          { pg8::Piece pc; if (pg8::piece_of(1024, 1024, G, bx, 4, 0, pc)) pg8::gemm_piece(lds + RING_OFF, P, E, pc, pg8::SplitCtx{slabs, ctl + 4096 + 256, MISC + 16}); }
        { pg8::ProbVp Pv{Wom_t, memv, 256, 1024, 1024}; pg8::PreOrder So{G - 32, (int)bx - 32}; pg8::EpiPlain Ev{Vp, 1024}; pg8::gemm_phase(lds + RING_OFF, Pv, So, Ev); }
    }
    SEAM(7);

    if (IN(8)) {
        pg8::ProbMA P{R1, Wp, 1024, 1024, 1024}; pg8::StaticOrder S; S.init(MP, 1024, G, bx);
        LAS float* rt8 = (LAS float*)(lds + MISC_OFF + 512); LAS int* pmt8 = (LAS int*)(lds + MISC_OFF + 256);
        { TID_LANE (void)lane;
          if (tid == 0) { int n = 0;
              for (int i = 0; ; ++i) { const int pmi = S.pm_of(i); if (pmi < 0) break; bool seen = false; for (int k = 0; k < n; ++k) seen = seen || (pmt8[k] == pmi); if (!seen && n < 7) pmt8[n++] = pmi; }
              pmt8[8] = n; for (int k = n; k < 8; ++k) pmt8[k] = -1; }
          __syncthreads();
          const int n_ = pmt8[8];
          for (int idx = tid; idx < n_ * 256; idx += NWAVES * 64) rt8[idx] = pg8::row_rstd(st1, pmt8[idx >> 8] * 256 + (idx & 255));
          __syncthreads(); }
        pg8::EpiSoftmaxS E{st1, MSCALE, R3, (LAS float*)(lds + SCR_OFF), (unsigned)(size_t)rt8, (unsigned)(size_t)pmt8}; pg8::gemm_phase(lds + RING_OFF, P, S, E);
          { pg8::Piece pc; if (pg8::piece_of_mem(G, bx, 4, 0, pc)) pg8::gemm_piece(lds + RING_OFF, P, E, pc, pg8::SplitCtx{slabs, ctl + 4096 + 320, MISC + 16}); }
    }
    SEAM(8);

    if (IN(9)) {
        pg8::ProbMA P{R3, Vp, 1024, 1024, 1024}; pg8::StaticOrder S; S.init(MP, 1024, G, bx);
        pg8::EpiResM E{out + OUT_Y, R1, st2}; pg8::gemm_phase(lds + RING_OFF, P, S, E);
          { pg8::Piece pc; if (pg8::piece_of_mem(G, bx, 4, 0, pc)) pg8::gemm_piece(lds + RING_OFF, P, E, pc, pg8::SplitCtx{slabs, ctl + 4096 + 384, MISC + 16}); }
    }
    SEAM(9);

    if (IN(12)) {
        pg8::Dense P{R1, Wup_t, 1024, 1024, 1024}; pg8::StaticOrder S; S.init(MP, DFF, G, bx);
        LAS float* rt = (LAS float*)(lds + SCR_OFF); LAS int* pmt = (LAS int*)(lds + MISC_OFF + 128);
        { TID_LANE
          if (tid == 0) { int n = 0;
              for (int i = 0; ; ++i) { const int pmi = S.pm_of(i); if (pmi < 0) break; bool seen = false; for (int k = 0; k < n; ++k) seen = seen || (pmt[k] == pmi); if (!seen && n < 8) pmt[n++] = pmi; }
              pmt[8] = n; for (int k = n; k < 8; ++k) pmt[k] = -1; }
          __syncthreads();
          const int n = pmt[8];
          for (int idx = tid; idx < n * 256; idx += NWAVES * 64) rt[idx] = pg8::row_rstd(st2, pmt[idx >> 8] * 256 + (idx & 255));
          __syncthreads(); (void)lane; }
        pg8::EpiNormAct<1> E{st2, R2, DFF, 1.0f, (unsigned)(size_t)rt, (unsigned)(size_t)pmt}; pg8::gemm_phase(lds + RING_OFF, P, S, E);
          { pg8::Piece pc; if (pg8::piece_of(DFF, 1024, G, bx, 4, 0, pc)) pg8::gemm_piece(lds + RING_OFF, P, E, pc, pg8::SplitCtx{slabs, ctl + 4096 + 448, MISC + 16}); }
    }
    SEAM(12);

    if (IN(13)) {
        pg8::Dense P{R2, Wdn_t, DFF, DFF, DFF}; pg8::StaticOrder S; S.init(MP, 1024, G, bx);
        if (G == 256) {
            pg8::EpiResFinal E{out + OUT_Y, out + OUT_Y + (size_t)MP * 1024, out + OUT_Y, st3, ctl + 8192, g_final}; pg8::gemm_phase(lds + RING_OFF, P, S, E);
            { pg8::Piece pc; if (pg8::piece_of(1024, DFF, G, bx, 8, 0, pc)) pg8::gemm_piece(lds + RING_OFF, P, E, pc, pg8::SplitCtx{slabs, ctl + 4096 + 512, MISC + 16}); }
        } else {
            pg8::EpiRes E{out + OUT_Y, out + OUT_Y + (size_t)MP * 1024, out + OUT_Y, nullptr, st3}; pg8::gemm_phase(lds + RING_OFF, P, S, E);
            { pg8::Piece pc; if (pg8::piece_of(1024, DFF, G, bx, 8, 0, pc)) pg8::gemm_piece(lds + RING_OFF, P, E, pc, pg8::SplitCtx{slabs, ctl + 4096 + 512, MISC + 16}); }
        }
    }
    if (G != 256) SEAM(13);

    if (IN(14) && G != 256) { TID_LANE
        for (int r = gw; r < MT; r += NGW) {
            const float rs = pg8::row_rstd(st3, r); float* p = out + OUT_Y + (size_t)r * 1024;
#pragma unroll
            for (int j = 0; j < 4; ++j) { const int c = 256 * j + 4 * lane; *(f32x4*)(p + c) = *(const f32x4*)(p + c) * rs * *(const f32x4*)(g_final + c); }
        }
    }
#undef IN
#undef SEAM
#undef x_prompt
#undef x_sample
#undef cache_conv
#undef cache_ckv
#undef cache_krope
#undef cache_mem_k
#undef cache_mem_v
#undef mem_prompt
#undef g_mix
#undef w_in
#undef w_conv
#undef w_conv_out
#undef g_q
#undef w_uq
#undef g_kv
#undef w_ukv
#undef w_mla_out
#undef w_mix_out
#undef g_mem_q
#undef g_mem_kv
#undef w_qm
#undef w_km
#undef w_vm
#undef w_om
#undef g_mlp
#undef w_up
#undef w_down
#undef g_final
#undef KIN
}

#ifndef MK_PER_PHASE
#define MK_PER_PHASE 0
#endif
constexpr int NPHASE = 15;
extern "C" void kernel_launch(void* const* d_in, const int* in_sizes, int n_in, void* d_out, int out_size, void* d_ws, size_t ws_size, hipStream_t stream) {
    static int grid = 0;
    if (grid == 0) {
        if (n_in != 28 || (size_t)out_size != OUT_TOTAL || ws_size < WS_END) { fprintf(stderr, "kernel_launch: unexpected problem (n_in %d, out %d, ws %zu)\n", n_in, out_size, ws_size); grid = -1; return; }
        int dev = 0, cus = 0, per_cu = 0;
        if (hipGetDevice(&dev) != hipSuccess || hipDeviceGetAttribute(&cus, hipDeviceAttributeMultiprocessorCount, dev) != hipSuccess) { grid = -1; return; }
        if (hipFuncSetAttribute((const void*)fwd_kernel, hipFuncAttributeMaxDynamicSharedMemorySize, LDS_BYTES) != hipSuccess) { fprintf(stderr, "kernel_launch: hipFuncSetAttribute failed\n"); grid = -1; return; }
        if (hipOccupancyMaxActiveBlocksPerMultiprocessor(&per_cu, (const void*)fwd_kernel, NWAVES * 64, LDS_BYTES) != hipSuccess || per_cu < 1) { fprintf(stderr, "kernel_launch: occupancy query says %d\n", per_cu); per_cu = 1; }
        (void)hipGetLastError();
        grid = cus;
    }
    if (grid < 0) return;
    (void)hipMemsetAsync((char*)d_ws + WS_CTL, 0, CTL_ZERO_BYTES, stream);
    Args a{};
    for (int i = 0; i < 28; ++i) a.in[i] = (const float*)d_in[i];
    a.out = (float*)d_out; a.ws = (unsigned char*)d_ws;
#if MK_PER_PHASE
    for (int p = 0; p < NPHASE; ++p) { a.ph_lo = p; a.ph_hi = p + 1; hipLaunchKernelGGL(fwd_kernel, dim3(grid), dim3(NWAVES * 64), LDS_BYTES, stream, a); }
#else
    a.ph_lo = 0; a.ph_hi = NPHASE;
    hipLaunchKernelGGL(fwd_kernel, dim3(grid), dim3(NWAVES * 64), LDS_BYTES, stream, a);
#endif
}
```

```cpp
#include <hip/hip_runtime.h>
#include <cstdio>
#include <cstdint>

#define LAS __attribute__((address_space(3)))
#define GAS __attribute__((address_space(1)))
typedef unsigned short bf16_t;
typedef short bf16x8 __attribute__((ext_vector_type(8)));
typedef short s16x4 __attribute__((ext_vector_type(4)));
typedef float f32x4 __attribute__((ext_vector_type(4)));
typedef float f32x2 __attribute__((ext_vector_type(2)));
typedef float f32x16 __attribute__((ext_vector_type(16)));
typedef unsigned u32x4 __attribute__((ext_vector_type(4)));
typedef unsigned u32x2 __attribute__((ext_vector_type(2)));

constexpr int DM = 1024, NB = 8, SEQ = 4096, DSEQ = 64, PAST = 1024;
constexpr int MP = NB * SEQ;
constexpr int MS = NB * DSEQ;
constexpr int MT = MP + MS;
constexpr int KVS = PAST + DSEQ;
constexpr int KVROWS = MP + NB * KVS;
constexpr int NIN = 5920, NINP = 6144, NIN1 = 5888;
constexpr int QW = 1536, KVW = 2048, DFF = 4096, NMEM = 256;
constexpr float EPS = 1e-6f;
constexpr float LOG2E = 1.4426950408889634f;
constexpr float QSCALE = 0.10206207261596577f * LOG2E;
constexpr float MSCALE = 0.0625f * LOG2E;

typedef __bf16 bf16x2_t __attribute__((ext_vector_type(2)));
__device__ __forceinline__ unsigned cvt_pk_bf16(float lo, float hi) { f32x2 v = {lo, hi}; bf16x2_t b = __builtin_convertvector(v, bf16x2_t); return __builtin_bit_cast(unsigned, b); }
__device__ __forceinline__ float bf_lo(unsigned w) { return __builtin_bit_cast(float, w << 16); }
__device__ __forceinline__ float bf_hi(unsigned w) { return __builtin_bit_cast(float, w & 0xffff0000u); }
__device__ __forceinline__ u32x4 pack8(f32x4 a, f32x4 b) { u32x4 w; w.x = cvt_pk_bf16(a[0], a[1]); w.y = cvt_pk_bf16(a[2], a[3]); w.z = cvt_pk_bf16(b[0], b[1]); w.w = cvt_pk_bf16(b[2], b[3]); return w; }
__device__ __forceinline__ void unpack8(u32x4 w, f32x4& a, f32x4& b) { a = (f32x4){bf_lo(w.x), bf_hi(w.x), bf_lo(w.y), bf_hi(w.y)}; b = (f32x4){bf_lo(w.z), bf_hi(w.z), bf_lo(w.w), bf_hi(w.w)}; }
__device__ __forceinline__ float fast_sigmoid(float x) { return __builtin_amdgcn_rcpf(1.0f + __builtin_amdgcn_exp2f(-x * LOG2E)); }
__device__ __forceinline__ float shx(float v, int m) { int z = 0; asm volatile("" : "+v"(z)); const int l = __builtin_amdgcn_mbcnt_hi(~0u, __builtin_amdgcn_mbcnt_lo(~0u, z));
    return __builtin_bit_cast(float, __builtin_amdgcn_ds_bpermute((l ^ m) << 2, __builtin_bit_cast(int, v))); }
__device__ __forceinline__ float xor32v(float v, bool lo) { auto r = __builtin_amdgcn_permlane32_swap(__float_as_uint(v), __float_as_uint(v), false, false); return __uint_as_float(lo ? r[1] : r[0]); }
__device__ __forceinline__ float wave_sum(float v) {
#pragma unroll
    for (int o = 1; o < 64; o <<= 1) v += shx(v, o);
    return v;
}

namespace pg8 {
constexpr int BM = 256, BK = 64, HALF = 128, HTB = HALF * BK * 2  , STAGE_BYTES = 8 * HTB, NXCD = 8, WGM = 4;
static_assert(WGM * 4 <= 32, "EpiResFinal: a row panel's four owners must share a round");
__host__ __device__ __forceinline__ int lds_byte(int r, int c) { const int st = (r >> 4) * 2 + (c >> 5), rr = r & 15, cc = c & 31, ob = rr * 64 + cc * 2; return st * 1024 + (ob ^ (((ob >> 9) & 1) << 5)); }
__host__ __device__ __forceinline__ void stage_rc(int b, int& R, int& C) { const int st = b / 1024, sb = b % 1024, swz = sb ^ (((sb >> 9) & 1) << 5); R = (st >> 1) * 16 + swz / 64; C = (st & 1) * 32 + (swz % 64) / 2; }
__host__ __device__ __forceinline__ int perm32(int rho) { const int n = rho >> 4, i = rho & 15; return 8 * (i >> 2) + 4 * n + (i & 3); }

struct Unit { int pm, pn; };
struct Dense {
    const bf16_t* A; const bf16_t* Bt; int K, lda, ldb;
    __device__ __forceinline__ const char* aptr(const Unit& u) const { return (const char*)(A + (size_t)u.pm * 256 * lda); }
    __device__ __forceinline__ const char* bptr(const Unit& u) const { return (const char*)(Bt + (size_t)u.pn * 256 * ldb); }
};
struct StaticOrder {
    int nM, nN, nwg, G, c;
    __host__ __device__ void init(int M, int N, int G_, int c_) { nM = M / BM; nN = N / BM; nwg = nM * nN; G = G_; c = c_; }
    __host__ __device__ bool next(int i, Unit& u) const {
        const long L = (long)i * G + c; if (L >= nwg) return false;
        int wgid = (int)L; { const int q = nwg / NXCD, r = nwg % NXCD, xcd = wgid % NXCD, off = wgid / NXCD; wgid = (xcd < r ? xcd * (q + 1) : r * (q + 1) + (xcd - r) * q) + off; }
        const int nig = WGM * nN, gid = wgid / nig, fm = gid * WGM, gsz = (nM - fm) < WGM ? (nM - fm) : WGM;
        u.pm = fm + ((wgid % nig) % gsz); u.pn = (wgid % nig) / gsz; return true;
    }
    __host__ __device__ __forceinline__ int pm_of(int i) const {
        const long L = (long)i * G + c; if (L >= nwg) return -1;
        int wgid = (int)L; { const int q = nwg / NXCD, r = nwg % NXCD, xcd = wgid % NXCD, off = wgid / NXCD; wgid = (xcd < r ? xcd * (q + 1) : r * (q + 1) + (xcd - r) * q) + off; }
        const int nig = WGM * nN, gid = wgid / nig, fm = gid * WGM, gsz = (nM - fm) < WGM ? (nM - fm) : WGM;
        return fm + ((wgid % nig) % gsz);
    }
};

typedef f32x4 Acc[2][2][4][2];

template <class Prob, class Epi, class Sched>
__device__ __forceinline__ void gemm_phase(LAS unsigned char* lds, const Prob& P, const Sched& S, const Epi& E) {
    const int tid = threadIdx.x, wid = __builtin_amdgcn_readfirstlane(tid >> 6), lane = tid & 63, wr = wid >> 2, wc = wid & 3, fr = lane & 15, fq = lane >> 4;
    const int nt = P.K / BK;
    unsigned voffA[2], voffB[2];
#pragma unroll
    for (int i = 0; i < 2; ++i) { int R, C; stage_rc(tid * 16 + i * 8192, R, C); const int Rb = (R & ~31) + perm32(R & 31);
        voffA[i] = (unsigned)(R * P.lda + C) * 2u; voffB[i] = (unsigned)(Rb * P.ldb + C) * 2u; }
    const size_t kstep = (size_t)(BK * 2);
    const size_t hstepA = (size_t)HALF * P.lda * 2, hstepB = (size_t)HALF * P.ldb * 2;
    const unsigned ldsw = (unsigned)wid * 1024u;
    const int aoff = lds_byte(wr * 64 + fr, fq * 8), boff = lds_byte(wc * 32 + fr, fq * 8);
#define PG8_SA(b, h) (((b) * 2 + (h)) * HTB)
#define PG8_SB(b, h) ((4 + (b) * 2 + (h)) * HTB)
#define PG8_STAGE(bufoff, gbase, voff) do { _Pragma("unroll") for (int _i = 0; _i < 2; ++_i) \
        __builtin_amdgcn_global_load_lds((const unsigned*)((const char*)(gbase) + (voff)[_i]), (LAS unsigned*)(lds + (bufoff) + ldsw + _i * 8192), 16, 0, 0); } while (0)
#define PG8_LDA(dst, b, h) do { _Pragma("unroll") for (int m = 0; m < 4; ++m) _Pragma("unroll") for (int k = 0; k < 2; ++k) dst[m][k] = *(const LAS bf16x8*)(lds + PG8_SA(b, h) + aoff + m * 2048 + k * 1024); } while (0)
#define PG8_LDB(dst, b, h) do { _Pragma("unroll") for (int n = 0; n < 2; ++n) _Pragma("unroll") for (int k = 0; k < 2; ++k) dst[n][k] = *(const LAS bf16x8*)(lds + PG8_SB(b, h) + boff + n * 2048 + k * 1024); } while (0)
#define PG8_MMA(ai, bj, At, Bt) do { __builtin_amdgcn_s_setprio(1); _Pragma("unroll") for (int m = 0; m < 4; ++m) _Pragma("unroll") for (int n = 0; n < 2; ++n) _Pragma("unroll") for (int k = 0; k < 2; ++k) \
        acc[ai][bj][m][n] = __builtin_amdgcn_mfma_f32_16x16x32_bf16(Bt[n][k], At[m][k], acc[ai][bj][m][n], 0, 0, 0); __builtin_amdgcn_s_setprio(0); } while (0)
#define PG8_WAIT_V(n) asm volatile("s_waitcnt vmcnt(" #n ")" ::: "memory")
#define PG8_WAIT_VR(rel) do { int r_ = __builtin_amdgcn_readfirstlane(rel); asm volatile("" : "+s"(r_)); asm volatile("s_cmp_lg_u32 %0, 0\n\ts_cbranch_scc1 .Lrxa%=\n\ts_waitcnt vmcnt(8)\n\ts_branch .Lrxb%=\n.Lrxa%=:\n\ts_waitcnt vmcnt(24)\n.Lrxb%=:" :: "s"(r_) : "scc", "memory"); } while (0)
#define PG8_WAIT_L(n) asm volatile("s_waitcnt lgkmcnt(" #n ")" ::: "memory")
#define PG8_BAR __builtin_amdgcn_s_barrier()
#define PG8_SCHED __builtin_amdgcn_sched_barrier(0)
    Unit cur, nxt; int ui = 0;
    if (!S.next(0, cur)) return;
    Acc acc;
#pragma unroll
    for (int a = 0; a < 2; ++a)
#pragma unroll
        for (int b = 0; b < 2; ++b)
#pragma unroll
            for (int m = 0; m < 4; ++m)
#pragma unroll
                for (int n = 0; n < 2; ++n) acc[a][b][m][n] = (f32x4){0.f, 0.f, 0.f, 0.f};
    bf16x8 At[4][2], B0[2][2], B1[2][2];
    const char* cA = P.aptr(cur); const char* cB = P.bptr(cur);
    PG8_STAGE(PG8_SB(0, 0), cB, voffB); PG8_STAGE(PG8_SB(0, 1), cB + hstepB, voffB); PG8_STAGE(PG8_SA(0, 0), cA, voffA); PG8_STAGE(PG8_SA(0, 1), cA + hstepA, voffA);
    if (wr == 1) PG8_BAR;
    PG8_WAIT_V(2); PG8_BAR;
    PG8_STAGE(PG8_SB(1, 0), cB + kstep, voffB); PG8_STAGE(PG8_SA(1, 0), cA + kstep, voffA); PG8_STAGE(PG8_SB(1, 1), cB + hstepB + kstep, voffB);
    PG8_WAIT_V(6); PG8_BAR;
    for (;;) {
        const bool has_next = S.next(ui + 1, nxt);
        const char* nA = has_next ? P.aptr(nxt) : cA; const char* nB = has_next ? P.bptr(nxt) : cB;
        for (int t = 0; t < nt; t += 2) {
            const bool last = (t == nt - 2);
            const char* a1 = cA + (size_t)(t + 1) * kstep;
            const char* a2 = last ? nA : cA + (size_t)(t + 2) * kstep; const char* b2 = last ? nB : cB + (size_t)(t + 2) * kstep;
            const char* a3 = a2 + kstep; const char* b3 = b2 + kstep;
            PG8_LDB(B0, 0, 0); PG8_LDB(B1, 0, 1); PG8_SCHED; PG8_LDA(At, 0, 0); PG8_STAGE(PG8_SA(1, 1), a1 + hstepA, voffA);
            PG8_WAIT_VR((Epi::RELAX && t == 0 && ui > 0) ? 1 : 0); PG8_WAIT_L(0); PG8_BAR; PG8_MMA(0, 0, At, B0); PG8_MMA(0, 1, At, B1); PG8_BAR; PG8_SCHED;
            PG8_LDA(At, 0, 1); PG8_STAGE(PG8_SB(0, 0), b2, voffB); PG8_STAGE(PG8_SB(0, 1), b2 + hstepB, voffB); PG8_STAGE(PG8_SA(0, 0), a2, voffA);
            PG8_WAIT_VR((Epi::RELAX && t == 0 && ui > 0) ? 1 : 0); PG8_WAIT_L(0); PG8_BAR; PG8_MMA(1, 0, At, B0); PG8_MMA(1, 1, At, B1); PG8_BAR; PG8_SCHED;
            PG8_LDB(B0, 1, 0); PG8_LDB(B1, 1, 1); PG8_SCHED; PG8_LDA(At, 1, 0); PG8_STAGE(PG8_SA(0, 1), a2 + hstepA, voffA);
            PG8_WAIT_V(8); PG8_WAIT_L(0); PG8_BAR; PG8_MMA(0, 0, At, B0); PG8_MMA(0, 1, At, B1); PG8_BAR; PG8_SCHED;
            PG8_LDA(At, 1, 1); PG8_STAGE(PG8_SB(1, 0), b3, voffB); PG8_STAGE(PG8_SB(1, 1), b3 + hstepB, voffB); PG8_STAGE(PG8_SA(1, 0), a3, voffA);
            PG8_WAIT_V(8); PG8_WAIT_L(0); PG8_BAR; PG8_MMA(1, 0, At, B0); PG8_MMA(1, 1, At, B1); PG8_BAR; PG8_SCHED;
        }
        if (wr == 0) PG8_BAR;
        E(acc, cur, wr, wc, fr, fq);
        if (!has_next) break;
#pragma unroll
        for (int a = 0; a < 2; ++a)
#pragma unroll
            for (int b = 0; b < 2; ++b)
#pragma unroll
                for (int m = 0; m < 4; ++m)
#pragma unroll
                    for (int n = 0; n < 2; ++n) acc[a][b][m][n] = (f32x4){0.f, 0.f, 0.f, 0.f};
        cur = nxt; cA = nA; cB = nB; ++ui;
        if (wr == 1) PG8_BAR;
    }
    PG8_WAIT_V(0);
    PG8_BAR;
#undef PG8_SA
#undef PG8_SB
#undef PG8_STAGE
#undef PG8_LDA
#undef PG8_LDB
#undef PG8_MMA
#undef PG8_WAIT_V
#undef PG8_WAIT_VR
#undef PG8_WAIT_L
#undef PG8_BAR
#undef PG8_SCHED
}

struct SplitCtx { float* slabs; unsigned* cnt; volatile LAS unsigned* flag; };
struct Piece { int pm, pn, k0, nk, split, slot, uid, rm; };
__device__ __forceinline__ bool piece_of(int N, int K, int G, int c, int split, int coff, Piece& p) {
    const int nN = N / BM, j = (c + coff) % G, un = j / split; p.slot = j % split; p.uid = un; p.pm = 128 + un / nN; p.pn = un % nN; p.nk = K / BK / split; p.k0 = p.slot * p.nk; p.split = split; p.rm = 0;
    return j < 2 * nN * split;
}
__device__ __forceinline__ bool piece_of_mem(int G, int c, int split, int coff, Piece& p) {
    const int j = (c + coff) % G, un = j / split; p.slot = j % split; p.uid = un; p.pm = 128 + (un >> 2); p.pn = un & 3; p.nk = 16 / split; p.k0 = p.slot * p.nk; p.split = split;
    p.rm = split == 4 ? (1 << p.slot) : 0;
    return j < 32 * split;
}
template <class Prob, class Epi>
__device__ __forceinline__ void gemm_piece(LAS unsigned char* lds, const Prob& P, const Epi& E, const Piece pc, const SplitCtx X) {
    int tid_ = threadIdx.x; asm volatile("" : "+v"(tid_));
    const int tid = tid_, wid = __builtin_amdgcn_readfirstlane(tid >> 6), lane = tid & 63, wr = wid >> 2, wc = wid & 3, fr = lane & 15, fq = lane >> 4;
    unsigned voffA[2], voffB[2];
#pragma unroll
    for (int i = 0; i < 2; ++i) { int R, C; stage_rc(tid * 16 + i * 8192, R, C); const int Rb = (R & ~31) + perm32(R & 31);
        voffA[i] = (unsigned)(R * P.lda + C) * 2u; voffB[i] = (unsigned)(Rb * P.ldb + C) * 2u; }
    const size_t kstep = (size_t)(BK * 2);
    const size_t hstepA = (size_t)HALF * P.lda * 2, hstepB = (size_t)HALF * P.ldb * 2;
    const unsigned ldsw = (unsigned)wid * 1024u;
    const int aoff = lds_byte(wr * 64 + fr, fq * 8), boff = lds_byte(wc * 32 + fr, fq * 8);
#define PG8_SA(b, h) (((b) * 2 + (h)) * HTB)
#define PG8_SB(b, h) ((4 + (b) * 2 + (h)) * HTB)
#define PG8_STAGE(bufoff, gbase, voff) do { _Pragma("unroll") for (int _i = 0; _i < 2; ++_i) \
        __builtin_amdgcn_global_load_lds((const unsigned*)((const char*)(gbase) + (voff)[_i]), (LAS unsigned*)(lds + (bufoff) + ldsw + _i * 8192), 16, 0, 0); } while (0)
#define PG8_LDA(dst, b, h) do { _Pragma("unroll") for (int m = 0; m < 4; ++m) _Pragma("unroll") for (int k = 0; k < 2; ++k) dst[m][k] = *(const LAS bf16x8*)(lds + PG8_SA(b, h) + aoff + m * 2048 + k * 1024); } while (0)
#define PG8_LDB(dst, b, h) do { _Pragma("unroll") for (int n = 0; n < 2; ++n) _Pragma("unroll") for (int k = 0; k < 2; ++k) dst[n][k] = *(const LAS bf16x8*)(lds + PG8_SB(b, h) + boff + n * 2048 + k * 1024); } while (0)
#define PG8_MMA(ai, bj, At, Bt) do { __builtin_amdgcn_s_setprio(1); _Pragma("unroll") for (int m = 0; m < 4; ++m) _Pragma("unroll") for (int n = 0; n < 2; ++n) _Pragma("unroll") for (int k = 0; k < 2; ++k) \
        acc[ai][bj][m][n] = __builtin_amdgcn_mfma_f32_16x16x32_bf16(Bt[n][k], At[m][k], acc[ai][bj][m][n], 0, 0, 0); __builtin_amdgcn_s_setprio(0); } while (0)
#define PG8_WAIT_V(n) asm volatile("s_waitcnt vmcnt(" #n ")" ::: "memory")
#define PG8_WAIT_L(n) asm volatile("s_waitcnt lgkmcnt(" #n ")" ::: "memory")
#define PG8_BAR __builtin_amdgcn_s_barrier()
#define PG8_SCHED __builtin_amdgcn_sched_barrier(0)
    Unit cur; cur.pm = pc.pm; cur.pn = pc.pn;
    Acc acc;
#pragma unroll
    for (int a = 0; a < 2; ++a)
#pragma unroll
        for (int b = 0; b < 2; ++b)
#pragma unroll
            for (int m = 0; m < 4; ++m)
#pragma unroll
                for (int n = 0; n < 2; ++n) acc[a][b][m][n] = (f32x4){0.f, 0.f, 0.f, 0.f};
    {
    bf16x8 At[4][2], B0[2][2], B1[2][2];
    const char* cA = P.aptr(cur) + (size_t)pc.k0 * kstep; const char* cB = P.bptr(cur) + (size_t)pc.k0 * kstep;
    PG8_STAGE(PG8_SB(0, 0), cB, voffB); PG8_STAGE(PG8_SB(0, 1), cB + hstepB, voffB); PG8_STAGE(PG8_SA(0, 0), cA, voffA); PG8_STAGE(PG8_SA(0, 1), cA + hstepA, voffA);
    if (wr == 1) PG8_BAR;
    PG8_WAIT_V(2); PG8_BAR;
    PG8_STAGE(PG8_SB(1, 0), cB + kstep, voffB); PG8_STAGE(PG8_SA(1, 0), cA + kstep, voffA); PG8_STAGE(PG8_SB(1, 1), cB + hstepB + kstep, voffB);
    PG8_WAIT_V(6); PG8_BAR;
    const int nt = pc.nk;
    for (int t = 0; t < nt; t += 2) {
        const bool last = (t == nt - 2);
        const char* a1 = cA + (size_t)(t + 1) * kstep;
        const char* a2 = last ? cA : cA + (size_t)(t + 2) * kstep; const char* b2 = last ? cB : cB + (size_t)(t + 2) * kstep;
        const char* a3 = a2 + kstep; const char* b3 = b2 + kstep;
        PG8_LDB(B0, 0, 0); PG8_LDB(B1, 0, 1); PG8_SCHED; PG8_LDA(At, 0, 0); PG8_STAGE(PG8_SA(1, 1), a1 + hstepA, voffA);
        PG8_WAIT_V(8); PG8_WAIT_L(0); PG8_BAR; PG8_MMA(0, 0, At, B0); PG8_MMA(0, 1, At, B1); PG8_BAR; PG8_SCHED;
        PG8_LDA(At, 0, 1); PG8_STAGE(PG8_SB(0, 0), b2, voffB); PG8_STAGE(PG8_SB(0, 1), b2 + hstepB, voffB); PG8_STAGE(PG8_SA(0, 0), a2, voffA);
        PG8_WAIT_V(8); PG8_WAIT_L(0); PG8_BAR; PG8_MMA(1, 0, At, B0); PG8_MMA(1, 1, At, B1); PG8_BAR; PG8_SCHED;
        PG8_LDB(B0, 1, 0); PG8_LDB(B1, 1, 1); PG8_SCHED; PG8_LDA(At, 1, 0); PG8_STAGE(PG8_SA(0, 1), a2 + hstepA, voffA);
        PG8_WAIT_V(8); PG8_WAIT_L(0); PG8_BAR; PG8_MMA(0, 0, At, B0); PG8_MMA(0, 1, At, B1); PG8_BAR; PG8_SCHED;
        PG8_LDA(At, 1, 1); PG8_STAGE(PG8_SB(1, 0), b3, voffB); PG8_STAGE(PG8_SB(1, 1), b3 + hstepB, voffB); PG8_STAGE(PG8_SA(1, 0), a3, voffA);
        PG8_WAIT_V(8); PG8_WAIT_L(0); PG8_BAR; PG8_MMA(1, 0, At, B0); PG8_MMA(1, 1, At, B1); PG8_BAR; PG8_SCHED;
    }
    if (wr == 0) PG8_BAR;
    }
    float* ubase = X.slabs + (size_t)pc.uid * pc.split * 65536;
    const __amdgpu_buffer_rsrc_t rs = __builtin_amdgcn_make_buffer_rsrc((void*)ubase, (short)0, pc.split * 262144, 0x00020000);
    { const int so = pc.slot * 262144;
#pragma unroll
      for (int a = 0; a < 2; ++a)
#pragma unroll
          for (int b = 0; b < 2; ++b)
#pragma unroll
              for (int m = 0; m < 4; ++m)
#pragma unroll
                  for (int n = 0; n < 2; ++n) __builtin_amdgcn_raw_buffer_store_b128(__builtin_bit_cast(u32x4, acc[a][b][m][n]), rs, tid * 16, so + ((((a * 2 + b) * 4 + m) * 2 + n) * 8192), 16); }
    asm volatile("s_waitcnt vmcnt(0)" ::: "memory"); __syncthreads();
    if (tid == 0) { (void)__hip_atomic_fetch_add(X.cnt + pc.uid, 1u, __ATOMIC_RELAXED, __HIP_MEMORY_SCOPE_AGENT);
        unsigned sp = 0u; while (__hip_atomic_load(X.cnt + pc.uid, __ATOMIC_RELAXED, __HIP_MEMORY_SCOPE_AGENT) < (unsigned)pc.split) { __builtin_amdgcn_s_sleep(2); if (++sp > (1u << 22)) break; } }
    __syncthreads();
    const int gsz = 8 / pc.split, g0 = pc.slot * gsz;
    const unsigned rowmask = pc.rm ? (unsigned)pc.rm : ((1u << gsz) - 1u) << g0;
#pragma unroll
    for (int a = 0; a < 2; ++a)
#pragma unroll
        for (int b = 0; b < 2; ++b)
#pragma unroll
            for (int m = 0; m < 4; ++m)
#pragma unroll
                for (int n = 0; n < 2; ++n) acc[a][b][m][n] = (f32x4){0.f, 0.f, 0.f, 0.f};
    int nsp = pc.split; asm volatile("" : "+s"(nsp));
    for (int s = 0; s < nsp; ++s) {
#pragma unroll
        for (int a = 0; a < 2; ++a)
#pragma unroll
            for (int m = 0; m < 4; ++m)
                if ((rowmask >> (a * 4 + m)) & 1u) {
#pragma unroll
                    for (int b = 0; b < 2; ++b)
#pragma unroll
                        for (int n = 0; n < 2; ++n) acc[a][b][m][n] += __builtin_bit_cast(f32x4, __builtin_amdgcn_raw_buffer_load_b128(rs, tid * 16, s * 262144 + ((((a * 2 + b) * 4 + m) * 2 + n) * 8192), 16));
                }
    }
    E(acc, cur, wr, wc, fr, fq, rowmask);
    return;
    E(acc, cur, wr, wc, fr, fq);
#undef PG8_SA
#undef PG8_SB
#undef PG8_STAGE
#undef PG8_LDA
#undef PG8_LDB
#undef PG8_MMA
#undef PG8_WAIT_V
#undef PG8_WAIT_L
#undef PG8_BAR
#undef PG8_SCHED
}
}

constexpr size_t MiB = 1u << 20;
constexpr size_t UB = (size_t)MT * 1024 * 2;
constexpr size_t WS_CTL = 0, CTL_ZERO_BYTES = 64 * 1024;
constexpr size_t WS_TAB = 1 * MiB;
constexpr size_t WS_RSTD0 = 2 * MiB;
constexpr size_t WS_RQ = WS_RSTD0 + 256 * 1024;
constexpr size_t WS_RSTDM = WS_RQ + 256 * 1024;
constexpr size_t WS_ST1 = 3 * MiB;
constexpr size_t WS_ST2 = WS_ST1 + 2304 * 1024;
constexpr size_t WS_ST3 = WS_ST2 + 2304 * 1024;
constexpr size_t WS_W = 12 * MiB;
constexpr size_t WS_WIN = WS_W;
constexpr size_t WS_WCO = WS_WIN + (size_t)NINP * 1024 * 2;
constexpr size_t WS_WUQ = WS_WCO + 2 * MiB;
constexpr size_t WS_WUKV = WS_WUQ + (size_t)QW * 512 * 2;
constexpr size_t WS_WMO = WS_WUKV + (size_t)KVW * 256 * 2;
constexpr size_t WS_WMX = WS_WMO + 2 * MiB;
constexpr size_t WS_WQM = WS_WMX + 2 * MiB;
constexpr size_t WS_WKV = WS_WQM + 2 * MiB;
constexpr size_t WS_WOM = WS_WKV + 4 * MiB;
constexpr size_t WS_WUP = WS_WOM + 2 * MiB;
constexpr size_t WS_WDN = WS_WUP + 8 * MiB;
constexpr size_t WS_WEND = WS_WDN + 8 * MiB;
constexpr size_t WS_MB = 57 * MiB;
constexpr size_t WS_MEMK = 61 * MiB;
constexpr size_t WS_MEMV = 69 * MiB;
constexpr size_t WS_CKVB = 77 * MiB;
constexpr size_t WS_KRB = 98 * MiB;
constexpr size_t WS_R1 = 101 * MiB;
constexpr size_t WS_R2 = WS_R1 + UB;
constexpr size_t WS_R3 = WS_R2 + UB;
constexpr size_t WS_R4 = WS_R3 + UB;
constexpr size_t WS_R5 = WS_R4 + UB / 2;
constexpr size_t WS_R6 = WS_R5 + UB / 4;
constexpr size_t WS_R7 = WS_R6 + UB;
constexpr size_t WS_R8 = WS_R7 + UB;
constexpr size_t WS_END = WS_R8 + (size_t)MT * 32 * 2;
constexpr size_t WS_WP = WS_R2, WS_VP = WS_R2 + 32 * MiB;
static_assert(64 * MiB <= UB, "Wp | Vp fit R2");
constexpr size_t WS_SLAB = 477 * MiB;
static_assert(WS_WEND <= WS_MB && WS_END <= WS_SLAB && WS_SLAB + 32 * MiB <= 512 * MiB, "d_ws map");
static_assert(WS_R2 + (size_t)KVROWS * KVW * 2 <= WS_R5, "kv overlays v | g | cq");
static_assert(WS_R2 + 4 * UB <= 512 * MiB, "hmid");

constexpr size_t OUT_Y = 0;
constexpr size_t OUT_CONVP = (size_t)MT * 1024;
constexpr size_t OUT_CKVP = OUT_CONVP + 16384;
constexpr size_t OUT_KRP = OUT_CKVP + (size_t)MP * 256;
constexpr size_t OUT_MEMK = OUT_KRP + (size_t)MP * 32;
constexpr size_t OUT_MEMV = OUT_MEMK + 2097152;
constexpr size_t OUT_CONVS = OUT_MEMV + 2097152;
constexpr size_t OUT_CKVS = OUT_CONVS + 16384;
constexpr size_t OUT_KRS = OUT_CKVS + (size_t)MS * 256;
constexpr size_t OUT_TOTAL = OUT_KRS + (size_t)MS * 32;

constexpr int RING_OFF = 0, RING_BYTES = 131072;
constexpr int SCR_OFF = RING_BYTES;
constexpr int LDSCTL_OFF = SCR_OFF + 8192, MISC_OFF = LDSCTL_OFF + 320;
constexpr int LDS_BYTES = 147456;
constexpr int NWAVES = 8;

#define XB_TMO      128
#define XB_XCNT(j)  (256  + 64 * (j))
#define XB_XSUB(j)  (1280 + 64 * (j))
#define XB_XGEN(j)  (2304 + 64 * (j))
#define XB_TOP      3328
#define XB_TOPGEN   3392
#define XCD_BAR_WORDS 3456
#define XB_SPIN_CAP (1u << 20)
__device__ __forceinline__ unsigned xb_ld(unsigned* p)              { return __hip_atomic_load(p, __ATOMIC_RELAXED, __HIP_MEMORY_SCOPE_AGENT); }
__device__ __forceinline__ unsigned xb_add(unsigned* p, unsigned v) { return __hip_atomic_fetch_add(p, v, __ATOMIC_RELAXED, __HIP_MEMORY_SCOPE_AGENT); }
__device__ __forceinline__ unsigned xb_xcc_id() { return (unsigned)__builtin_amdgcn_s_getreg((3 << 11) | 20) & 0xFu; }
#define XB_SPIN(cond, bar) do { unsigned _sp = 0; while (cond) { __builtin_amdgcn_s_sleep(1); \
    if ((++_sp & 255u) == 0u) { if (xb_ld(&(bar)[XB_TMO])) break; if (_sp > XB_SPIN_CAP) { atomicAdd(&(bar)[XB_TMO], 1u); break; } } } } while (0)
struct XcdBarrier { unsigned* bar; unsigned x; volatile LAS unsigned* st; };
__device__ __forceinline__ XcdBarrier xcd_barrier_post(unsigned* bar, volatile LAS unsigned* st) {
    XcdBarrier b; b.bar = bar; b.x = xb_xcc_id(); b.st = st;
    if (threadIdx.x == 0) (void)xb_add(&bar[XB_XCNT(b.x)], 1u);
    return b;
}
__device__ __forceinline__ void xcd_barrier_complete(unsigned* bar, unsigned x, unsigned& nloc, unsigned& nx) {
    const unsigned G = gridDim.x * gridDim.y * gridDim.z;
    unsigned sum, cnt, mine, sp = 0u;
    for (;;) {
        sum = 0u; cnt = 0u; mine = 0u;
#pragma unroll
        for (unsigned j = 0; j < 16; ++j) { const unsigned c = xb_ld(&bar[XB_XCNT(j)]); sum += c; cnt += (c > 0u) ? 1u : 0u; mine = (j == x) ? c : mine; }
        if (sum == G) break;
        __builtin_amdgcn_s_sleep(1);
        if ((++sp & 255u) == 0u) { if (xb_ld(&bar[XB_TMO])) break; if (sp > XB_SPIN_CAP) { atomicAdd(&bar[XB_TMO], 1u); break; } }
    }
    nloc = mine > 0u ? mine : 1u; nx = cnt > 0u ? cnt : 1u;
}
__device__ __forceinline__ void xcd_barrier(const XcdBarrier& b) {
    asm volatile("s_waitcnt vmcnt(0)" ::: "memory");
    __syncthreads();
    if (threadIdx.x == 0) {
        unsigned* bar = b.bar;
        __builtin_amdgcn_s_waitcnt(0);
        unsigned nloc = b.st[0], nx = b.st[1];
        if (nloc == 0u) { xcd_barrier_complete(bar, b.x, nloc, nx); b.st[0] = nloc; b.st[1] = nx; }
        const unsigned old = xb_add(&bar[XB_XSUB(b.x)], 1u);
        const unsigned gen = old / nloc;
        if (old + 1u == (gen + 1u) * nloc) {
            __builtin_amdgcn_fence(__ATOMIC_RELEASE, "agent");
            asm volatile("s_waitcnt vmcnt(0)" ::: "memory");
            const unsigned og = xb_add(&bar[XB_TOP], 1u);
            const unsigned tg = og / nx;
            if (og + 1u == (tg + 1u) * nx) xb_add(&bar[XB_TOPGEN], 1u);
            else XB_SPIN(xb_ld(&bar[XB_TOPGEN]) == tg, bar);
            __builtin_amdgcn_fence(__ATOMIC_ACQUIRE, "agent");
            xb_add(&bar[XB_XGEN(b.x)], 1u);
            asm volatile("s_waitcnt vmcnt(0)" ::: "memory");
        } else {
            XB_SPIN(xb_ld(&bar[XB_XGEN(b.x)]) == gen, bar);
            __builtin_amdgcn_fence(__ATOMIC_ACQUIRE, "agent");
            asm volatile("s_waitcnt vmcnt(0)" ::: "memory");
        }
    }
    __syncthreads();
}

namespace pg8 {
#define EPI_ROWS(ai, m) (u.pm * 256 + (ai) * 128 + wr * 64 + (m) * 16 + fr)
#define FOR_AI_M _Pragma("unroll") for (int ai = 0; ai < 2; ++ai) _Pragma("unroll") for (int m = 0; m < 4; ++m) if ((rowmask >> (ai * 4 + m)) & 1u)

struct EpiIn {
    const float* rstd0; bf16_t *v, *Bg, *cq, *ckvraw, *sigc, *siga;
    static constexpr bool RELAX = false;
    static __device__ __forceinline__ void plain(const Acc& acc, bf16_t* dst, int ld, int ai, int m, float rs) {
#pragma unroll
        for (int bj = 0; bj < 2; ++bj) *(u32x4*)(dst + bj * 128) = pack8(acc[ai][bj][m][0] * rs, acc[ai][bj][m][1] * rs);
    }
    static __device__ __forceinline__ void sigm(const Acc& acc, bf16_t* dst, int ai, int m, float rs) {
#pragma unroll
        for (int bj = 0; bj < 2; ++bj) { f32x4 a = acc[ai][bj][m][0] * rs, b = acc[ai][bj][m][1] * rs;
#pragma unroll
            for (int e = 0; e < 4; ++e) { a[e] = fast_sigmoid(a[e]); b[e] = fast_sigmoid(b[e]); }
            *(u32x4*)(dst + bj * 128) = pack8(a, b); }
    }
    __device__ __forceinline__ void operator()(Acc& acc, const Unit& u, int wr, int wc, int fr, int fq, unsigned rowmask = 0xffu) const {
        const int pn = u.pn, cw = wc * 32 + 8 * fq;
        FOR_AI_M {
            const int r = EPI_ROWS(ai, m); const float rs = rstd0[r];
            if (pn < 8) {
                const float rs2 = rs * rs;
                *(u32x4*)(v + (size_t)r * 1024 + pn * 128 + cw) = pack8(acc[ai][0][m][0] * acc[ai][1][m][0] * rs2, acc[ai][0][m][1] * acc[ai][1][m][1] * rs2);
            } else if (pn < 12) { plain(acc, Bg + (size_t)r * 1024 + (pn - 8) * 256 + cw, 1024, ai, m, rs);
            } else if (pn < 14) { plain(acc, cq + (size_t)r * 512 + (pn - 12) * 256 + cw, 512, ai, m, rs);
            } else if (pn < 15) { plain(acc, ckvraw + (size_t)r * 256 + cw, 256, ai, m, rs);
            } else if (pn < 19) { sigm(acc, sigc + (size_t)r * 1024 + (pn - 15) * 256 + cw, ai, m, rs);
            } else { sigm(acc, siga + (size_t)r * 1024 + (pn - 19) * 256 + cw, ai, m, rs); }
        }
    }
};
struct EpiMemKV {
    const float* rstdm; float *outk, *outv; bf16_t *memk, *memv;
    static constexpr bool RELAX = true;
    __device__ __forceinline__ void operator()(Acc& acc, const Unit& u, int wr, int wc, int fr, int fq, unsigned rowmask = 0xffu) const {
        const bool isk = u.pn < 4; const int c0 = (u.pn & 3) * 256 + wc * 32 + 8 * fq; float* out = isk ? outk : outv; bf16_t* cp = isk ? memk : memv;
        FOR_AI_M {
            const int r = EPI_ROWS(ai, m); const float rs = rstdm[r];
#pragma unroll
            for (int bj = 0; bj < 2; ++bj) { const f32x4 a = acc[ai][bj][m][0] * rs, b = acc[ai][bj][m][1] * rs; const size_t off = (size_t)r * 1024 + c0 + bj * 128;
                *(f32x4*)(out + off) = a; *(f32x4*)(out + off + 4) = b; *(u32x4*)(cp + off) = pack8(a, b); }
        }
    }
};
struct EpiGate {
    bf16_t* buf;
    static constexpr bool RELAX = true;
    __device__ __forceinline__ void operator()(Acc& acc, const Unit& u, int wr, int wc, int fr, int fq, unsigned rowmask = 0xffu) const {
        const int c0 = u.pn * 256 + wc * 32 + 8 * fq;
        FOR_AI_M { const int r = EPI_ROWS(ai, m);
#pragma unroll
            for (int bj = 0; bj < 2; ++bj) { bf16_t* p = buf + (size_t)r * 1024 + c0 + bj * 128; f32x4 a, b; unpack8(*(const u32x4*)p, a, b);
                *(u32x4*)p = pack8(a * acc[ai][bj][m][0], b * acc[ai][bj][m][1]); } }
    }
};
struct EpiMix {
    const bf16_t* ya; bf16_t* buf;
    static constexpr bool RELAX = true;
    __device__ __forceinline__ void operator()(Acc& acc, const Unit& u, int wr, int wc, int fr, int fq, unsigned rowmask = 0xffu) const {
        const int c0 = u.pn * 256 + wc * 32 + 8 * fq;
        FOR_AI_M { const int r = EPI_ROWS(ai, m);
#pragma unroll
            for (int bj = 0; bj < 2; ++bj) { const size_t off = (size_t)r * 1024 + c0 + bj * 128; f32x4 a, b, ya0, ya1; unpack8(*(const u32x4*)(buf + off), a, b); unpack8(*(const u32x4*)(ya + off), ya0, ya1);
                *(u32x4*)(buf + off) = pack8(ya0 + a * acc[ai][bj][m][0], ya1 + b * acc[ai][bj][m][1]); } }
    }
};
struct EpiQ {
    const float* rq; const f32x2* tab; bf16_t* q;
    static constexpr bool RELAX = true;
    __device__ __forceinline__ void operator()(Acc& acc, const Unit& u, int wr, int wc, int fr, int fq, unsigned rowmask = 0xffu) const {
        FOR_AI_M {
            const int r = EPI_ROWS(ai, m); const float rs = rq[r];
            const int pos = r < MP ? (r & (SEQ - 1)) : PAST + ((r - MP) & (DSEQ - 1));
#pragma unroll
            for (int bj = 0; bj < 2; ++bj) {
                const int g = u.pn * 8 + bj * 4 + wc;
                f32x4 a = acc[ai][bj][m][0] * rs, b = acc[ai][bj][m][1] * rs;
                if (g % 3 == 2) {
                    const f32x2* t = tab + pos * 16 + 8 * (fq & 1);
                    const float sgn = fq < 2 ? -1.f : 1.f;
#pragma unroll
                    for (int e = 0; e < 4; ++e) { const f32x2 cs0 = t[e], cs1 = t[4 + e];
                        auto ra_ = __builtin_amdgcn_permlane32_swap(__float_as_uint(a[e]), __float_as_uint(a[e]), false, false); auto rb_ = __builtin_amdgcn_permlane32_swap(__float_as_uint(b[e]), __float_as_uint(b[e]), false, false);
                        const float pa = __uint_as_float(fq < 2 ? ra_[1] : ra_[0]), pb = __uint_as_float(fq < 2 ? rb_[1] : rb_[0]);
                        a[e] = a[e] * cs0.x + sgn * pa * cs0.y; b[e] = b[e] * cs1.x + sgn * pb * cs1.y; }
                }
                *(u32x4*)(q + (size_t)r * QW + g * 32 + 8 * fq) = pack8(a * QSCALE, b * QSCALE);
            }
        }
    }
};
struct EpiPlain {
    bf16_t* out; int ld;
    static constexpr bool RELAX = true;
    __device__ __forceinline__ void operator()(Acc& acc, const Unit& u, int wr, int wc, int fr, int fq, unsigned rowmask = 0xffu) const {
        const int c0 = u.pn * 256 + wc * 32 + 8 * fq;
        FOR_AI_M { const int r = EPI_ROWS(ai, m);
#pragma unroll
            for (int bj = 0; bj < 2; ++bj) *(u32x4*)(out + (size_t)r * ld + c0 + bj * 128) = pack8(acc[ai][bj][m][0], acc[ai][bj][m][1]); }
    }
};
struct EpiRes {
    const float* xold_p; const float* xold_s; float* xout; bf16_t* xb; float* stats;
    static constexpr bool RELAX = true;
    __device__ __forceinline__ void operator()(Acc& acc, const Unit& u, int wr, int wc, int fr, int fq, unsigned rowmask = 0xffu) const {
        const int c0 = u.pn * 256 + wc * 32 + 8 * fq;
        FOR_AI_M { const int r = EPI_ROWS(ai, m); const float* xo = r < MP ? xold_p + (size_t)r * 1024 : xold_s + (size_t)(r - MP) * 1024; float ss = 0.f;
#pragma unroll
            for (int bj = 0; bj < 2; ++bj) { const int c = c0 + bj * 128; const f32x4 a = *(const f32x4*)(xo + c) + acc[ai][bj][m][0], b = *(const f32x4*)(xo + c + 4) + acc[ai][bj][m][1];
                if (xout) { *(f32x4*)(xout + (size_t)r * 1024 + c) = a; *(f32x4*)(xout + (size_t)r * 1024 + c + 4) = b; }
                if (xb) *(u32x4*)(xb + (size_t)r * 1024 + c) = pack8(a, b);
                ss += (a[0] * a[0] + a[1] * a[1]) + (a[2] * a[2] + a[3] * a[3]) + (b[0] * b[0] + b[1] * b[1]) + (b[2] * b[2] + b[3] * b[3]); }
            ss += xor32v(ss, fq < 2); ss += shx(ss, 16);
            if (fq == 0) stats[(size_t)r * 16 + u.pn * 4 + wc] = ss; }
    }
};
struct EpiResFinal {
    const float* xold_p; const float* xold_s; float* out; float* stats; unsigned* cnt; const float* gfin; const bf16_t* xb16;
    static constexpr bool RELAX = false;
    __device__ __forceinline__ void operator()(Acc& acc, const Unit& u, int wr, int wc, int fr, int fq, unsigned rowmask = 0xffu) const {
        const int c0 = u.pn * 256 + wc * 32 + 8 * fq;
        FOR_AI_M { const int r = EPI_ROWS(ai, m); const float* xo = r < MP ? xold_p + (size_t)r * 1024 : xold_s + (size_t)(r - MP) * 1024; float ss = 0.f;
#pragma unroll
            for (int bj = 0; bj < 2; ++bj) { const int c = c0 + bj * 128; f32x4 a, b;
                if (xb16) { f32x4 xa, xc; unpack8(*(const u32x4*)(xb16 + (size_t)r * 1024 + c), xa, xc); a = xa + acc[ai][bj][m][0]; b = xc + acc[ai][bj][m][1]; }
                else { a = *(const f32x4*)(xo + c) + acc[ai][bj][m][0]; b = *(const f32x4*)(xo + c + 4) + acc[ai][bj][m][1]; }
                acc[ai][bj][m][0] = a; acc[ai][bj][m][1] = b;
                ss += (a[0] * a[0] + a[1] * a[1]) + (a[2] * a[2] + a[3] * a[3]) + (b[0] * b[0] + b[1] * b[1]) + (b[2] * b[2] + b[3] * b[3]); }
            ss += xor32v(ss, fq < 2); ss += shx(ss, 16);
            if (fq == 0) __hip_atomic_store(stats + (size_t)r * 16 + u.pn * 4 + wc, ss, __ATOMIC_RELAXED, __HIP_MEMORY_SCOPE_AGENT); }
        asm volatile("s_waitcnt vmcnt(0)" ::: "memory"); __builtin_amdgcn_s_barrier(); asm volatile("" ::: "memory");
        if (threadIdx.x == 0) { unsigned* cw = cnt + u.pm * 8 + __builtin_ctz(rowmask);
            (void)__hip_atomic_fetch_add(cw, 1u, __ATOMIC_RELAXED, __HIP_MEMORY_SCOPE_AGENT);
            unsigned sp = 0u; while (__hip_atomic_load(cw, __ATOMIC_RELAXED, __HIP_MEMORY_SCOPE_AGENT) < 4u) { __builtin_amdgcn_s_sleep(2); if (++sp > (1u << 22)) break; } }
        asm volatile("s_waitcnt vmcnt(0)" ::: "memory"); __builtin_amdgcn_s_barrier(); asm volatile("" ::: "memory");
        const __amdgpu_buffer_rsrc_t rs = __builtin_amdgcn_make_buffer_rsrc((void*)stats, (short)0, MT * 64, 0x00020000);
        FOR_AI_M { const int r = EPI_ROWS(ai, m);
            const f32x4 s0 = __builtin_bit_cast(f32x4, __builtin_amdgcn_raw_buffer_load_b128(rs, r * 64, 0, 16)), s1 = __builtin_bit_cast(f32x4, __builtin_amdgcn_raw_buffer_load_b128(rs, r * 64 + 16, 0, 16)),
                        s2 = __builtin_bit_cast(f32x4, __builtin_amdgcn_raw_buffer_load_b128(rs, r * 64 + 32, 0, 16)), s3 = __builtin_bit_cast(f32x4, __builtin_amdgcn_raw_buffer_load_b128(rs, r * 64 + 48, 0, 16));
            const float t = ((s0[0] + s0[1]) + (s0[2] + s0[3])) + ((s1[0] + s1[1]) + (s1[2] + s1[3])) + ((s2[0] + s2[1]) + (s2[2] + s2[3])) + ((s3[0] + s3[1]) + (s3[2] + s3[3]));
            const float rsd = __builtin_amdgcn_rsqf(t * (1.0f / 1024.0f) + EPS);
#pragma unroll
            for (int bj = 0; bj < 2; ++bj) { const int c = c0 + bj * 128; const f32x4 g0 = *(const f32x4*)(gfin + c), g1 = *(const f32x4*)(gfin + c + 4);
                *(f32x4*)(out + (size_t)r * 1024 + c) = acc[ai][bj][m][0] * rsd * g0; *(f32x4*)(out + (size_t)r * 1024 + c + 4) = acc[ai][bj][m][1] * rsd * g1; } }
    }
};
__device__ __forceinline__ float row_rstd(const float* stats, int r) {
    const f32x4* s = (const f32x4*)(stats + (size_t)r * 16); const f32x4 a = s[0], b = s[1], c = s[2], d = s[3];
    const float t = ((a[0] + a[1]) + (a[2] + a[3])) + ((b[0] + b[1]) + (b[2] + b[3])) + ((c[0] + c[1]) + (c[2] + c[3])) + ((d[0] + d[1]) + (d[2] + d[3]));
    return __builtin_amdgcn_rsqf(t * (1.0f / 1024.0f) + EPS);
}
template <int ACT> struct EpiNormAct {
    const float* stats; bf16_t* out; int ld; float scale; unsigned rt, pmt;
    static constexpr bool RELAX = true;
    __device__ __forceinline__ void operator()(Acc& acc, const Unit& u, int wr, int wc, int fr, int fq, unsigned rowmask = 0xffu) const {
        const int c0 = u.pn * 256 + wc * 32 + 8 * fq;
        int slot = -1;
#pragma unroll
        for (int k = 0; k < 8; ++k) slot = (*reinterpret_cast<const LAS int*>(pmt + 4 * k) == u.pm) ? k : slot;
        slot = __builtin_amdgcn_readfirstlane(slot);
        if (slot >= 0) {
            const LAS float* rp = reinterpret_cast<const LAS float*>(rt + (unsigned)(slot * 256 + wr * 64 + fr) * 4u);
            FOR_AI_M { const int r = EPI_ROWS(ai, m); const float rs = rp[ai * 128 + m * 16] * scale;
#pragma unroll
                for (int bj = 0; bj < 2; ++bj) { f32x4 a = acc[ai][bj][m][0] * rs, b = acc[ai][bj][m][1] * rs;
                    if (ACT == 1) {
#pragma unroll
                        for (int e = 0; e < 4; ++e) { const float x = fmaxf(a[e], 0.f), y = fmaxf(b[e], 0.f); a[e] = x * x; b[e] = y * y; } }
                    *(u32x4*)(out + (size_t)r * ld + c0 + bj * 128) = pack8(a, b); } }
        } else {
            FOR_AI_M { const int r = EPI_ROWS(ai, m); const float rs = row_rstd(stats, r) * scale;
#pragma unroll
                for (int bj = 0; bj < 2; ++bj) { f32x4 a = acc[ai][bj][m][0] * rs, b = acc[ai][bj][m][1] * rs;
                    if (ACT == 1) {
#pragma unroll
                        for (int e = 0; e < 4; ++e) { const float x = fmaxf(a[e], 0.f), y = fmaxf(b[e], 0.f); a[e] = x * x; b[e] = y * y; } }
                    *(u32x4*)(out + (size_t)r * ld + c0 + bj * 128) = pack8(a, b); } }
        }
    }
};

__device__ __forceinline__ int ma_row0(int pm) { return pm < 128 ? pm * 256 : MP + (pm - 128) * DSEQ; }
__device__ __forceinline__ int ma_batch(int pm) { return pm < 128 ? pm >> 4 : 8 + (pm - 128); }
struct ProbMA {
    const bf16_t* A; const bf16_t* W; int K, lda, ldb;
    __device__ __forceinline__ const char* aptr(const Unit& u) const { return (const char*)(A + (size_t)ma_row0(u.pm) * 1024); }
    __device__ __forceinline__ const char* bptr(const Unit& u) const { return (const char*)(W + ((size_t)ma_batch(u.pm) * 1024 + u.pn * 256) * 1024); }
};
struct PreOrder {
    int G, c, lo, hi;
    __device__ __forceinline__ bool next(int i, Unit& u) const { const int L = lo + i * G + c; u.pm = L >> 2; u.pn = L & 3; return c >= 0 && c < G && L < hi; }
};
struct ProbWp {
    const bf16_t* memk; const bf16_t* wqg; int K, lda, ldb;
    __device__ __forceinline__ const char* aptr(const Unit& u) const { return (const char*)(memk + (size_t)((u.pm >> 2) * 256) * 1024 + (u.pm & 3) * 256); }
    __device__ __forceinline__ const char* bptr(const Unit& u) const { return (const char*)(wqg + (size_t)(u.pn * 256) * 1024 + (u.pm & 3) * 256); }
};
struct ProbVp {
    const bf16_t* womt; const bf16_t* memv; int K, lda, ldb;
    __device__ __forceinline__ const char* aptr(const Unit& u) const { return (const char*)(womt + (size_t)((u.pm & 3) * 256) * 1024 + u.pn * 256); }
    __device__ __forceinline__ const char* bptr(const Unit& u) const { return (const char*)(memv + (size_t)((u.pm >> 2) * 256) * 1024 + u.pn * 256); }
};
struct EpiSoftmaxS {
    const float* stats; float scale; bf16_t* P; LAS float* scr; unsigned rt, pmt;
    static constexpr bool RELAX = false;
    __device__ __forceinline__ void operator()(Acc& acc, const Unit& u, int wr, int wc, int fr, int fq, unsigned rowmask = 0xffu) const {
        const int row0 = ma_row0(u.pm), valid = u.pm < 128 ? 256 : DSEQ;
        int slot = -1;
#pragma unroll
        for (int k = 0; k < 8; ++k) slot = (*reinterpret_cast<const LAS int*>(pmt + 4 * k) == u.pm) ? k : slot;
        slot = __builtin_amdgcn_readfirstlane(slot);
        const LAS float* rp = reinterpret_cast<const LAS float*>(rt + (unsigned)((slot < 0 ? 0 : slot) * 256) * 4u);
        FOR_AI_M { const int lr = ai * 128 + wr * 64 + m * 16 + fr; const int rr = row0 + lr < MT ? row0 + lr : MT - 1; const float rs = (slot >= 0 ? rp[lr] : row_rstd(stats, rr)) * scale; float mx = -3.0e38f;
#pragma unroll
            for (int bj = 0; bj < 2; ++bj)
#pragma unroll
                for (int n = 0; n < 2; ++n) { acc[ai][bj][m][n] = acc[ai][bj][m][n] * rs;
#pragma unroll
                    for (int e = 0; e < 4; ++e) mx = fmaxf(mx, acc[ai][bj][m][n][e]); }
            mx = fmaxf(mx, xor32v(mx, fq < 2)); mx = fmaxf(mx, shx(mx, 16)); float sm = 0.f;
#pragma unroll
            for (int bj = 0; bj < 2; ++bj)
#pragma unroll
                for (int n = 0; n < 2; ++n)
#pragma unroll
                    for (int e = 0; e < 4; ++e) { const float p = __builtin_amdgcn_exp2f(acc[ai][bj][m][n][e] - mx); acc[ai][bj][m][n][e] = p; sm += p; }
            sm += xor32v(sm, fq < 2); sm += shx(sm, 16);
            if (fq == 0) { scr[lr * 4 + wc] = mx; scr[1024 + lr * 4 + wc] = sm; } }
        asm volatile("s_waitcnt lgkmcnt(0)" ::: "memory"); __builtin_amdgcn_s_barrier(); asm volatile("" ::: "memory");
        FOR_AI_M { const int lr = ai * 128 + wr * 64 + m * 16 + fr; const f32x4 q = *(const LAS f32x4*)(scr + lr * 4), s4 = *(const LAS f32x4*)(scr + 1024 + lr * 4);
            const float M = fmaxf(fmaxf(q[0], q[1]), fmaxf(q[2], q[3]));
            const float tot = (s4[0] * __builtin_amdgcn_exp2f(q[0] - M) + s4[1] * __builtin_amdgcn_exp2f(q[1] - M)) + (s4[2] * __builtin_amdgcn_exp2f(q[2] - M) + s4[3] * __builtin_amdgcn_exp2f(q[3] - M));
            const float mo = wc == 0 ? q[0] : (wc == 1 ? q[1] : (wc == 2 ? q[2] : q[3]));
            const float inv = __builtin_amdgcn_exp2f(mo - M) * __builtin_amdgcn_rcpf(tot);
            if (lr < valid) {
#pragma unroll
                for (int bj = 0; bj < 2; ++bj) *(u32x4*)(P + (size_t)(row0 + lr) * 1024 + u.pn * 256 + bj * 128 + wc * 32 + 8 * fq) = pack8(acc[ai][bj][m][0] * inv, acc[ai][bj][m][1] * inv); } }
    }
};
struct EpiResM {
    float* x; bf16_t* xb; float* stats;
    static constexpr bool RELAX = false;
    __device__ __forceinline__ void operator()(Acc& acc, const Unit& u, int wr, int wc, int fr, int fq, unsigned rowmask = 0xffu) const {
        const int row0 = ma_row0(u.pm), valid = u.pm < 128 ? 256 : DSEQ; const int c0 = u.pn * 256 + wc * 32 + 8 * fq;
        FOR_AI_M { const int lr = ai * 128 + wr * 64 + m * 16 + fr; const bool ok = lr < valid; const int r = ok ? row0 + lr : row0; float ss = 0.f;
#pragma unroll
            for (int bj = 0; bj < 2; ++bj) { const int c = c0 + bj * 128; f32x4 a, b;
                if (x) { float* xr = x + (size_t)r * 1024; a = *(const f32x4*)(xr + c) + acc[ai][bj][m][0]; b = *(const f32x4*)(xr + c + 4) + acc[ai][bj][m][1];
                         if (ok) { *(f32x4*)(xr + c) = a; *(f32x4*)(xr + c + 4) = b; } }
                else { f32x4 xa, xc; unpack8(*(const u32x4*)(xb + (size_t)r * 1024 + c), xa, xc); a = xa + acc[ai][bj][m][0]; b = xc + acc[ai][bj][m][1]; }
                if (ok) *(u32x4*)(xb + (size_t)r * 1024 + c) = pack8(a, b);
                ss += (a[0] * a[0] + a[1] * a[1]) + (a[2] * a[2] + a[3] * a[3]) + (b[0] * b[0] + b[1] * b[1]) + (b[2] * b[2] + b[3] * b[3]); }
            ss += xor32v(ss, fq < 2); ss += shx(ss, 16);
            if (fq == 0 && ok) stats[(size_t)r * 16 + u.pn * 4 + wc] = ss; }
    }
};
#undef EPI_ROWS
#undef FOR_AI_M
}

namespace attn {
constexpr int NSLOT = 4, NOPE_B = 0, ROPE_B = NSLOT * 8192, V_B = ROPE_B + NSLOT * 4096;
constexpr int QR_OFF = V_B + NSLOT * 8192;
__device__ __forceinline__ void glds16(const void* sbase, unsigned voff, unsigned lds_dst) { unsigned keep;
    asm volatile("s_mov_b32 %0, m0\n\ts_mov_b32 m0, %3\n\ts_nop 0\n\tglobal_load_lds_dwordx4 %1, %2\n\ts_mov_b32 m0, %0" : "=&s"(keep) : "v"(voff), "s"(sbase), "s"(lds_dst) : "memory"); }
__device__ __forceinline__ s16x4 vtr(const LAS unsigned char* p) { return __builtin_bit_cast(s16x4, __builtin_amdgcn_ds_read_tr16_b64_v4i16((LAS s16x4*)p)); }
struct Unit { int qrow0, kvrow0, h, ntiles, lim_base, lim_step, nwq; };

__device__ __forceinline__ float row_max32(const f32x16& p0, const f32x16& p1) {
    float a = fmaxf(fmaxf(p0[0], p0[1]), p1[0]), b = fmaxf(fmaxf(p0[2], p0[3]), p1[1]); a = fmaxf(fmaxf(a, p1[2]), p1[3]);
#pragma unroll
    for (int r = 4; r < 16; r += 4) { a = fmaxf(fmaxf(a, p0[r]), p0[r + 1]); b = fmaxf(fmaxf(b, p0[r + 2]), p0[r + 3]); a = fmaxf(fmaxf(a, p1[r]), p1[r + 1]); b = fmaxf(fmaxf(b, p1[r + 2]), p1[r + 3]); }
    const float m = fmaxf(a, b);
    auto rr = __builtin_amdgcn_permlane32_swap(__float_as_uint(m), __float_as_uint(m), false, false);
    return fmaxf(__uint_as_float(rr[0]), __uint_as_float(rr[1]));
}
__device__ __forceinline__ void kfrag(bf16x8& a0, bf16x8& a1, int d0, const unsigned (&ka)[6], int ko) {
    if (d0 < 4) { a0 = *reinterpret_cast<const LAS bf16x8*>(ka[d0] + ko); a1 = *reinterpret_cast<const LAS bf16x8*>(ka[d0] + ko + 32 * 128); }
    else { a0 = *reinterpret_cast<const LAS bf16x8*>(ka[d0] + (ko >> 1)); a1 = *reinterpret_cast<const LAS bf16x8*>(ka[d0] + (ko >> 1) + 32 * 64); }
}
struct NoDma { __device__ __forceinline__ void operator()() const {} };
template <bool DO_QK, class Dma = NoDma>
__device__ __forceinline__ void step(f32x16& pn0, f32x16& pn1, f32x16& pc0, f32x16& pc1, f32x16& o0, f32x16& o1, float& lrun, const bf16x8 qmf, const bf16x8 kneg,
                                     const unsigned (&ka)[6], int ko, const LAS unsigned char* vb, const bf16x8 (&qf)[4], const LAS unsigned char* qr, const Dma& dma = Dma()) {
    bf16x8 fa[2][2];
    if (DO_QK) kfrag(fa[0][0], fa[0][1], 0, ka, ko);
    __builtin_amdgcn_s_setprio(1);
#pragma unroll
    for (int d0 = 0; d0 < 6; ++d0) {
        if (DO_QK) {
            if (d0 + 1 < 6) kfrag(fa[(d0 + 1) & 1][0], fa[(d0 + 1) & 1][1], d0 + 1, ka, ko);
            const bf16x8 qd = d0 < 4 ? qf[d0 < 4 ? d0 : 0] : *(const LAS bf16x8*)(qr + (d0 - 4) * 16);
            if (d0 == 0) { const f32x16 z = {}; pn0 = __builtin_amdgcn_mfma_f32_32x32x16_bf16(fa[0][0], qd, z, 0, 0, 0); pn1 = __builtin_amdgcn_mfma_f32_32x32x16_bf16(fa[0][1], qd, z, 0, 0, 0); }
            else { pn0 = __builtin_amdgcn_mfma_f32_32x32x16_bf16(fa[d0 & 1][0], qd, pn0, 0, 0, 0); pn1 = __builtin_amdgcn_mfma_f32_32x32x16_bf16(fa[d0 & 1][1], qd, pn1, 0, 0, 0); }
        }
        if (d0 == 1) dma();
#pragma unroll
        for (int r = (16 * d0) / 6; r < (16 * (d0 + 1)) / 6; ++r) { pc0[r] = __builtin_amdgcn_exp2f(pc0[r]); pc1[r] = __builtin_amdgcn_exp2f(pc1[r]); }
        asm volatile("" ::: "memory");
    }
    if (DO_QK) {
        pn0 = __builtin_amdgcn_mfma_f32_32x32x16_bf16(kneg, qmf, pn0, 0, 0, 0); pn1 = __builtin_amdgcn_mfma_f32_32x32x16_bf16(kneg, qmf, pn1, 0, 0, 0); }
    { float one = 1.0f; asm volatile("" : "+s"(one));
      float sa = pc0[0], sb = pc1[0];
#pragma unroll
      for (int r = 1; r < 16; ++r) { sa = sa + pc0[r]; sb = __builtin_fmaf(pc1[r], one, sb); }
      lrun += sa + sb; }
    u32x4 pw[4];
    pw[0] = (u32x4){cvt_pk_bf16(pc0[0], pc0[1]), cvt_pk_bf16(pc0[2], pc0[3]), cvt_pk_bf16(pc0[4], pc0[5]), cvt_pk_bf16(pc0[6], pc0[7])};
    pw[1] = (u32x4){cvt_pk_bf16(pc0[8], pc0[9]), cvt_pk_bf16(pc0[10], pc0[11]), cvt_pk_bf16(pc0[12], pc0[13]), cvt_pk_bf16(pc0[14], pc0[15])};
    pw[2] = (u32x4){cvt_pk_bf16(pc1[0], pc1[1]), cvt_pk_bf16(pc1[2], pc1[3]), cvt_pk_bf16(pc1[4], pc1[5]), cvt_pk_bf16(pc1[6], pc1[7])};
    pw[3] = (u32x4){cvt_pk_bf16(pc1[8], pc1[9]), cvt_pk_bf16(pc1[10], pc1[11]), cvt_pk_bf16(pc1[12], pc1[13]), cvt_pk_bf16(pc1[14], pc1[15])};
    s16x4 vl[2][4];
    vl[0][0] = vtr(vb); vl[0][1] = vtr(vb + 512); vl[0][2] = vtr(vb + 4096); vl[0][3] = vtr(vb + 4096 + 512);
#pragma unroll
    for (int ks = 0; ks < 4; ++ks) {
        if (ks + 1 < 4) { const int n = (ks + 1) & 1; vl[n][0] = vtr(vb + (ks + 1) * 1024); vl[n][1] = vtr(vb + (ks + 1) * 1024 + 512); vl[n][2] = vtr(vb + 4096 + (ks + 1) * 1024); vl[n][3] = vtr(vb + 4096 + (ks + 1) * 1024 + 512); }
        const int c = ks & 1; const bf16x8 pb = __builtin_bit_cast(bf16x8, pw[ks]);
        const bf16x8 v0 = (bf16x8){vl[c][0][0], vl[c][0][1], vl[c][0][2], vl[c][0][3], vl[c][1][0], vl[c][1][1], vl[c][1][2], vl[c][1][3]};
        const bf16x8 v1 = (bf16x8){vl[c][2][0], vl[c][2][1], vl[c][2][2], vl[c][2][3], vl[c][3][0], vl[c][3][1], vl[c][3][2], vl[c][3][3]};
        o0 = __builtin_amdgcn_mfma_f32_32x32x16_bf16(v0, pb, o0, 0, 0, 0);
        o1 = __builtin_amdgcn_mfma_f32_32x32x16_bf16(v1, pb, o1, 0, 0, 0);
        asm volatile("" ::: "memory");
    }
    __builtin_amdgcn_s_setprio(0);
}
__device__ __forceinline__ bf16x8 mfrag(float m, int hi) {
    const unsigned h = cvt_pk_bf16(m, 0.f) & 0xffffu; const float mh = __builtin_bit_cast(float, h << 16); const unsigned l = cvt_pk_bf16(m - mh, 0.f) & 0xffffu;
    const unsigned w = hi ? 0u : (h | (l << 16));
    return __builtin_bit_cast(bf16x8, (u32x4){w, 0u, 0u, 0u});
}
constexpr float ATT_BIG = 1099511627776.0f;
__device__ __forceinline__ void rebase(f32x16& p0, f32x16& p1, f32x16& o0, f32x16& o1, float& lrun, float& mrun, bf16x8& qmf, int hi) {
    if (__builtin_amdgcn_ballot_w64(lrun > ATT_BIG) != 0ull) {
        auto rr = __builtin_amdgcn_permlane32_swap(__float_as_uint(lrun), __float_as_uint(lrun), false, false);
        const float lt = __uint_as_float(rr[0]) + __uint_as_float(rr[1]);
        const int e = __builtin_amdgcn_frexp_expf(lt) - 1;
        const int d = e > 0 ? e : 0; const float delta = (float)d, alpha = __builtin_amdgcn_ldexpf(1.0f, -d); mrun += delta; lrun *= alpha; qmf = mfrag(mrun, hi);
#pragma unroll
        for (int r = 0; r < 16; ++r) { p0[r] -= delta; p1[r] -= delta; o0[r] *= alpha; o1[r] *= alpha; }
    }
}
__device__ __forceinline__ void unit(const Unit& U, const bf16_t* __restrict__ Q, const bf16_t* __restrict__ KV, const bf16_t* __restrict__ KR, bf16_t* __restrict__ O, LAS unsigned char* lds) {
    int tid_ = threadIdx.x; asm volatile("" : "+v"(tid_));
    const int tid = tid_, lane = tid & 63, r32 = lane & 31, hi = lane >> 5; const int wid = __builtin_amdgcn_readfirstlane(tid >> 6);
    const bool active = wid < U.nwq; const int mylim = active ? U.lim_base + (wid >> 1) * U.lim_step : 0;
    const int nr = wid * 8 + (lane >> 3), rr = wid * 8 + ((lane & 31) >> 2), vr = 16 * (wid & 3) + (lane >> 2);
    const unsigned voffN = (unsigned)(((U.kvrow0 + nr) * KVW + U.h * 128 + 8 * ((lane & 7) ^ ((nr >> 1) & 7))) * 2);
    const unsigned voffR = (unsigned)(((U.kvrow0 + rr) * 32 + 8 * ((lane & 3) ^ ((rr >> 2) & 3))) * 2);
    const unsigned voffV = (unsigned)(((U.kvrow0 + vr) * KVW + U.h * 128 + 64 + (wid >> 2) * 32 + 8 * (lane & 3)) * 2);
    const unsigned lds0 = (unsigned)(size_t)lds;
#define ATT_DMAS(t, s) do { if (wid < 4) { const char* kvb_ = (const char*)KV + (size_t)(t) * (64 * KVW * 2); const char* krb_ = (const char*)KR + (size_t)(t) * (64 * 32 * 2); \
          \
          \
        glds16(kvb_, voffN, (unsigned)__builtin_amdgcn_readfirstlane(lds0 + NOPE_B + (s) * 8192 + wid * 1024)); \
        glds16(kvb_ + 32 * KVW * 2, voffN, (unsigned)__builtin_amdgcn_readfirstlane(lds0 + NOPE_B + (s) * 8192 + (wid + 4) * 1024)); \
        glds16(kvb_, voffV, (unsigned)__builtin_amdgcn_readfirstlane(lds0 + V_B + (s) * 8192 + wid * 1024)); \
        glds16(kvb_ + 64, voffV, (unsigned)__builtin_amdgcn_readfirstlane(lds0 + V_B + (s) * 8192 + (wid + 4) * 1024)); \
        if (lane < 32) { glds16(krb_, voffR, (unsigned)__builtin_amdgcn_readfirstlane(lds0 + ROPE_B + (s) * 4096 + wid * 512)); \
                         glds16(krb_ + 32 * 64, voffR, (unsigned)__builtin_amdgcn_readfirstlane(lds0 + ROPE_B + (s) * 4096 + (wid + 4) * 512)); } } } while (0)
#define ATT_DMA(t) ATT_DMAS(t, (t) & 3)
    ATT_DMA(0); ATT_DMA(1); ATT_DMA(2);
    bf16x8 qf[4], qr4 = (bf16x8){0, 0, 0, 0, 0, 0, 0, 0}, qr5 = qr4;
    if (active) {
        const bf16_t* qp = Q + (size_t)(U.qrow0 + wid * 32 + r32) * QW + U.h * 96 + hi * 8;
#pragma unroll
        for (int d0 = 0; d0 < 4; ++d0) qf[d0] = *(const bf16x8*)(qp + d0 * 16);
        qr4 = *(const bf16x8*)(qp + 64); qr5 = *(const bf16x8*)(qp + 80);
    } else {
#pragma unroll
        for (int d0 = 0; d0 < 4; ++d0) qf[d0] = (bf16x8){0, 0, 0, 0, 0, 0, 0, 0};
    }
    const LAS unsigned char* qr = lds + QR_OFF + tid * 32;
    *(LAS bf16x8*)(lds + QR_OFF + tid * 32) = qr4; *(LAS bf16x8*)(lds + QR_OFF + tid * 32 + 16) = qr5;
    float mrun = 0.f, lrun = 0.f; f32x16 o0 = {}, o1 = {}, pA0 = {}, pA1 = {}, pB0 = {}, pB1 = {};
    bf16x8 qmf = (bf16x8){0, 0, 0, 0, 0, 0, 0, 0}; const bf16x8 kneg = __builtin_bit_cast(bf16x8, (u32x4){hi ? 0u : 0xBF80BF80u, 0u, 0u, 0u});
    unsigned ka[6];
    { const int xn = ((r32 >> 1) & 7) << 4, xr = ((r32 >> 2) & 3) << 4, hb = hi << 4;
#pragma unroll
      for (int d0 = 0; d0 < 6; ++d0) { unsigned a_ = d0 < 4 ? lds0 + NOPE_B + r32 * 128 + ((d0 * 32 + hb) ^ xn) : lds0 + ROPE_B + r32 * 64 + (((d0 - 4) * 32 + hb) ^ xr); asm volatile("" : "+v"(a_)); ka[d0] = a_; } }
    const int vfo = V_B + (4 * hi + ((lane & 15) >> 2)) * 64 + ((lane >> 4) & 1) * 32 + (lane & 3) * 8;
#define ATT_HEADX(t) do { asm volatile("s_waitcnt vmcnt(6) lgkmcnt(0)\n\ts_barrier" ::: "memory"); ATT_DMA((t) + 3); } while (0)
#define ATT_HEAD(t) do { if ((t) + 2 < U.ntiles) asm volatile("s_waitcnt vmcnt(6) lgkmcnt(0)\n\ts_barrier" ::: "memory"); else asm volatile("s_waitcnt vmcnt(0) lgkmcnt(0)\n\ts_barrier" ::: "memory"); \
        if ((t) + 3 < U.ntiles) ATT_DMA((t) + 3); } while (0)
#define ATT_FULLS(PC0, PC1, PN0, PN1, s0, s1) do { \
        step<true>(PN0, PN1, PC0, PC1, o0, o1, lrun, qmf, kneg, ka, (s1) * 8192, lds + (s0) * 8192 + vfo, qf, qr); rebase(PN0, PN1, o0, o1, lrun, mrun, qmf, hi); } while (0)
#define ATT_BARX asm volatile("s_waitcnt vmcnt(6) lgkmcnt(0)\n\ts_barrier" ::: "memory")
#define ATT_FULLD(PC0, PC1, PN0, PN1, s0, s1, td, sd) do { auto dma_ = [&]() { ATT_DMAS(td, sd); }; \
        step<true>(PN0, PN1, PC0, PC1, o0, o1, lrun, qmf, kneg, ka, (s1) * 8192, lds + (s0) * 8192 + vfo, qf, qr, dma_); rebase(PN0, PN1, o0, o1, lrun, mrun, qmf, hi); } while (0)
#define ATT_FULL(PC0, PC1, PN0, PN1, j) ATT_FULLS(PC0, PC1, PN0, PN1, (j) & 3, ((j) + 1) & 3)
#define ATT_LAST(PC0, PC1, PN0, PN1, j) do { const int s0_ = (j) & 3; \
        step<false>(PN0, PN1, PC0, PC1, o0, o1, lrun, qmf, kneg, ka, 0, lds + s0_ * 8192 + vfo, qf, qr); } while (0)
#define ATT_HEADS(t, s) do { asm volatile("s_waitcnt vmcnt(6) lgkmcnt(0)\n\ts_barrier" ::: "memory"); ATT_DMAS((t) + 3, s); } while (0)
    ATT_HEAD(0);
    int j = 1;
    if (0 < mylim) {
        {
#pragma unroll
            for (int d0 = 0; d0 < 6; ++d0) { bf16x8 a0_, a1_; kfrag(a0_, a1_, d0, ka, 0); const bf16x8 qd_ = d0 < 4 ? qf[d0 < 4 ? d0 : 0] : (d0 == 4 ? qr4 : qr5);
                pA0 = __builtin_amdgcn_mfma_f32_32x32x16_bf16(a0_, qd_, pA0, 0, 0, 0); pA1 = __builtin_amdgcn_mfma_f32_32x32x16_bf16(a1_, qd_, pA1, 0, 0, 0); }
            mrun = row_max32(pA0, pA1); qmf = mfrag(mrun, hi);
#pragma unroll
            for (int r_ = 0; r_ < 16; ++r_) { pA0[r_] -= mrun; pA1[r_] -= mrun; }
        }
        j = 0;
        while (j + 4 < mylim && j + 7 < U.ntiles) {
            ATT_FULLS(pA0, pA1, pB0, pB1, 0, 1); ATT_BARX; ATT_FULLD(pB0, pB1, pA0, pA1, 1, 2, j + 4, 0); ATT_BARX;
            ATT_FULLD(pA0, pA1, pB0, pB1, 2, 3, j + 5, 1); ATT_BARX; ATT_FULLD(pB0, pB1, pA0, pA1, 3, 0, j + 6, 2); ATT_HEADS(j + 4, 3); j += 4; }
        while (j + 2 < mylim && j + 5 < U.ntiles) { ATT_FULL(pA0, pA1, pB0, pB1, j); ATT_HEADX(j + 1); ATT_FULL(pB0, pB1, pA0, pA1, j + 1); ATT_HEADX(j + 2); j += 2; }
        while (j + 2 < mylim) { ATT_FULL(pA0, pA1, pB0, pB1, j); ATT_HEAD(j + 1); ATT_FULL(pB0, pB1, pA0, pA1, j + 1); ATT_HEAD(j + 2); j += 2; }
        if (j + 1 < mylim) { ATT_FULL(pA0, pA1, pB0, pB1, j); ATT_HEAD(j + 1); ATT_LAST(pB0, pB1, pA0, pA1, j + 1); j += 2; }
        else { ATT_LAST(pA0, pA1, pB0, pB1, j); j += 1; }
    }
    for (; j < U.ntiles; ++j) ATT_HEAD(j);
#undef ATT_HEADX
#undef ATT_HEAD
#undef ATT_FULL
#undef ATT_LAST
#undef ATT_FULLS
#undef ATT_FULLD
#undef ATT_BARX
#undef ATT_HEADS
#undef ATT_DMAS
#undef ATT_DMA
    asm volatile("s_waitcnt vmcnt(0) lgkmcnt(0)\n\ts_barrier" ::: "memory");
    if (active) {
        const float lt = lrun + shx(lrun, 32), inv = __builtin_amdgcn_rcpf(lt);
        bf16_t* op = O + (size_t)(U.qrow0 + wid * 32 + r32) * 1024 + U.h * 64 + 8 * hi;
#pragma unroll
        for (int dh = 0; dh < 2; ++dh) {
            const f32x16& oo = dh ? o1 : o0;
#pragma unroll
            for (int g = 0; g < 4; g += 2) {
                const unsigned a0 = cvt_pk_bf16(oo[4 * g] * inv, oo[4 * g + 1] * inv), a1 = cvt_pk_bf16(oo[4 * g + 2] * inv, oo[4 * g + 3] * inv);
                const unsigned b0 = cvt_pk_bf16(oo[4 * g + 4] * inv, oo[4 * g + 5] * inv), b1 = cvt_pk_bf16(oo[4 * g + 6] * inv, oo[4 * g + 7] * inv);
                auto s0 = __builtin_amdgcn_permlane32_swap(a0, b0, false, false); auto s1 = __builtin_amdgcn_permlane32_swap(a1, b1, false, false);
                *(u32x4*)(op + dh * 32 + 8 * g) = (u32x4){s0[0], s1[0], s0[1], s1[1]};
            }
        }
    }
}
__device__ __forceinline__ void phase(int vcu, int G, const bf16_t* Q, const bf16_t* KV, const bf16_t* KR, bf16_t* O, LAS unsigned char* lds) {
    for (int w = vcu; w < 256; w += G) {
        const int g = w >> 3, s = w & 7;
        for (int rnd = 0; rnd < 4; ++rnd) {
            const int bh = g + 32 * rnd, b = bh >> 4, h = bh & 15;
            int qlong, qshort;
            if (rnd < 2) { if (s < 4) { qlong = 15 - 2 * s; qshort = 2 * s + 1; } else { qlong = 14 - 2 * (s - 4); qshort = 2 * (s - 4); } }
            else { qlong = 15 - s; qshort = s; }
            for (int k = 0; k < 2; ++k) {
                const int qb = k ? qshort : qlong;
                Unit U; U.qrow0 = b * SEQ + qb * 256; U.kvrow0 = b * SEQ; U.h = h; U.ntiles = 4 * qb + 4; U.lim_base = 4 * qb + 1; U.lim_step = 1; U.nwq = 8;
                unit(U, Q, KV, KR, O, lds);
            }
        }
        if (s >= 4) {
            const int su = g * 4 + (s - 4), b = su >> 4, h = su & 15;
            Unit U; U.qrow0 = MP + b * DSEQ; U.kvrow0 = MP + b * KVS; U.h = h; U.ntiles = KVS / 64; U.lim_base = KVS / 64; U.lim_step = 0; U.nwq = 2;
            unit(U, Q, KV, KR, O, lds);
        }
    }
}
}

struct Args { const float* in[28]; float* out; unsigned char* ws; int ph_lo, ph_hi; };

__device__ __forceinline__ unsigned f2bf(float f) { unsigned u = __builtin_bit_cast(unsigned, f); return (u + 0x7fffu + ((u >> 16) & 1u)) >> 16; }
__device__ __forceinline__ unsigned pk2(float lo, float hi) { return f2bf(lo) | (f2bf(hi) << 16); }

__device__ __forceinline__ void transpose_item(const float* W, int N, const float* gain, bf16_t* WT, size_t ldw, int coff, int k0, int n0, int drow0, LAS float* scr, int lane) {
    float wv[32];
#pragma unroll
    for (int i = 0; i < 32; ++i) wv[i] = W[(size_t)(k0 + 2 * i + (lane >> 5)) * N + n0 + (lane & 31)];
    if (gain) {
#pragma unroll
        for (int i = 0; i < 32; ++i) wv[i] *= gain[k0 + 2 * i + (lane >> 5)];
    }
#pragma unroll
    for (int i = 0; i < 32; ++i) scr[(2 * i + (lane >> 5)) * 33 + (lane & 31)] = wv[i];
    asm volatile("s_waitcnt lgkmcnt(0)" ::: "memory");
    const int c = lane & 7;
#pragma unroll
    for (int j = 0; j < 4; ++j) { const int n = (lane >> 3) + 8 * j; const LAS float* s = scr + (8 * c) * 33 + n;
        u32x4 o; o.x = pk2(s[0 * 33], s[1 * 33]); o.y = pk2(s[2 * 33], s[3 * 33]); o.z = pk2(s[4 * 33], s[5 * 33]); o.w = pk2(s[6 * 33], s[7 * 33]);
        *(u32x4*)(WT + (size_t)(drow0 + n) * ldw + coff + k0 + 8 * c) = o; }
    asm volatile("s_waitcnt lgkmcnt(0)" ::: "memory");
}
__device__ __forceinline__ int win_row(int n0) {
    if (n0 < 1024) return (n0 >> 7) * 256 + (n0 & 127);
    if (n0 < 2048) return 2048 + (n0 - 1024);
    if (n0 < 3072) { const int j = n0 - 2048; return (j >> 7) * 256 + 128 + (j & 127); }
    if (n0 < 3840) return n0;
    if (n0 < 3872) return 5888 + (n0 - 3840);
    return n0 - 32;
}

__device__ __forceinline__ void rope_cs(int pos, int i, float& c, float& s) {
    float iv = 1.0f;
    iv = (i == 1) ? 0.5623413324356079f : iv;
    iv = (i == 2) ? 0.3162277638912201f : iv;
    iv = (i == 3) ? 0.17782793939113617f : iv;
    iv = (i == 4) ? 0.10000000149011612f : iv;
    iv = (i == 5) ? 0.05623413249850273f : iv;
    iv = (i == 6) ? 0.03162277489900589f : iv;
    iv = (i == 7) ? 0.017782794311642647f : iv;
    iv = (i == 8) ? 0.009999999776482582f : iv;
    iv = (i == 9) ? 0.005623413249850273f : iv;
    iv = (i == 10) ? 0.003162277629598975f : iv;
    iv = (i == 11) ? 0.0017782794311642647f : iv;
    iv = (i == 12) ? 0.0010000000474974513f : iv;
    iv = (i == 13) ? 0.000562341301701963f : iv;
    iv = (i == 14) ? 0.0003162277571391314f : iv;
    iv = (i == 15) ? 0.00017782794020604342f : iv;
    const float ang = (float)pos * iv;
    const float n = rintf(ang * 0.15915494309189535f);
    float r = fmaf(-n, 6.2831854820251465f, ang); r = fmaf(-n, -1.7484555e-7f, r);
    c = __cosf(r); s = __sinf(r);
}

__global__ void __launch_bounds__(NWAVES * 64, 2) fwd_kernel(Args args) {
    extern __shared__ __attribute__((aligned(16))) unsigned char lds_raw[];
    LAS unsigned char* lds = (LAS unsigned char*)lds_raw;
    volatile LAS unsigned* MISC = (volatile LAS unsigned*)(lds + MISC_OFF);
    const int wave = __builtin_amdgcn_readfirstlane((int)threadIdx.x >> 6);
    const int G = gridDim.x; const int bx = blockIdx.x; const int vcu = (G % 8 == 0) ? (bx % 8) * (G / 8) + bx / 8 : bx;
    unsigned char* ws = args.ws; float* out = args.out;
    unsigned* ctl = (unsigned*)(ws + WS_CTL);
    for (int u = threadIdx.x; u < (LDS_BYTES - LDSCTL_OFF) / 4; u += NWAVES * 64) ((LAS unsigned*)(lds + LDSCTL_OFF))[u] = 0u;
    __syncthreads();
    const int lo = args.ph_lo, hi = args.ph_hi;
    const bool multi = (hi - lo) > 1;
    XcdBarrier bar; bar.bar = ctl; bar.x = 0; bar.st = nullptr;
    if (multi) bar = xcd_barrier_post(ctl, MISC + 8);
#define IN(k) (({ asm volatile("" : "+s"(kp)); }), (lo <= (k) && (k) < hi))
#define TID_LANE int tid = threadIdx.x; asm volatile("" : "+v"(tid)); const int lane = tid & 63;
#define SEAM(k) do { if (IN(k) && IN((k) + 1)) xcd_barrier(bar); } while (0)
    const int gw = vcu * NWAVES + wave, NGW = G * NWAVES;

    const __attribute__((address_space(4))) unsigned char* kp = (const __attribute__((address_space(4))) unsigned char*)__builtin_amdgcn_kernarg_segment_ptr();
#define KIN(k) (((const float* const __attribute__((address_space(4)))*)kp)[k])
#define x_prompt KIN(0)
#define x_sample KIN(1)
#define cache_conv KIN(2)
#define cache_ckv KIN(3)
#define cache_krope KIN(4)
#define cache_mem_k KIN(5)
#define cache_mem_v KIN(6)
#define mem_prompt KIN(7)
#define g_mix KIN(8)
#define w_in KIN(9)
#define w_conv KIN(10)
#define w_conv_out KIN(11)
#define g_q KIN(12)
#define w_uq KIN(13)
#define g_kv KIN(14)
#define w_ukv KIN(15)
#define w_mla_out KIN(16)
#define w_mix_out KIN(17)
#define g_mem_q KIN(18)
#define g_mem_kv KIN(19)
#define w_qm KIN(20)
#define w_km KIN(21)
#define w_vm KIN(22)
#define w_om KIN(23)
#define g_mlp KIN(24)
#define w_up KIN(25)
#define w_down KIN(26)
#define g_final KIN(27)
    f32x2* tab = (f32x2*)(ws + WS_TAB);
    float* rstd0 = (float*)(ws + WS_RSTD0); float* rq = (float*)(ws + WS_RQ); float* rstdm = (float*)(ws + WS_RSTDM);
    float* st1 = (float*)(ws + WS_ST1); float* st2 = (float*)(ws + WS_ST2); float* st3 = (float*)(ws + WS_ST3);
    bf16_t* Win_t = (bf16_t*)(ws + WS_WIN); bf16_t* Wco_t = (bf16_t*)(ws + WS_WCO); bf16_t* Wuq_t = (bf16_t*)(ws + WS_WUQ); bf16_t* Wukv_t = (bf16_t*)(ws + WS_WUKV);
    bf16_t* Wmo_t = (bf16_t*)(ws + WS_WMO); bf16_t* Wmx_t = (bf16_t*)(ws + WS_WMX); bf16_t* Wqm_g = (bf16_t*)(ws + WS_WQM); bf16_t* Wkv_t = (bf16_t*)(ws + WS_WKV);
    bf16_t* Wom_t = (bf16_t*)(ws + WS_WOM); bf16_t* Wup_t = (bf16_t*)(ws + WS_WUP); bf16_t* Wdn_t = (bf16_t*)(ws + WS_WDN);
    bf16_t* mb = (bf16_t*)(ws + WS_MB); bf16_t* memk = (bf16_t*)(ws + WS_MEMK); bf16_t* memv = (bf16_t*)(ws + WS_MEMV); bf16_t* Wp = (bf16_t*)(ws + WS_WP); bf16_t* Vp = (bf16_t*)(ws + WS_VP);
    bf16_t* ckvb = (bf16_t*)(ws + WS_CKVB); bf16_t* krb = (bf16_t*)(ws + WS_KRB);
    bf16_t* R1 = (bf16_t*)(ws + WS_R1); bf16_t* R2 = (bf16_t*)(ws + WS_R2); bf16_t* R3 = (bf16_t*)(ws + WS_R3); bf16_t* R4 = (bf16_t*)(ws + WS_R4);
    bf16_t* R5 = (bf16_t*)(ws + WS_R5); bf16_t* R6 = (bf16_t*)(ws + WS_R6); bf16_t* R7 = (bf16_t*)(ws + WS_R7); bf16_t* R8 = (bf16_t*)(ws + WS_R8);
    float* slabs = (float*)(ws + WS_SLAB);
    bf16_t* cqb = (bf16_t*)out + (size_t)MT * QW;
    bf16_t* qbuf = (bf16_t*)out;

    if (IN(0)) { TID_LANE
        { constexpr int WKP = 1032; LAS unsigned short* wk = (LAS unsigned short*)(lds + RING_OFF);
          for (int k = tid; k < 1024; k += NWAVES * 64) { const float gk = g_mix[k]; const float* src = w_in + (size_t)k * NIN + 3840;
#pragma unroll
              for (int j4 = 0; j4 < 8; ++j4) { const f32x4 v = *(const f32x4*)(src + 4 * j4) * gk;
#pragma unroll
                  for (int e = 0; e < 4; ++e) wk[(4 * j4 + e) * WKP + k] = (unsigned short)(cvt_pk_bf16(v[e], 0.f) & 0xffffu); } }
          __syncthreads();
          const int rr = lane & 15, q = lane >> 4;
          const LAS unsigned char* wkb = lds + RING_OFF + (rr * WKP + 8 * q) * 2;
          f32x4 acc0, acc1; float ss;
#define P0_LOAD4(A, src, kc) do { _Pragma("unroll") for (int u = 0; u < 4; ++u) { A[u][0] = *(const f32x4*)((src) + 32 * ((kc) + u)); A[u][1] = *(const f32x4*)((src) + 32 * ((kc) + u) + 4); } } while (0)
#define P0_PROC4(A, dst, kc) do { _Pragma("unroll") for (int u = 0; u < 4; ++u) { \
              ss += (A[u][0][0] * A[u][0][0] + A[u][0][1] * A[u][0][1]) + (A[u][0][2] * A[u][0][2] + A[u][0][3] * A[u][0][3]) + (A[u][1][0] * A[u][1][0] + A[u][1][1] * A[u][1][1]) + (A[u][1][2] * A[u][1][2] + A[u][1][3] * A[u][1][3]); \
              const u32x4 pk = pack8(A[u][0], A[u][1]); *(u32x4*)((dst) + 32 * ((kc) + u)) = pk; const bf16x8 af = __builtin_bit_cast(bf16x8, pk); \
              const bf16x8 b0 = *(const LAS bf16x8*)(wkb + ((kc) + u) * 64), b1 = *(const LAS bf16x8*)(wkb + 16 * WKP * 2 + ((kc) + u) * 64); \
              acc0 = __builtin_amdgcn_mfma_f32_16x16x32_bf16(af, b0, acc0, 0, 0, 0); acc1 = __builtin_amdgcn_mfma_f32_16x16x32_bf16(af, b1, acc1, 0, 0, 0); } } while (0)
#define P0_FINISH(R0) do { ss += shx(ss, 16); ss += shx(ss, 32); const float rs = 1.0f / sqrtf(ss * (1.0f / 1024.0f) + EPS); if (q == 0) rstd0[(R0) + rr] = rs; \
              _Pragma("unroll") for (int e = 0; e < 4; ++e) { const float rse = __builtin_bit_cast(float, __builtin_amdgcn_ds_bpermute((4 * q + e) << 2, __builtin_bit_cast(int, rs))); \
                  unsigned short* kp = (unsigned short*)R8 + (size_t)((R0) + 4 * q + e) * 32 + rr; \
                  kp[0] = (unsigned short)(cvt_pk_bf16(acc0[e] * rse, 0.f) & 0xffffu); kp[16] = (unsigned short)(cvt_pk_bf16(acc1[e] * rse, 0.f) & 0xffffu); } } while (0)
          for (int bi = gw; bi < MP / 16; bi += NGW) {
              const int R0 = bi * 16; const float* src = x_prompt + (size_t)(R0 + rr) * 1024 + 8 * q; bf16_t* dst = R1 + (size_t)(R0 + rr) * 1024 + 8 * q;
              acc0 = (f32x4){0.f, 0.f, 0.f, 0.f}; acc1 = acc0; ss = 0.f;
              f32x4 a[3][4][2]; P0_LOAD4(a[0], src, 0); P0_LOAD4(a[1], src, 4);
#pragma unroll
              for (int it = 0; it < 8; ++it) { if (it + 2 < 8) P0_LOAD4(a[(it + 2) % 3], src, 4 * (it + 2)); P0_PROC4(a[it % 3], dst, 4 * it); }
              P0_FINISH(R0);
          }
          { LAS float* part = (LAS float*)(lds + RING_OFF + 73728);
            for (int sb = vcu; sb < MS / 16; sb += G) {
              const int R0 = MP + sb * 16; const float* src = x_sample + (size_t)(sb * 16 + rr) * 1024 + 8 * q; bf16_t* dst = R1 + (size_t)(R0 + rr) * 1024 + 8 * q;
              acc0 = (f32x4){0.f, 0.f, 0.f, 0.f}; acc1 = acc0; ss = 0.f;
              f32x4 a[4][2]; P0_LOAD4(a, src, 4 * wave); P0_PROC4(a, dst, 4 * wave);
              LAS float* mine = part + (wave * 9) * 64 + lane;
              mine[0] = ss;
#pragma unroll
              for (int e = 0; e < 4; ++e) { mine[(1 + e) * 64] = acc0[e]; mine[(5 + e) * 64] = acc1[e]; }
              __syncthreads();
              if (wave == 0) {
                  ss = 0.f; acc0 = (f32x4){0.f, 0.f, 0.f, 0.f}; acc1 = acc0;
                  for (int w = 0; w < NWAVES; ++w) { const LAS float* o = part + (w * 9) * 64 + lane; ss += o[0];
#pragma unroll
                      for (int e = 0; e < 4; ++e) { acc0[e] += o[(1 + e) * 64]; acc1[e] += o[(5 + e) * 64]; } }
                  P0_FINISH(R0);
              }
              __syncthreads();
            } }
#undef P0_LOAD4
#undef P0_PROC4
#undef P0_FINISH
          __syncthreads();
        }
        LAS float* scr = (LAS float*)(lds + RING_OFF + wave * 16384);
        int it = gw;
#define WJ(W, K, N, gain, dst, ldw, coff, mode) do { const int nblk = (N) / 32, nitems = ((K) / 64) * nblk; \
            for (; it < nitems; it += NGW) { const int kb = it / nblk, nb = it % nblk, n0 = nb * 32; transpose_item(W, N, gain, dst, (size_t)(ldw), coff, kb * 64, n0, (mode) ? win_row(n0) : n0, scr, lane); } \
            it -= nitems; } while (0)
        WJ(w_in, 1024, NIN, g_mix, Win_t, 1024, 0, 1);
        WJ(w_conv_out, 1024, 1024, (const float*)nullptr, Wco_t, 1024, 0, 0);
        WJ(w_uq, 512, QW, g_q, Wuq_t, 512, 0, 0);
        WJ(w_ukv, 256, KVW, (const float*)nullptr, Wukv_t, 256, 0, 0);
        WJ(w_mla_out, 1024, 1024, (const float*)nullptr, Wmo_t, 1024, 0, 0);
        WJ(w_mix_out, 1024, 1024, (const float*)nullptr, Wmx_t, 1024, 0, 0);
        WJ(w_km, 1024, 1024, g_mem_kv, Wkv_t, 1024, 0, 0);
        WJ(w_vm, 1024, 1024, g_mem_kv, Wkv_t + (size_t)1024 * 1024, 1024, 0, 0);
        WJ(w_om, 1024, 1024, (const float*)nullptr, Wom_t, 1024, 0, 0);
        WJ(w_up, 1024, DFF, g_mlp, Wup_t, 1024, 0, 0);
        WJ(w_down, DFF, 1024, (const float*)nullptr, Wdn_t, DFF, 0, 0);
#undef WJ
        for (int r = MT + gw; r < MT + 2048; r += NGW) {
            const float* src = r < MP ? x_prompt + (size_t)r * 1024 : (r < MT ? x_sample + (size_t)(r - MP) * 1024 : mem_prompt + (size_t)(r - MT) * 1024);
            bf16_t* dst = r < MT ? R1 + (size_t)r * 1024 : mb + (size_t)(r - MT) * 1024;
            f32x4 v[4]; float s = 0.f;
#pragma unroll
            for (int j = 0; j < 4; ++j) { v[j] = *(const f32x4*)(src + 256 * j + 4 * lane); s += (v[j][0] * v[j][0] + v[j][1] * v[j][1]) + (v[j][2] * v[j][2] + v[j][3] * v[j][3]); }
            s = wave_sum(s); const float rs = 1.0f / sqrtf(s * (1.0f / 1024.0f) + EPS);
            if (lane == 0) { if (r < MT) rstd0[r] = rs; else rstdm[r - MT] = rs; }
#pragma unroll
            for (int j = 0; j < 4; ++j) *(u32x2*)(dst + 256 * j + 4 * lane) = (u32x2){cvt_pk_bf16(v[j][0], v[j][1]), cvt_pk_bf16(v[j][2], v[j][3])};
        }
        for (int i = gw * 64 + lane; i < NB * PAST * 256 / 8; i += NGW * 64) { const int e = i * 8, row = e >> 8, c = e & 255, b = row >> 10, t = row & 1023;
            const f32x4 a = *(const f32x4*)(cache_ckv + e), bb = *(const f32x4*)(cache_ckv + e + 4); *(u32x4*)(ckvb + (size_t)(MP + b * KVS + t) * 256 + c) = pack8(a, bb); }
        for (int i = gw * 64 + lane; i < NB * PAST * 32 / 8; i += NGW * 64) { const int e = i * 8, row = e >> 5, c = e & 31, b = row >> 10, t = row & 1023;
            const f32x4 a = *(const f32x4*)(cache_krope + e), bb = *(const f32x4*)(cache_krope + e + 4); *(u32x4*)(krb + (size_t)(MP + b * KVS + t) * 32 + c) = pack8(a, bb); }
        for (int i = gw * 64 + lane; i < 2048 * 1024 / 8; i += NGW * 64) { const size_t e = (size_t)i * 8;
            const f32x4 a = *(const f32x4*)(cache_mem_k + e), bb = *(const f32x4*)(cache_mem_k + e + 4); *(u32x4*)(memk + (size_t)2048 * 1024 + e) = pack8(a, bb); }
        for (int i = gw * 64 + lane; i < 2048 * 1024 / 8; i += NGW * 64) { const size_t e = (size_t)i * 8;
            const f32x4 a = *(const f32x4*)(cache_mem_v + e), bb = *(const f32x4*)(cache_mem_v + e + 4); *(u32x4*)(memv + (size_t)2048 * 1024 + e) = pack8(a, bb); }
        for (int i = gw * 64 + lane; i < 1024 * 1024 / 8; i += NGW * 64) { const size_t e = (size_t)i * 8; const float gk = g_mem_q[e >> 10];
            const f32x4 a = *(const f32x4*)(w_qm + e) * gk, bb = *(const f32x4*)(w_qm + e + 4) * gk; *(u32x4*)(Wqm_g + e) = pack8(a, bb); }
        for (int i = gw * 64 + lane; i < SEQ * 16; i += NGW * 64) { float c, s; rope_cs(i >> 4, i & 15, c, s); tab[i] = (f32x2){c, s}; }
    }
    SEAM(0);

    if (IN(1)) {
        { pg8::Dense P{R1, Win_t, 1024, 1024, 1024}; pg8::StaticOrder S; S.init(MP, NIN1, G, bx);
          pg8::EpiIn E{rstd0, R2, R3, cqb, R5, R6, R7}; pg8::gemm_phase(lds + RING_OFF, P, S, E);
          { pg8::Piece pc; if (pg8::piece_of(NIN1, 1024, G, bx, 2, 128, pc)) pg8::gemm_piece(lds + RING_OFF, P, E, pc, pg8::SplitCtx{out + OUT_Y, ctl + 4096, MISC + 16}); } }
        if (G != 256) { pg8::Dense P{mb, Wkv_t, 1024, 1024, 1024}; pg8::StaticOrder S; S.init(2048, 2048, G, (bx + G - 96) % G);
          pg8::EpiMemKV E{rstdm, out + OUT_MEMK, out + OUT_MEMV, memk, memv}; pg8::gemm_phase(lds + RING_OFF, P, S, E); }
    }
    SEAM(1);

    if (IN(2)) {
        const bool kvcu = G == 256 && (vcu & 31) < 8;
        if (kvcu) { pg8::Dense P{mb, Wkv_t, 1024, 1024, 1024}; pg8::StaticOrder S; S.init(2048, 2048, 64, (vcu >> 5) * 8 + (vcu & 31));
            pg8::EpiMemKV E{rstdm, out + OUT_MEMK, out + OUT_MEMV, memk, memv}; pg8::gemm_phase(lds + RING_OFF, P, S, E); }
        TID_LANE
        int h0, h1, nh;
        if (G == 256) { nh = 3584; if (kvcu) { h0 = 3072 + ((vcu >> 5) * 8 + (vcu & 31)) * NWAVES + wave; h1 = h0 + 1; } else { h0 = 2 * (((vcu >> 5) * 24 + (vcu & 31) - 8) * NWAVES + wave); h1 = h0 + 2; } }
        else { nh = G * NWAVES; h0 = vcu * NWAVES + wave; h1 = h0 + 1; }
        const int rbeg = (int)(((long)h0 * MT) / nh), rend = (int)(((long)h1 * MT) / nh);
        f32x4 wc_[2][6];
#pragma unroll
        for (int hh = 0; hh < 2; ++hh) { const int c = hh * 512 + lane * 8;
#pragma unroll
            for (int k = 0; k < 3; ++k) { wc_[hh][2 * k] = *(const f32x4*)(w_conv + k * 1024 + c); wc_[hh][2 * k + 1] = *(const f32x4*)(w_conv + k * 1024 + c + 4); } }
        const f32x4 gkv = *(const f32x4*)(g_kv + lane * 4);
        f32x4 p1[2][2] = {}, p2[2][2] = {};
        u32x4 cv[2], cb[2], ccq; u32x2 cck; unsigned short ckr;
#define P2_LOAD(r_, V, B, CQ, CK, KR) do { _Pragma("unroll") for (int hh = 0; hh < 2; ++hh) { V[hh] = *(const u32x4*)(R2 + (size_t)(r_) * 1024 + hh * 512 + lane * 8); B[hh] = *(const u32x4*)(R3 + (size_t)(r_) * 1024 + hh * 512 + lane * 8); } \
            CQ = *(const u32x4*)(cqb + (size_t)(r_) * 512 + lane * 8); CK = *(const u32x2*)(R5 + (size_t)(r_) * 256 + lane * 4); KR = R8[(size_t)(r_) * 32 + (lane & 31)]; } while (0)
        if (rbeg < rend) {
            P2_LOAD(rbeg, cv, cb, ccq, cck, ckr);
            { const bool isP = rbeg < MP; const int rr = isP ? rbeg : rbeg - MP; const int b = isP ? rr >> 12 : rr >> 6, t = isP ? rr & (SEQ - 1) : rr & (DSEQ - 1);
#pragma unroll
              for (int hh = 0; hh < 2; ++hh) { const int c = hh * 512 + lane * 8;
                  if (t >= 1) unpack8(*(const u32x4*)(R2 + (size_t)(rbeg - 1) * 1024 + c), p1[hh][0], p1[hh][1]);
                  else if (!isP) { p1[hh][0] = *(const f32x4*)(cache_conv + (size_t)(b * 2 + 1) * 1024 + c); p1[hh][1] = *(const f32x4*)(cache_conv + (size_t)(b * 2 + 1) * 1024 + c + 4); }
                  if (t >= 2) unpack8(*(const u32x4*)(R2 + (size_t)(rbeg - 2) * 1024 + c), p2[hh][0], p2[hh][1]);
                  else if (!isP) { p2[hh][0] = *(const f32x4*)(cache_conv + (size_t)(b * 2 + t) * 1024 + c); p2[hh][1] = *(const f32x4*)(cache_conv + (size_t)(b * 2 + t) * 1024 + c + 4); } } }
        }
        for (int r = rbeg; r < rend; ++r) {
            u32x4 nv[2], nb[2], ncq; u32x2 nck; unsigned short nkr;
            const int rn = r + 1 < rend ? r + 1 : r;
            P2_LOAD(rn, nv, nb, ncq, nck, nkr);
            const bool isP = r < MP; const int rr = isP ? r : r - MP; const int b = isP ? rr >> 12 : rr >> 6, t = isP ? rr & (SEQ - 1) : rr & (DSEQ - 1), T = isP ? SEQ : DSEQ;
            const int kvrow = isP ? r : MP + b * KVS + PAST + t, pos = isP ? t : PAST + t;
            float* oconv = out + (isP ? OUT_CONVP : OUT_CONVS); float* ockv = out + (isP ? OUT_CKVP : OUT_CKVS); float* okr = out + (isP ? OUT_KRP : OUT_KRS);
            if (t == 0) {
#pragma unroll
                for (int hh = 0; hh < 2; ++hh) { const int c = hh * 512 + lane * 8;
                    if (isP) { p1[hh][0] = p1[hh][1] = p2[hh][0] = p2[hh][1] = (f32x4){0.f, 0.f, 0.f, 0.f}; }
                    else { p1[hh][0] = *(const f32x4*)(cache_conv + (size_t)(b * 2 + 1) * 1024 + c); p1[hh][1] = *(const f32x4*)(cache_conv + (size_t)(b * 2 + 1) * 1024 + c + 4);
                           p2[hh][0] = *(const f32x4*)(cache_conv + (size_t)(b * 2) * 1024 + c); p2[hh][1] = *(const f32x4*)(cache_conv + (size_t)(b * 2) * 1024 + c + 4); } }
            }
#pragma unroll
            for (int hh = 0; hh < 2; ++hh) {
                const int c = hh * 512 + lane * 8;
                f32x4 v0a, v0b, ba, bb; unpack8(cv[hh], v0a, v0b); unpack8(cb[hh], ba, bb);
                const f32x4 ga = ba * (wc_[hh][0] * p2[hh][0] + wc_[hh][2] * p1[hh][0] + wc_[hh][4] * v0a), gb = bb * (wc_[hh][1] * p2[hh][1] + wc_[hh][3] * p1[hh][1] + wc_[hh][5] * v0b);
                *(u32x4*)(R1 + (size_t)r * 1024 + c) = pack8(ga, gb);
                if (t >= T - 2) { float* o = oconv + (size_t)(b * 2 + (t - (T - 2))) * 1024 + c; *(f32x4*)o = v0a; *(f32x4*)(o + 4) = v0b; }
                p2[hh][0] = p1[hh][0]; p2[hh][1] = p1[hh][1]; p1[hh][0] = v0a; p1[hh][1] = v0b;
            }
            f32x4 qa, qb; unpack8(ccq, qa, qb);
            float s1 = (qa[0] * qa[0] + qa[1] * qa[1]) + (qa[2] * qa[2] + qa[3] * qa[3]) + (qb[0] * qb[0] + qb[1] * qb[1]) + (qb[2] * qb[2] + qb[3] * qb[3]);
            f32x4 ka = (f32x4){bf_lo(cck.x), bf_hi(cck.x), bf_lo(cck.y), bf_hi(cck.y)};
            float s2 = (ka[0] * ka[0] + ka[1] * ka[1]) + (ka[2] * ka[2] + ka[3] * ka[3]);
#pragma unroll
            for (int o = 1; o < 64; o <<= 1) { s1 += shx(s1, o); s2 += shx(s2, o); }
            if (lane == 0) rq[r] = 1.0f / sqrtf(s1 * (1.0f / 512.0f) + EPS);
            { const float rs = 1.0f / sqrtf(s2 * (1.0f / 256.0f) + EPS); ka = ka * rs * gkv;
              *(f32x4*)(ockv + (size_t)rr * 256 + lane * 4) = ka; *(u32x2*)(ckvb + (size_t)kvrow * 256 + lane * 4) = (u32x2){cvt_pk_bf16(ka[0], ka[1]), cvt_pk_bf16(ka[2], ka[3])}; }
            { const int i = lane & 31; const float xv = __builtin_bit_cast(float, (unsigned)ckr << 16);
              const float pv = shx(xv, 16); const f32x2 cs = tab[pos * 16 + (i & 15)];
              const float o = (i < 16) ? xv * cs.x - pv * cs.y : xv * cs.x + pv * cs.y;
              if (lane < 32) { okr[(size_t)rr * 32 + i] = o; krb[(size_t)kvrow * 32 + i] = (bf16_t)f2bf(o); } }
#pragma unroll
            for (int hh = 0; hh < 2; ++hh) { cv[hh] = nv[hh]; cb[hh] = nb[hh]; }
            ccq = ncq; cck = nck; ckr = nkr;
        }
#undef P2_LOAD
    }
    SEAM(2);

    if (IN(3)) {
        { pg8::Dense P{R1, Wco_t, 1024, 1024, 1024}; pg8::StaticOrder S; S.init(MP, 1024, G, bx);
          pg8::EpiGate E{R6}; pg8::gemm_phase(lds + RING_OFF, P, S, E);
          { pg8::Piece pc; if (pg8::piece_of(1024, 1024, G, bx, 4, 0, pc)) pg8::gemm_piece(lds + RING_OFF, P, E, pc, pg8::SplitCtx{slabs, ctl + 4096 + 64, MISC + 16}); } }
        { pg8::Dense P{cqb, Wuq_t, 512, 512, 512}; pg8::StaticOrder S; S.init(MP, QW, G, bx);
          pg8::EpiQ E{rq, tab, qbuf}; pg8::gemm_phase(lds + RING_OFF, P, S, E);
          { pg8::Piece pc; if (pg8::piece_of(QW, 512, G, bx, 2, 128, pc)) pg8::gemm_piece(lds + RING_OFF, P, E, pc, pg8::SplitCtx{slabs + (size_t)32 * 65536, ctl + 4096 + 128, MISC + 16}); } }
        { pg8::Dense P{ckvb, Wukv_t, 256, 256, 256}; pg8::StaticOrder S; S.init(KVROWS, KVW, G, (bx + 64) % G);
          pg8::EpiPlain E{R2, KVW}; pg8::gemm_phase(lds + RING_OFF, P, S, E); }
    }
    SEAM(3);

    if (IN(5)) attn::phase(vcu, G, qbuf, R2, krb, R1, lds + RING_OFF);
    SEAM(5);

    if (IN(6)) {
        pg8::Dense P{R1, Wmo_t, 1024, 1024, 1024}; pg8::StaticOrder S; S.init(MP, 1024, G, bx);
        pg8::EpiMix E{R6, R7}; pg8::gemm_phase(lds + RING_OFF, P, S, E);
          { pg8::Piece pc; if (pg8::piece_of(1024, 1024, G, bx, 4, 0, pc)) pg8::gemm_piece(lds + RING_OFF, P, E, pc, pg8::SplitCtx{slabs, ctl + 4096 + 192, MISC + 16}); }
        { pg8::ProbWp Pw{memk, Wqm_g, 256, 1024, 1024}; pg8::PreOrder So{G - 32, (int)bx - 32, 0, G == 256 ? 192 : 256}; pg8::EpiPlain Ew{Wp, 1024}; pg8::gemm_phase(lds + RING_OFF, Pw, So, Ew); }
    }
    SEAM(6);

    if (IN(7)) {
        pg8::Dense P{R7, Wmx_t, 1024, 1024, 1024}; pg8::StaticOrder S; S.init(MP, 1024, G, bx);
        pg8::EpiRes E{x_prompt, x_sample, G == 256 ? (float*)nullptr : out + OUT_Y, R1, st1}; pg8::gemm_phase(lds + RING_OFF, P, S, E);
          { pg8::Piece pc; if (pg8::piece_of(1024, 1024, G, bx, 4, 0, pc)) pg8::gemm_piece(lds + RING_OFF, P, E, pc, pg8::SplitCtx{slabs, ctl + 4096 + 256, MISC + 16}); }
        if (G == 256) {
            { pg8::ProbWp Pw{memk, Wqm_g, 256, 1024, 1024}; pg8::PreOrder So{64, (int)bx - 32, 192, 256}; pg8::EpiPlain Ew{Wp, 1024}; pg8::gemm_phase(lds + RING_OFF, Pw, So, Ew); }
            { pg8::ProbVp Pv{Wom_t, memv, 256, 1024, 1024}; pg8::PreOrder So{128, (int)bx - 96, 0, 128}; pg8::EpiPlain Ev{Vp, 1024}; pg8::gemm_phase(lds + RING_OFF, Pv, So, Ev); }
        } else { pg8::ProbVp Pv{Wom_t, memv, 256, 1024, 1024}; pg8::PreOrder So{G - 32, (int)bx - 32, 0, 256}; pg8::EpiPlain Ev{Vp, 1024}; pg8::gemm_phase(lds + RING_OFF, Pv, So, Ev); }
    }
    SEAM(7);

    if (IN(8)) {
        pg8::ProbMA P{R1, Wp, 1024, 1024, 1024}; pg8::StaticOrder S; S.init(MP, 1024, G, bx);
        LAS float* rt8 = (LAS float*)(lds + MISC_OFF + 512); LAS int* pmt8 = (LAS int*)(lds + MISC_OFF + 256);
        { TID_LANE (void)lane;
          if (tid == 0) { int n = 0;
              for (int i = 0; ; ++i) { const int pmi = S.pm_of(i); if (pmi < 0) break; bool seen = false; for (int k = 0; k < n; ++k) seen = seen || (pmt8[k] == pmi); if (!seen && n < 7) pmt8[n++] = pmi; }
              pmt8[8] = n; for (int k = n; k < 8; ++k) pmt8[k] = -1; }
          __syncthreads();
          const int n_ = pmt8[8];
          for (int idx = tid; idx < n_ * 256; idx += NWAVES * 64) rt8[idx] = pg8::row_rstd(st1, pmt8[idx >> 8] * 256 + (idx & 255));
          __syncthreads(); }
        pg8::EpiSoftmaxS E{st1, MSCALE, R3, (LAS float*)(lds + SCR_OFF), (unsigned)(size_t)rt8, (unsigned)(size_t)pmt8}; pg8::gemm_phase(lds + RING_OFF, P, S, E);
          { pg8::Piece pc; if (pg8::piece_of_mem(G, bx, 4, 0, pc)) pg8::gemm_piece(lds + RING_OFF, P, E, pc, pg8::SplitCtx{slabs, ctl + 4096 + 320, MISC + 16}); }
        if (G == 256) { pg8::ProbVp Pv{Wom_t, memv, 256, 1024, 1024}; pg8::PreOrder So{128, (int)bx - 128, 128, 256}; pg8::EpiPlain Ev{Vp, 1024}; pg8::gemm_phase(lds + RING_OFF, Pv, So, Ev); }
    }
    SEAM(8);

    if (IN(9)) {
        pg8::ProbMA P{R3, Vp, 1024, 1024, 1024}; pg8::StaticOrder S; S.init(MP, 1024, G, bx);
        pg8::EpiResM E{G == 256 ? (float*)nullptr : out + OUT_Y, R1, st2}; pg8::gemm_phase(lds + RING_OFF, P, S, E);
          { pg8::Piece pc; if (pg8::piece_of_mem(G, bx, 4, 0, pc)) pg8::gemm_piece(lds + RING_OFF, P, E, pc, pg8::SplitCtx{slabs, ctl + 4096 + 384, MISC + 16}); }
    }
    SEAM(9);

    if (IN(12)) {
        pg8::Dense P{R1, Wup_t, 1024, 1024, 1024}; pg8::StaticOrder S; S.init(MP, DFF, G, bx);
        LAS float* rt = (LAS float*)(lds + SCR_OFF); LAS int* pmt = (LAS int*)(lds + MISC_OFF + 128);
        { TID_LANE
          if (tid == 0) { int n = 0;
              for (int i = 0; ; ++i) { const int pmi = S.pm_of(i); if (pmi < 0) break; bool seen = false; for (int k = 0; k < n; ++k) seen = seen || (pmt[k] == pmi); if (!seen && n < 8) pmt[n++] = pmi; }
              pmt[8] = n; for (int k = n; k < 8; ++k) pmt[k] = -1; }
          __syncthreads();
          const int n = pmt[8];
          for (int idx = tid; idx < n * 256; idx += NWAVES * 64) rt[idx] = pg8::row_rstd(st2, pmt[idx >> 8] * 256 + (idx & 255));
          __syncthreads(); (void)lane; }
        pg8::EpiNormAct<1> E{st2, R2, DFF, 1.0f, (unsigned)(size_t)rt, (unsigned)(size_t)pmt}; pg8::gemm_phase(lds + RING_OFF, P, S, E);
          { pg8::Piece pc; if (pg8::piece_of(DFF, 1024, G, bx, 4, 0, pc)) pg8::gemm_piece(lds + RING_OFF, P, E, pc, pg8::SplitCtx{slabs, ctl + 4096 + 448, MISC + 16}); }
    }
    SEAM(12);

    if (IN(13)) {
        pg8::Dense P{R2, Wdn_t, DFF, DFF, DFF}; pg8::StaticOrder S; S.init(MP, 1024, G, bx);
        if (G == 256) {
            pg8::EpiResFinal E{out + OUT_Y, out + OUT_Y + (size_t)MP * 1024, out + OUT_Y, st3, ctl + 8192, g_final, R1}; pg8::gemm_phase(lds + RING_OFF, P, S, E);
            { pg8::Piece pc; if (pg8::piece_of(1024, DFF, G, bx, 8, 0, pc)) pg8::gemm_piece(lds + RING_OFF, P, E, pc, pg8::SplitCtx{slabs, ctl + 4096 + 512, MISC + 16}); }
        } else {
            pg8::EpiRes E{out + OUT_Y, out + OUT_Y + (size_t)MP * 1024, out + OUT_Y, nullptr, st3}; pg8::gemm_phase(lds + RING_OFF, P, S, E);
            { pg8::Piece pc; if (pg8::piece_of(1024, DFF, G, bx, 8, 0, pc)) pg8::gemm_piece(lds + RING_OFF, P, E, pc, pg8::SplitCtx{slabs, ctl + 4096 + 512, MISC + 16}); }
        }
    }
    if (G != 256) SEAM(13);

    if (IN(14) && G != 256) { TID_LANE
        for (int r = gw; r < MT; r += NGW) {
            const float rs = pg8::row_rstd(st3, r); float* p = out + OUT_Y + (size_t)r * 1024;
#pragma unroll
            for (int j = 0; j < 4; ++j) { const int c = 256 * j + 4 * lane; *(f32x4*)(p + c) = *(const f32x4*)(p + c) * rs * *(const f32x4*)(g_final + c); }
        }
    }
#undef IN
#undef SEAM
#undef x_prompt
#undef x_sample
#undef cache_conv
#undef cache_ckv
#undef cache_krope
#undef cache_mem_k
#undef cache_mem_v
#undef mem_prompt
#undef g_mix
#undef w_in
#undef w_conv
#undef w_conv_out
#undef g_q
#undef w_uq
#undef g_kv
#undef w_ukv
#undef w_mla_out
#undef w_mix_out
#undef g_mem_q
#undef g_mem_kv
#undef w_qm
#undef w_km
#undef w_vm
#undef w_om
#undef g_mlp
#undef w_up
#undef w_down
#undef g_final
#undef KIN
}

#ifndef MK_PER_PHASE
#define MK_PER_PHASE 0
#endif
constexpr int NPHASE = 15;
extern "C" void kernel_launch(void* const* d_in, const int* in_sizes, int n_in, void* d_out, int out_size, void* d_ws, size_t ws_size, hipStream_t stream) {
    static int grid = 0;
    if (grid == 0) {
        if (n_in != 28 || (size_t)out_size != OUT_TOTAL || ws_size < WS_END) { fprintf(stderr, "kernel_launch: unexpected problem (n_in %d, out %d, ws %zu)\n", n_in, out_size, ws_size); grid = -1; return; }
        int dev = 0, cus = 0, per_cu = 0;
        if (hipGetDevice(&dev) != hipSuccess || hipDeviceGetAttribute(&cus, hipDeviceAttributeMultiprocessorCount, dev) != hipSuccess) { grid = -1; return; }
        if (hipFuncSetAttribute((const void*)fwd_kernel, hipFuncAttributeMaxDynamicSharedMemorySize, LDS_BYTES) != hipSuccess) { fprintf(stderr, "kernel_launch: hipFuncSetAttribute failed\n"); grid = -1; return; }
        if (hipOccupancyMaxActiveBlocksPerMultiprocessor(&per_cu, (const void*)fwd_kernel, NWAVES * 64, LDS_BYTES) != hipSuccess || per_cu < 1) { fprintf(stderr, "kernel_launch: occupancy query says %d\n", per_cu); per_cu = 1; }
        (void)hipGetLastError();
        grid = cus;
    }
    if (grid < 0) return;
    (void)hipMemsetAsync((char*)d_ws + WS_CTL, 0, CTL_ZERO_BYTES, stream);
    Args a{};
    for (int i = 0; i < 28; ++i) a.in[i] = (const float*)d_in[i];
    a.out = (float*)d_out; a.ws = (unsigned char*)d_ws;
#if MK_PER_PHASE
    for (int p = 0; p < NPHASE; ++p) { a.ph_lo = p; a.ph_hi = p + 1; hipLaunchKernelGGL(fwd_kernel, dim3(grid), dim3(NWAVES * 64), LDS_BYTES, stream, a); }
#else
    a.ph_lo = 0; a.ph_hi = NPHASE;
    hipLaunchKernelGGL(fwd_kernel, dim3(grid), dim3(NWAVES * 64), LDS_BYTES, stream, a);
#endif
}
```
